# Optimizing an MI355X kernel written in HIP

```python
import math
import jax
import jax.numpy as jnp
from jax import lax
import numpy as np

D_MODEL = 1024
BATCH = 2
SEQ = 16384
DEPTH = 4

GRID_W = 64
CTX_LEN = 256
N_MIXERS = 3
NORM_EPS = 1e-6

RW_HEAD = 64
RW_H = D_MODEL // RW_HEAD
RW_DECAY_LORA = 64
RW_AAA_LORA = 64
RW_MV_LORA = 32
RW_GATE_LORA = 160
RW_LN_EPS = 64e-5

HY_ORDER = 2
HY_EMB = 33
HY_BANDS = (HY_EMB - 1) // 2
HY_FILTER_W = 64
HY_FAST_DECAY = 0.3
HY_SLOW_DECAY = 1.5
HY_TARGET = 1e-2

HG_DK = 128
HG_H = D_MODEL // HG_DK
HG_DV = D_MODEL // HG_H
HG_CHUNK = 32

FFN_DIM = 2816
N_EXPERTS = 8
TOP_K = 2
EXPERT_DIM = 3584
MOE_BLOCK = 512

N_RWKV = (DEPTH + 2) // 3
N_HYENA = (DEPTH + 1) // 3
N_HGRN = DEPTH // 3
N_DENSE = (DEPTH + 1) // 2
N_MOE = DEPTH // 2

kernel_name = 'hybrid_rwkv7_hyena_hgrn2_moe_dit'


def rmsnorm(x, g, eps=NORM_EPS):
    xf = x.astype(jnp.float32)
    y = xf * lax.rsqrt(jnp.mean(xf * xf, axis=-1, keepdims=True) + eps)
    return (y * g.astype(jnp.float32)).astype(x.dtype)


def shift_seq(h):
    half = h.shape[-1] // 2
    prev = jnp.pad(h[:, :-1, :half], ((0, 0), (1, 0), (0, 0)))
    nxt = jnp.pad(h[:, 1:, half:], ((0, 0), (0, 1), (0, 0)))
    return jnp.concatenate([prev, nxt], axis=-1)


def shift_grid(h):
    b, l, d = h.shape
    rows = l // GRID_W
    g = h.reshape(b, rows, GRID_W, d)
    q = d // 4
    left = jnp.pad(g[:, :, :-1, :q], ((0, 0), (0, 0), (1, 0), (0, 0)))
    right = jnp.pad(g[:, :, 1:, q:2 * q], ((0, 0), (0, 0), (0, 1), (0, 0)))
    up = jnp.pad(g[:, :-1, :, 2 * q:3 * q], ((0, 0), (1, 0), (0, 0), (0, 0)))
    down = jnp.pad(g[:, 1:, :, 3 * q:], ((0, 0), (0, 1), (0, 0), (0, 0)))
    return jnp.concatenate([left, right, up, down], axis=-1).reshape(b, l, d)


def rwkv7_scan(r, decay, k, v, a_vec, b_vec, state0, reverse):
    def step(S, inp):
        r_t, w_t, k_t, v_t, a_t, b_t = inp
        sa = jnp.einsum('bhvk,bhk->bhv', S, a_t)
        S = S * w_t[:, :, None, :] + sa[..., None] * b_t[:, :, None, :] + v_t[..., None] * k_t[:, :, None, :]
        return S, jnp.einsum('bhvk,bhk->bhv', S, r_t)
    xs = tuple(jnp.swapaxes(t, 0, 1) for t in (r, decay, k, v, a_vec, b_vec))
    s_last, ys = lax.scan(step, state0, xs, reverse=reverse)
    return jnp.swapaxes(ys, 0, 1), s_last


def rwkv7_stream(h, shifted, state0, v_first, mu, w_rkv, w_o, w0, w1, w2, a0, a1, a2,
                 g1, g2, k_k, k_a, r_k, ln_w, ln_b, vres):
    f32 = jnp.float32
    B, L, D = h.shape
    xx = shifted - h
    xr, xw, xk, xv, xa, xg = (h + xx * mu[j] for j in range(6))
    r, k, v = jnp.einsum('nbld,nde->nble', jnp.stack([xr, xk, xv]), w_rkv)
    if vres is not None:
        v0, v1, v2 = vres
        v = v + (v_first - v) * jax.nn.sigmoid(v0 + (xv @ v1) @ v2)
    heads = lambda t: t.reshape(B, L, RW_H, RW_HEAD).astype(f32)
    kk = heads(k * k_k)
    kk = kk / jnp.maximum(jnp.linalg.norm(kk, axis=-1, keepdims=True), 1e-12)
    rh, vh, kh = heads(r), heads(v), heads(k)
    kah = k_a.reshape(RW_H, RW_HEAD).astype(f32)
    rkh = r_k.astype(f32)
    ys, bonuses, states = [], [], []
    for d in range(2):
        wl = w0[d] + jnp.tanh(xw @ w1[d]) @ w2[d]
        decay = jnp.exp(-jnp.exp(-jax.nn.softplus(-heads(wl)) - 0.5))
        a = jax.nn.sigmoid(heads(a0[d] + (xa @ a1[d]) @ a2[d]))
        kd = kh * (1.0 + (a - 1.0) * kah)
        yd, sd = rwkv7_scan(rh, decay, kd, vh, -kk, kk * a, state0[d], reverse=(d == 1))
        ys.append(yd)
        bonuses.append(jnp.sum(rh * kd * rkh, axis=-1, keepdims=True) * vh)
        states.append(sd)
    y = ys[0] + ys[1]
    mean = jnp.mean(y, axis=-1, keepdims=True)
    var = jnp.mean(jnp.square(y - mean), axis=-1, keepdims=True)
    y = ((y - mean) * lax.rsqrt(var + RW_LN_EPS)).reshape(B, L, D) * ln_w + ln_b
    y = y + (bonuses[0] + bonuses[1]).reshape(B, L, D)
    g = jax.nn.sigmoid(xg @ g1) @ g2
    out = (y.astype(h.dtype) * g) @ w_o
    return out, jnp.stack(states), v


def hyena_filter(L, w1, b1, w2, b2, w3, b3, w4, freq):
    f32 = jnp.float32
    w1, b1, w2, b2, w3, b3, w4, freq = (p.astype(f32) for p in (w1, b1, w2, b2, w3, b3, w4, freq))
    pos = jnp.arange(L, dtype=f32)
    t = (pos / max(L - 1, 1))[:, None]
    ang = (2.0 * math.pi / L) * pos[:, None] * jnp.linspace(1e-4, HY_BANDS - 1, HY_BANDS, dtype=f32)[None, :]
    z = jnp.concatenate([t, jnp.cos(ang), -jnp.sin(ang)], axis=-1)
    hid = jnp.sin(freq[0] * (z @ w1 + b1))
    hid = jnp.sin(freq[1] * (hid @ w2 + b2))
    hid = jnp.sin(freq[2] * (hid @ w3 + b3))
    filt = (hid @ w4).reshape(L, HY_ORDER, 2, D_MODEL)
    deltas = jnp.linspace(math.log(HY_TARGET) / HY_FAST_DECAY, math.log(HY_TARGET) / HY_SLOW_DECAY,
                          D_MODEL, dtype=f32)
    window = jnp.exp(-t * jnp.abs(deltas))
    return filt * window[:, None, None, :]


def long_conv(u, h_fwd, h_bwd, bias):
    f32 = jnp.float32
    L = u.shape[1]
    kern = jnp.concatenate([h_fwd, jnp.zeros_like(h_fwd[:1]), h_bwd[:0:-1]], axis=0)
    kf = jnp.fft.rfft(kern, axis=0)
    uf = jnp.fft.rfft(u.astype(f32), n=2 * L, axis=1)
    y = jnp.fft.irfft(uf * kf[None], n=2 * L, axis=1)[:, :L]
    return y + u.astype(f32) * bias.astype(f32)


def hyena_stream(h, filt, w_in, b_in, conv_w, conv_b, skip, w_o, b_o):
    proj = h @ w_in + b_in
    prev = jnp.pad(proj[:, :-1], ((0, 0), (1, 0), (0, 0)))
    nxt = jnp.pad(proj[:, 1:], ((0, 0), (0, 1), (0, 0)))
    proj = prev * conv_w[0] + proj * conv_w[1] + nxt * conv_w[2] + conv_b
    x1, x2, v = jnp.split(proj, 3, axis=-1)
    z = long_conv(v, filt[:, 0, 0], filt[:, 0, 1], skip[0]) * x1
    y = long_conv(z, filt[:, 1, 0], filt[:, 1, 1], skip[1]) * x2
    return y.astype(h.dtype) @ w_o + b_o


def gla_chunked(q, k, v, logf, s0):
    B, L, H, DK = q.shape
    DV = v.shape[-1]
    n = L // HG_CHUNK
    def chunks(t):
        return jnp.moveaxis(t.reshape(B, n, HG_CHUNK, H, t.shape[-1]), 3, 1)
    qc, kc, vc, gc = chunks(q), chunks(k), chunks(v), chunks(logf)
    G = jnp.cumsum(gc, axis=3)
    G_ref = G[:, :, :, HG_CHUNK // 2 - 1:HG_CHUNK // 2]
    scores = jnp.einsum('bhntk,bhnsk->bhnts', qc * jnp.exp(G - G_ref), kc * jnp.exp(G_ref - G))
    mask = jnp.tril(jnp.ones((HG_CHUNK, HG_CHUNK), dtype=bool))
    o_intra = jnp.einsum('bhnts,bhnsv->bhntv', jnp.where(mask, scores, 0.0), vc)
    G_last = G[:, :, :, -1:]
    xs = (jnp.moveaxis(qc * jnp.exp(G), 2, 0),
          jnp.moveaxis(kc * jnp.exp(G_last - G), 2, 0),
          jnp.moveaxis(vc, 2, 0),
          jnp.moveaxis(jnp.exp(G_last[:, :, :, 0]), 2, 0))
    def step(S, inp):
        qd, kd, vv, dec = inp
        o = jnp.einsum('bhck,bhkv->bhcv', qd, S)
        S = S * dec[..., None] + jnp.einsum('bhck,bhcv->bhkv', kd, vv)
        return S, o
    s_last, o_inter = lax.scan(step, s0, xs)
    o = o_intra + jnp.moveaxis(o_inter, 0, 2)
    return jnp.moveaxis(o, 1, 3).reshape(B, L, H, DV), s_last


def hgrn2_stream(h, state0, lb, w_in, gn, w_o):
    f32 = jnp.float32
    B, L, D = h.shape
    q, f_fwd, f_bwd, i_in, g = jnp.split(h @ w_in, 5, axis=-1)
    heads = lambda t: t.reshape(B, L, HG_H, -1).astype(f32)
    qh, vh = heads(jax.nn.silu(q)), heads(i_in)
    outs, states = [], []
    for d, f_raw in enumerate((f_fwd, f_bwd)):
        lbd = lb[d].reshape(HG_H, HG_DK).astype(f32)
        fg = lbd + (1.0 - lbd) * jax.nn.sigmoid(heads(f_raw))
        flip = (lambda t: jnp.flip(t, axis=1)) if d == 1 else (lambda t: t)
        od, sd = gla_chunked(flip(qh), flip(1.0 - fg), flip(vh), flip(jnp.log(fg)), state0[d])
        outs.append(flip(od))
        states.append(sd)
    o = outs[0] + outs[1]
    o = o * lax.rsqrt(jnp.mean(o * o, axis=-1, keepdims=True) + NORM_EPS) * gn.astype(f32)
    o = o.reshape(B, L, D).astype(h.dtype) * jax.nn.silu(g)
    return o @ w_o, jnp.stack(states)


def swiglu(h, w13, w2):
    gate, up = jnp.split(h @ w13, 2, axis=-1)
    return (jax.nn.silu(gate) * up) @ w2


def moe_swiglu(h, w_router, w13, w2):
    T, D = h.shape
    A = T * TOP_K
    logits = (h @ w_router).astype(jnp.float32)
    top_val, top_idx = lax.top_k(logits, TOP_K)
    gates = jax.nn.softmax(top_val, axis=-1).reshape(A)
    flat_e = top_idx.reshape(A)
    flat_tok = jnp.repeat(jnp.arange(T, dtype=jnp.int32), TOP_K)
    order = jnp.argsort(flat_e)
    sorted_e, sorted_tok = flat_e[order], flat_tok[order]
    counts = jnp.bincount(flat_e, length=N_EXPERTS)
    starts = jnp.cumsum(counts) - counts
    padded = (counts + MOE_BLOCK - 1) // MOE_BLOCK * MOE_BLOCK
    pends = jnp.cumsum(padded)
    dest = (pends - padded)[sorted_e] + jnp.arange(A, dtype=jnp.int32) - starts[sorted_e]
    n_blocks = (A + N_EXPERTS * (MOE_BLOCK - 1) + MOE_BLOCK - 1) // MOE_BLOCK
    buf = jnp.zeros((n_blocks * MOE_BLOCK, D), h.dtype).at[dest].set(h[sorted_tok])
    block_e = jnp.minimum(jnp.searchsorted(pends, jnp.arange(n_blocks, dtype=jnp.int32) * MOE_BLOCK,
                                           side='right'), N_EXPERTS - 1)
    def expert_block(args):
        xb, e = args
        return swiglu(xb, w13[e], w2[e])
    out = lax.map(expert_block, (buf.reshape(n_blocks, MOE_BLOCK, D), block_e)).reshape(-1, D)
    y = out[dest] * gates[order][:, None].astype(out.dtype)
    return jax.ops.segment_sum(y, sorted_tok, num_segments=T)


def setup_inputs(seed: int = 0) -> dict:
    key = jax.random.key(seed)
    keys = iter(jax.random.split(key, 64))
    f32 = jnp.float32
    D = D_MODEL
    def nrm(shape, scale):
        return jax.random.normal(next(keys), shape, f32) * scale
    def unif(shape, lo, hi):
        return jax.random.uniform(next(keys), shape, f32, lo, hi)
    return {
        'x': nrm((BATCH, SEQ, D), 1.0),
        'c': nrm((BATCH, D), 1.0),
        'ctx': nrm((BATCH, CTX_LEN, D), 1.0),
        'c_ctx': nrm((D,), 1.0),
        'norm_g': 1.0 + nrm((DEPTH, 2, D), 0.1),
        'ada_w': nrm((DEPTH, D, 6 * D), 0.5 * D ** -0.5),
        'ada_b': nrm((DEPTH, 6 * D), 0.02),
        'final_g': 1.0 + nrm((D,), 0.1),
        'rw_mu': unif((N_RWKV, 6, D), 0.0, 1.0),
        'rw_wrkv': nrm((N_RWKV, 3, D, D), D ** -0.5),
        'rw_wo': nrm((N_RWKV, D, D), D ** -0.5),
        'rw_w0': unif((N_RWKV, 2, D), -6.0, -1.0),
        'rw_w1': nrm((N_RWKV, 2, D, RW_DECAY_LORA), D ** -0.5),
        'rw_w2': nrm((N_RWKV, 2, RW_DECAY_LORA, D), 0.1 * RW_DECAY_LORA ** -0.5),
        'rw_a0': nrm((N_RWKV, 2, D), 0.1),
        'rw_a1': nrm((N_RWKV, 2, D, RW_AAA_LORA), D ** -0.5),
        'rw_a2': nrm((N_RWKV, 2, RW_AAA_LORA, D), 0.5 * RW_AAA_LORA ** -0.5),
        'rw_v0': nrm((N_RWKV - 1, D), 0.1),
        'rw_v1': nrm((N_RWKV - 1, D, RW_MV_LORA), D ** -0.5),
        'rw_v2': nrm((N_RWKV - 1, RW_MV_LORA, D), 0.5 * RW_MV_LORA ** -0.5),
        'rw_g1': nrm((N_RWKV, D, RW_GATE_LORA), D ** -0.5),
        'rw_g2': nrm((N_RWKV, RW_GATE_LORA, D), RW_GATE_LORA ** -0.5),
        'rw_kk': 0.85 + nrm((N_RWKV, D), 0.05),
        'rw_ka': 1.0 + nrm((N_RWKV, D), 0.1),
        'rw_rk': nrm((N_RWKV, RW_H, RW_HEAD), 0.1),
        'rw_lnw': 1.0 + nrm((N_RWKV, D), 0.1),
        'rw_lnb': nrm((N_RWKV, D), 0.02),
        'hy_win': nrm((N_HYENA, D, 3 * D), D ** -0.5),
        'hy_bin': nrm((N_HYENA, 3 * D), 0.02),
        'hy_cw': nrm((N_HYENA, 3, 3 * D), 0.5),
        'hy_cb': nrm((N_HYENA, 3 * D), 0.02),
        'hy_fw1': nrm((N_HYENA, HY_EMB, HY_FILTER_W), HY_EMB ** -0.5),
        'hy_fb1': nrm((N_HYENA, HY_FILTER_W), 0.1),
        'hy_fw2': nrm((N_HYENA, HY_FILTER_W, HY_FILTER_W), HY_FILTER_W ** -0.5),
        'hy_fb2': nrm((N_HYENA, HY_FILTER_W), 0.1),
        'hy_fw3': nrm((N_HYENA, HY_FILTER_W, HY_FILTER_W), HY_FILTER_W ** -0.5),
        'hy_fb3': nrm((N_HYENA, HY_FILTER_W), 0.1),
        'hy_fw4': nrm((N_HYENA, HY_FILTER_W, HY_ORDER * 2 * D), 0.05 * HY_FILTER_W ** -0.5),
        'hy_freq': 1.0 + nrm((N_HYENA, 3, HY_FILTER_W), 0.1),
        'hy_skip': nrm((N_HYENA, HY_ORDER, D), 0.5),
        'hy_wo': nrm((N_HYENA, D, D), D ** -0.5),
        'hy_bo': nrm((N_HYENA, D), 0.02),
        'hg_win': nrm((N_HGRN, D, 5 * D), D ** -0.5),
        'hg_lb': nrm((DEPTH, 2, D), 0.1),
        'hg_gn': 1.0 + nrm((N_HGRN, HG_DV), 0.1),
        'hg_wo': nrm((N_HGRN, D, D), D ** -0.5),
        'ffn_w13': nrm((N_DENSE, D, 2 * FFN_DIM), D ** -0.5),
        'ffn_w2': nrm((N_DENSE, FFN_DIM, D), FFN_DIM ** -0.5),
        'moe_router': nrm((N_MOE, D, N_EXPERTS), D ** -0.5),
        'moe_w13': nrm((N_MOE, N_EXPERTS, D, 2 * EXPERT_DIM), D ** -0.5),
        'moe_w2': nrm((N_MOE, N_EXPERTS, EXPERT_DIM, D), EXPERT_DIM ** -0.5),
    }


def reference(x, c, ctx, c_ctx, norm_g, ada_w, ada_b, final_g,
              rw_mu, rw_wrkv, rw_wo, rw_w0, rw_w1, rw_w2, rw_a0, rw_a1, rw_a2,
              rw_v0, rw_v1, rw_v2, rw_g1, rw_g2, rw_kk, rw_ka, rw_rk, rw_lnw, rw_lnb,
              hy_win, hy_bin, hy_cw, hy_cb, hy_fw1, hy_fb1, hy_fw2, hy_fb2, hy_fw3, hy_fb3,
              hy_fw4, hy_freq, hy_skip, hy_wo, hy_bo,
              hg_win, hg_lb, hg_gn, hg_wo,
              ffn_w13, ffn_w2, moe_router, moe_w13, moe_w2):
    f32 = jnp.float32
    B = x.shape[0]
    lat, cx = x, ctx
    v_first = None
    lbc = jnp.cumsum(jax.nn.softmax(hg_lb.astype(f32), axis=0), axis=0)
    lower = lbc - lbc[:1]
    for i in range(DEPTH):
        last = i == DEPTH - 1
        mod_l = jnp.split((jax.nn.silu(c) @ ada_w[i] + ada_b[i])[:, None, :], 6, axis=-1)
        mod_c = jnp.split((jax.nn.silu(c_ctx) @ ada_w[i] + ada_b[i])[None, None, :], 6, axis=-1)
        hl = rmsnorm(lat, norm_g[i, 0]) * (1.0 + mod_l[1]) + mod_l[0]
        hc = rmsnorm(cx, norm_g[i, 0]) * (1.0 + mod_c[1]) + mod_c[0]
        kind, slot = i % N_MIXERS, i // N_MIXERS
        if kind == 0:
            vres = None if slot == 0 else (rw_v0[slot - 1], rw_v1[slot - 1], rw_v2[slot - 1])
            rw = (rw_mu[slot], rw_wrkv[slot], rw_wo[slot], rw_w0[slot], rw_w1[slot], rw_w2[slot],
                  rw_a0[slot], rw_a1[slot], rw_a2[slot], rw_g1[slot], rw_g2[slot], rw_kk[slot],
                  rw_ka[slot], rw_rk[slot], rw_lnw[slot], rw_lnb[slot], vres)
            zero = jnp.zeros((2, B, RW_H, RW_HEAD, RW_HEAD), f32)
            vf_c = None if v_first is None else v_first[0]
            vf_l = None if v_first is None else v_first[1]
            y_c, s_ctx, v_c = rwkv7_stream(hc, shift_seq(hc), zero, vf_c, *rw)
            y_l, _, v_l = rwkv7_stream(hl, shift_grid(hl), s_ctx, vf_l, *rw)
            if slot == 0:
                v_first = (v_c, v_l)
        elif kind == 1:
            fprm = (hy_fw1[slot], hy_fb1[slot], hy_fw2[slot], hy_fb2[slot], hy_fw3[slot],
                    hy_fb3[slot], hy_fw4[slot], hy_freq[slot])
            hprm = (hy_win[slot], hy_bin[slot], hy_cw[slot], hy_cb[slot], hy_skip[slot],
                    hy_wo[slot], hy_bo[slot])
            y_l = hyena_stream(hl, hyena_filter(hl.shape[1], *fprm), *hprm)
            y_c = None if last else hyena_stream(hc, hyena_filter(hc.shape[1], *fprm), *hprm)
        else:
            zero = jnp.zeros((2, B, HG_H, HG_DK, HG_DV), f32)
            gprm = (lower[i], hg_win[slot], hg_gn[slot], hg_wo[slot])
            y_c, s_ctx = hgrn2_stream(hc, zero, *gprm)
            y_l, _ = hgrn2_stream(hl, s_ctx, *gprm)
        lat = lat + mod_l[2] * y_l
        if not last:
            cx = cx + mod_c[2] * y_c
        hl = rmsnorm(lat, norm_g[i, 1]) * (1.0 + mod_l[4]) + mod_l[3]
        if last:
            n_ctx = 0
            tokens = hl.reshape(-1, D_MODEL)
        else:
            hc = rmsnorm(cx, norm_g[i, 1]) * (1.0 + mod_c[4]) + mod_c[3]
            n_ctx = cx.shape[0] * cx.shape[1]
            tokens = jnp.concatenate([hc.reshape(-1, D_MODEL), hl.reshape(-1, D_MODEL)], axis=0)
        if i % 2 == 0:
            out = swiglu(tokens, ffn_w13[i // 2], ffn_w2[i // 2])
        else:
            out = moe_swiglu(tokens, moe_router[i // 2], moe_w13[i // 2], moe_w2[i // 2])
        lat = lat + mod_l[5] * out[n_ctx:].reshape(lat.shape)
        if not last:
            cx = cx + mod_c[5] * out[:n_ctx].reshape(cx.shape)
    return rmsnorm(lat, final_g)
```

```cpp
#include <hip/hip_runtime.h>
#include <cstdio>
#include <cstdint>

#define GAS __attribute__((address_space(1)))
#define LAS __attribute__((address_space(3)))
typedef unsigned short bf16_t;
typedef unsigned v4u __attribute__((ext_vector_type(4)));
typedef unsigned v2u __attribute__((ext_vector_type(2)));
typedef float f32x4 __attribute__((ext_vector_type(4)));
typedef float f32x2 __attribute__((ext_vector_type(2)));
typedef short bf16x8 __attribute__((ext_vector_type(8)));
typedef GAS unsigned gu32;
#define RLX_AGENT __ATOMIC_RELAXED, __HIP_MEMORY_SCOPE_AGENT
#define LDS_WAIT() asm volatile("s_waitcnt lgkmcnt(0)" ::: "memory")
#define VM_WAIT() asm volatile("s_waitcnt vmcnt(0)" ::: "memory")

constexpr int D = 1024, NB = 2, SEQ = 16384, CTXL = 256, GRIDW = 64;
constexpr int NCTX = NB * CTXL;
constexpr int NLAT = NB * SEQ;
constexpr int MROWS = NCTX + NLAT;
constexpr int PMT = MROWS / 256;
constexpr int DEPTH = 4;
constexpr int FFN = 2816, NEXP = 8, EDIM = 3584;
constexpr int NWAVES = 8, NTHR = 512;
constexpr float NORM_EPS = 1e-6f;

__device__ __forceinline__ unsigned f2bf(float f) { unsigned u = __builtin_bit_cast(unsigned, f); return (u + 0x7fffu + ((u >> 16) & 1u)) >> 16; }
__device__ __forceinline__ unsigned pk2(float lo, float hi) { return f2bf(lo) | (f2bf(hi) << 16); }
__device__ __forceinline__ float bf2f(unsigned b) { return __builtin_bit_cast(float, b << 16); }
__device__ __forceinline__ float bflo(unsigned w) { return __builtin_bit_cast(float, w << 16); }
__device__ __forceinline__ float bfhi(unsigned w) { return __builtin_bit_cast(float, w & 0xffff0000u); }
__device__ __forceinline__ float sigmoidf_(float x) { return 1.0f / (1.0f + __expf(-x)); }
__device__ __forceinline__ float siluf_(float x) { return x / (1.0f + __expf(-x)); }
__device__ __forceinline__ float wave_sum(float v) {
#pragma unroll
    for (int o = 1; o < 64; o <<= 1) v += __shfl_xor(v, o);
    return v;
}
__device__ __forceinline__ int row_bidx(int r) { return r < NCTX ? 0 : 1 + ((r - NCTX) >> 14); }

#define XB_TMO      128
#define XB_XCNT(j)  (256  + 64 * (j))
#define XB_XSUB(j)  (1280 + 64 * (j))
#define XB_XGEN(j)  (2304 + 64 * (j))
#define XB_TOP      3328
#define XB_TOPGEN   3392
#define XCD_BAR_WORDS 3456
#define XB_SPIN_CAP (1u << 20)

__device__ __forceinline__ unsigned xb_ld(unsigned* p)              { return __hip_atomic_load(p, __ATOMIC_RELAXED, __HIP_MEMORY_SCOPE_AGENT); }
__device__ __forceinline__ unsigned xb_add(unsigned* p, unsigned v) { return __hip_atomic_fetch_add(p, v, __ATOMIC_RELAXED, __HIP_MEMORY_SCOPE_AGENT); }
__device__ __forceinline__ unsigned xb_xcc_id() { return (unsigned)__builtin_amdgcn_s_getreg((3 << 11) | 20) & 0xFu; }
#define XB_SPIN(cond, bar) do { unsigned _sp = 0; while (cond) { __builtin_amdgcn_s_sleep(1); \
    if ((++_sp & 255u) == 0u) { if (xb_ld(&(bar)[XB_TMO])) break; if (_sp > XB_SPIN_CAP) { atomicAdd(&(bar)[XB_TMO], 1u); break; } } } } while (0)

struct XcdBarrier { unsigned* bar; unsigned x; volatile LAS unsigned* st; };

__device__ __forceinline__ XcdBarrier xcd_barrier_post(unsigned* bar, volatile LAS unsigned* st) {
    XcdBarrier b; b.bar = bar; b.x = xb_xcc_id(); b.st = st;
    if (threadIdx.x == 0) (void)xb_add(&bar[XB_XCNT(b.x)], 1u);
    return b;
}
__device__ __forceinline__ void xcd_barrier_complete(unsigned* bar, unsigned x, unsigned& nloc, unsigned& nx) {
    const unsigned G = gridDim.x * gridDim.y * gridDim.z;
    unsigned sum, cnt, mine, sp = 0u;
    for (;;) {
        sum = 0u; cnt = 0u; mine = 0u;
#pragma unroll
        for (unsigned j = 0; j < 16; ++j) { const unsigned c = xb_ld(&bar[XB_XCNT(j)]); sum += c; cnt += (c > 0u) ? 1u : 0u; mine = (j == x) ? c : mine; }
        if (sum == G) break;
        __builtin_amdgcn_s_sleep(1);
        if ((++sp & 255u) == 0u) { if (xb_ld(&bar[XB_TMO])) break; if (sp > XB_SPIN_CAP) { atomicAdd(&bar[XB_TMO], 1u); break; } }
    }
    nloc = mine > 0u ? mine : 1u; nx = cnt > 0u ? cnt : 1u;
}
__device__ __forceinline__ void xcd_barrier(const XcdBarrier& b) {
    asm volatile("s_waitcnt vmcnt(0)" ::: "memory");
    __syncthreads();
    if (threadIdx.x == 0) {
        unsigned* bar = b.bar;
        __builtin_amdgcn_s_waitcnt(0);
        unsigned nloc = b.st[0], nx = b.st[1];
        if (nloc == 0u) { xcd_barrier_complete(bar, b.x, nloc, nx); b.st[0] = nloc; b.st[1] = nx; }
        const unsigned old = xb_add(&bar[XB_XSUB(b.x)], 1u);
        const unsigned gen = old / nloc;
        if (old + 1u == (gen + 1u) * nloc) {
            __builtin_amdgcn_fence(__ATOMIC_RELEASE, "agent");
            asm volatile("s_waitcnt vmcnt(0)" ::: "memory");
            const unsigned og = xb_add(&bar[XB_TOP], 1u);
            const unsigned tg = og / nx;
            if (og + 1u == (tg + 1u) * nx) xb_add(&bar[XB_TOPGEN], 1u);
            else XB_SPIN(xb_ld(&bar[XB_TOPGEN]) == tg, bar);
            __builtin_amdgcn_fence(__ATOMIC_ACQUIRE, "agent");
            xb_add(&bar[XB_XGEN(b.x)], 1u);
            asm volatile("s_waitcnt vmcnt(0)" ::: "memory");
        } else {
            XB_SPIN(xb_ld(&bar[XB_XGEN(b.x)]) == gen, bar);
            __builtin_amdgcn_fence(__ATOMIC_ACQUIRE, "agent");
            asm volatile("s_waitcnt vmcnt(0)" ::: "memory");
        }
    }
    __syncthreads();
}
namespace pg8 {
constexpr int BM = 256, BK = 64, HALF = 128, HTB = HALF * BK * 2, STAGE_BYTES = 8 * HTB, NXCD = 8, WGM = 8;
__host__ __device__ __forceinline__ int lds_byte(int r, int c) { const int st = (r >> 4) * 2 + (c >> 5), rr = r & 15, cc = c & 31, ob = rr * 64 + cc * 2; return st * 1024 + (ob ^ (((ob >> 9) & 1) << 5)); }
__host__ __device__ __forceinline__ void stage_rc(int b, int& R, int& C) { const int st = b / 1024, sb = b % 1024, swz = sb ^ (((sb >> 9) & 1) << 5); R = (st >> 1) * 16 + swz / 64; C = (st & 1) * 32 + (swz % 64) / 2; }
__host__ __device__ __forceinline__ int perm32(int rho) { const int n = rho >> 4, i = rho & 15; return 8 * (i >> 2) + 4 * n + (i & 3); }

struct Unit { int pm, pn, aux; };

__device__ __forceinline__ bool static_unit(int nM, int nN, int G, int c, int i, int& pm, int& pn) {
    const int nwg = nM * nN; const long L = (long)i * G + c; if (L >= nwg) return false;
    int wgid = (int)L; { const int q = nwg / NXCD, r = nwg % NXCD, xcd = wgid % NXCD, off = wgid / NXCD; wgid = (xcd < r ? xcd * (q + 1) : r * (q + 1) + (xcd - r) * q) + off; }
    const int nig = WGM * nN, gid = wgid / nig, fm = gid * WGM, gsz = (nM - fm) < WGM ? (nM - fm) : WGM;
    pm = fm + ((wgid % nig) % gsz); pn = (wgid % nig) / gsz; return true;
}

__device__ __forceinline__ unsigned cvt_pk_bf16(float lo, float hi) { unsigned r; asm volatile("v_cvt_pk_bf16_f32 %0, %1, %2" : "=v"(r) : "v"(lo), "v"(hi)); return r; }

template <class Epi, class Sched>
__device__ __forceinline__ void gemm_phase(LAS unsigned char* lds, const int K_, const int lda, const int ldb, const Sched& S, const Epi& E) {
    int K = K_; asm volatile("" : "+s"(K));
    const int tid = threadIdx.x, wid = __builtin_amdgcn_readfirstlane(tid >> 6), lane = tid & 63, wr = wid >> 2, wc = wid & 3, fr = lane & 15, fq = lane >> 4;
    const int nt = K / BK;
    unsigned voffA[2], voffB[2];
#pragma unroll
    for (int i = 0; i < 2; ++i) { int R, C; stage_rc(tid * 16 + i * 8192, R, C); const int Rb = Epi::PERM ? ((R & ~31) + perm32(R & 31)) : R;
        voffA[i] = (unsigned)(R * lda + C) * 2u; voffB[i] = (unsigned)(Rb * ldb + C) * 2u; }
    const size_t kstep = (size_t)(BK * 2);
    const size_t hstepA = (size_t)HALF * lda * 2, hstepB = (size_t)HALF * ldb * 2;
    const unsigned ldsw = (unsigned)wid * 1024u;
    const int aoff = lds_byte(wr * 64 + fr, fq * 8), boff = lds_byte(wc * 32 + fr, fq * 8);
#define PG8_SA(b, h) (((b) * 2 + (h)) * HTB)
#define PG8_SB(b, h) ((4 + (b) * 2 + (h)) * HTB)
#define PG8_STAGE(bufoff, gbase, voff) do { _Pragma("unroll") for (int _i = 0; _i < 2; ++_i) \
        __builtin_amdgcn_global_load_lds((const GAS unsigned*)((const char*)(gbase) + (voff)[_i]), (LAS unsigned*)(lds + (bufoff) + ldsw + _i * 8192), 16, 0, 0); } while (0)
#define PG8_LDA(dst, b, h) do { _Pragma("unroll") for (int m = 0; m < 4; ++m) _Pragma("unroll") for (int k = 0; k < 2; ++k) dst[m][k] = *(const LAS bf16x8*)(lds + PG8_SA(b, h) + aoff + m * 2048 + k * 1024); } while (0)
#define PG8_LDB(dst, b, h) do { _Pragma("unroll") for (int n = 0; n < 2; ++n) _Pragma("unroll") for (int k = 0; k < 2; ++k) dst[n][k] = *(const LAS bf16x8*)(lds + PG8_SB(b, h) + boff + n * 2048 + k * 1024); } while (0)
#define PG8_MMA(ai, bj, At, Bt) do { __builtin_amdgcn_s_setprio(1); _Pragma("unroll") for (int m = 0; m < 4; ++m) _Pragma("unroll") for (int n = 0; n < 2; ++n) _Pragma("unroll") for (int k = 0; k < 2; ++k) \
        acc[ai][bj][m][n] = __builtin_amdgcn_mfma_f32_16x16x32_bf16(Bt[n][k], At[m][k], acc[ai][bj][m][n], 0, 0, 0); __builtin_amdgcn_s_setprio(0); } while (0)
#define PG8_WAIT_V(n) asm volatile("s_waitcnt vmcnt(" #n ")" ::: "memory")
#define PG8_WAIT_L(n) asm volatile("s_waitcnt lgkmcnt(" #n ")" ::: "memory")
#define PG8_BAR __builtin_amdgcn_s_barrier()
#define PG8_SCHED __builtin_amdgcn_sched_barrier(0)
    Unit cur, nxt; int ui = 0;
    if (!S.next(0, cur)) return;
    f32x4 acc[2][2][4][2];
#pragma unroll
    for (int a = 0; a < 2; ++a)
#pragma unroll
        for (int b = 0; b < 2; ++b)
#pragma unroll
            for (int m = 0; m < 4; ++m)
#pragma unroll
                for (int n = 0; n < 2; ++n) acc[a][b][m][n] = (f32x4){0.f, 0.f, 0.f, 0.f};
    bf16x8 At[4][2], B0[2][2], B1[2][2];
    const char* cA = S.a_ptr(cur); const char* cB = S.b_ptr(cur);
    PG8_STAGE(PG8_SB(0, 0), cB, voffB); PG8_STAGE(PG8_SA(0, 0), cA, voffA); PG8_STAGE(PG8_SB(0, 1), cB + hstepB, voffB); PG8_STAGE(PG8_SA(0, 1), cA + hstepA, voffA);
    if (wr == 1) PG8_BAR;
    PG8_WAIT_V(4); PG8_BAR;
    PG8_STAGE(PG8_SB(1, 0), cB + kstep, voffB); PG8_STAGE(PG8_SA(1, 0), cA + kstep, voffA); PG8_STAGE(PG8_SB(1, 1), cB + hstepB + kstep, voffB);
    PG8_WAIT_V(6); PG8_BAR;
    for (;;) {
        const bool has_next = S.next(ui + 1, nxt);
        const char* nA = has_next ? S.a_ptr(nxt) : cA; const char* nB = has_next ? S.b_ptr(nxt) : cB;
#pragma unroll 1
        for (int t = 0; t < nt; t += 2) {
            const bool last = (t == nt - 2);
            const char* a1 = cA + (size_t)(t + 1) * kstep;
            const char* a2 = last ? nA : cA + (size_t)(t + 2) * kstep; const char* b2 = last ? nB : cB + (size_t)(t + 2) * kstep;
            const char* a3 = a2 + kstep; const char* b3 = b2 + kstep;
            PG8_LDB(B0, 0, 0); PG8_SCHED; PG8_LDA(At, 0, 0); PG8_STAGE(PG8_SA(1, 1), a1 + hstepA, voffA);
            PG8_WAIT_L(8); PG8_BAR; PG8_WAIT_L(0); PG8_MMA(0, 0, At, B0); PG8_BAR; PG8_SCHED;
            PG8_LDB(B1, 0, 1); PG8_STAGE(PG8_SB(0, 0), b2, voffB);
            PG8_BAR; PG8_WAIT_L(0); PG8_MMA(0, 1, At, B1); PG8_BAR;
            PG8_LDA(At, 0, 1); PG8_STAGE(PG8_SA(0, 0), a2, voffA);
            PG8_BAR; PG8_WAIT_L(0); PG8_MMA(1, 0, At, B0); PG8_BAR; PG8_SCHED;
            PG8_STAGE(PG8_SB(0, 1), b2 + hstepB, voffB);
            PG8_WAIT_V(6); PG8_BAR; PG8_MMA(1, 1, At, B1); PG8_BAR;
            PG8_LDB(B0, 1, 0); PG8_SCHED; PG8_LDA(At, 1, 0); PG8_STAGE(PG8_SA(0, 1), a2 + hstepA, voffA);
            PG8_WAIT_L(8); PG8_BAR; PG8_WAIT_L(0); PG8_MMA(0, 0, At, B0); PG8_BAR; PG8_SCHED;
            PG8_LDB(B1, 1, 1); PG8_STAGE(PG8_SB(1, 0), b3, voffB);
            PG8_BAR; PG8_WAIT_L(0); PG8_MMA(0, 1, At, B1); PG8_BAR;
            PG8_LDA(At, 1, 1); PG8_STAGE(PG8_SA(1, 0), a3, voffA);
            PG8_BAR; PG8_WAIT_L(0); PG8_MMA(1, 0, At, B0); PG8_BAR; PG8_SCHED;
            PG8_STAGE(PG8_SB(1, 1), b3 + hstepB, voffB);
            PG8_WAIT_V(6); PG8_BAR; PG8_MMA(1, 1, At, B1); PG8_BAR;
        }
        E(acc, cur, wr, wc, fr, fq);
        if (!has_next) break;
#pragma unroll
        for (int a = 0; a < 2; ++a)
#pragma unroll
            for (int b = 0; b < 2; ++b)
#pragma unroll
                for (int m = 0; m < 4; ++m)
#pragma unroll
                    for (int n = 0; n < 2; ++n) acc[a][b][m][n] = (f32x4){0.f, 0.f, 0.f, 0.f};
        cur = nxt; cA = nA; cB = nB; ++ui;
    }
    PG8_WAIT_V(0);
    if (wr == 0) PG8_BAR;
    PG8_BAR;
#undef PG8_SA
#undef PG8_SB
#undef PG8_STAGE
#undef PG8_LDA
#undef PG8_LDB
#undef PG8_MMA
#undef PG8_WAIT_V
#undef PG8_WAIT_L
#undef PG8_BAR
#undef PG8_SCHED
}
}
using pg8::Unit;
constexpr size_t al256(size_t x) { return (x + 255) & ~(size_t)255; }
constexpr size_t SZ_ACT_BF = (size_t)MROWS * D * 2;
constexpr size_t SZ_ACT_F32 = (size_t)MROWS * D * 4;
constexpr size_t WS_CTL = 0, CTL_BYTES = 65536;
constexpr size_t WS_ZREG = WS_CTL + CTL_BYTES;
constexpr size_t Z_LDN = 0;
constexpr size_t Z_LUP = Z_LDN + (size_t)1024 * 1024 * 2;
constexpr size_t Z_SLOT = Z_LUP + (size_t)6144 * 256 * 2;
constexpr size_t Z_AW = 2 * Z_SLOT;
constexpr size_t ZREG_BYTES = al256(Z_AW + (size_t)4096 * 256 * 2);
constexpr size_t WS_MOD = WS_ZREG + ZREG_BYTES;
constexpr size_t WS_RSTD = WS_MOD + al256((size_t)DEPTH * 3 * 6 * D * 4);
constexpr size_t WS_RES = WS_RSTD + al256((size_t)MROWS * 4);
constexpr size_t WS_VFIRST = WS_RES + SZ_ACT_F32;
constexpr size_t WS_WREG = WS_VFIRST + SZ_ACT_BF;
constexpr size_t WREG_BYTES = (size_t)200 * 1024 * 1024;
constexpr size_t WS_ARENA = WS_WREG + WREG_BYTES;
constexpr size_t ARENA_BYTES = (size_t)1170 * 1000 * 1000;
constexpr size_t WS_END = WS_ARENA + ARENA_BYTES;

constexpr int CW_BAR = 0;
constexpr int CW_MOE = 4096;

constexpr int LDS_MAIN = 139264;
constexpr int LDS_MISC = LDS_MAIN;
constexpr int LDS_BYTES = LDS_MAIN + 256;

struct Args { const float* in[51]; float* out; unsigned char* ws; int ph_lo, ph_hi; };

enum InIdx { I_X = 0, I_C, I_CTX, I_CCTX, I_NORMG, I_ADAW, I_ADAB, I_FINALG, I_RW_MU, I_RW_WRKV, I_RW_WO, I_RW_W0, I_RW_W1, I_RW_W2, I_RW_A0, I_RW_A1, I_RW_A2,
             I_RW_V0, I_RW_V1, I_RW_V2, I_RW_G1, I_RW_G2, I_RW_KK, I_RW_KA, I_RW_RK, I_RW_LNW, I_RW_LNB, I_HY_WIN, I_HY_BIN, I_HY_CW, I_HY_CB, I_HY_FW1, I_HY_FB1,
             I_HY_FW2, I_HY_FB2, I_HY_FW3, I_HY_FB3, I_HY_FW4, I_HY_FREQ, I_HY_SKIP, I_HY_WO, I_HY_BO, I_HG_WIN, I_HG_LB, I_HG_GN, I_HG_WO, I_FFN_W13, I_FFN_W2,
             I_MOE_ROUTER, I_MOE_W13, I_MOE_W2, N_IN };

struct Ctx {
    LAS unsigned char* lds;
    int tid, lane, wave, G, bid;
};

__device__ __forceinline__ void ph_init_res(const Ctx& C, const float* x, const float* ctx, float* res) {
    const size_t nctx4 = (size_t)NCTX * D / 4, n4 = (size_t)MROWS * D / 4;
    const GAS f32x4* c4 = (const GAS f32x4*)ctx; const GAS f32x4* x4 = (const GAS f32x4*)x; GAS f32x4* r4 = (GAS f32x4*)res;
    for (size_t i = (size_t)C.bid * NTHR + C.tid; i < n4; i += (size_t)C.G * NTHR) r4[i] = i < nctx4 ? c4[i] : x4[i - nctx4];
}

__device__ __forceinline__ void ph_adaln(const Ctx& C, const float* c, const float* c_ctx, const float* ada_w, const float* ada_b, float* mod) {
    LAS float* sv = (LAS float*)C.lds;
    LAS float* red = sv + 3 * D;
    for (int i = C.tid; i < 3 * D; i += NTHR) { const int b = i / D, k = i % D; const float v = (b == 0) ? c_ctx[k] : c[(b - 1) * D + k]; sv[i] = siluf_(v); }
    __syncthreads();
    const int NITEM = DEPTH * (6 * D / 64);
    const int col = C.tid & 63, ks = C.tid >> 6;
    for (int it = C.bid; it < NITEM; it += C.G) {
        const int layer = it / (6 * D / 64), cb = it % (6 * D / 64);
        const GAS float* W = (const GAS float*)ada_w + (size_t)layer * D * 6 * D + cb * 64 + col;
        float a0 = 0.f, a1 = 0.f, a2 = 0.f;
#pragma unroll 8
        for (int k = ks * 128; k < ks * 128 + 128; ++k) { const float w = W[(size_t)k * 6 * D]; a0 += sv[k] * w; a1 += sv[D + k] * w; a2 += sv[2 * D + k] * w; }
        red[(ks * 3 + 0) * 64 + col] = a0; red[(ks * 3 + 1) * 64 + col] = a1; red[(ks * 3 + 2) * 64 + col] = a2;
        __syncthreads();
        if (C.tid < 192) { const int b = C.tid / 64, cc = C.tid % 64; float s = 0.f;
#pragma unroll
            for (int q = 0; q < 8; ++q) s += red[(q * 3 + b) * 64 + cc];
            const int n = cb * 64 + cc;
            mod[((size_t)(layer * 3 + b) * 6 * D) + n] = s + ada_b[(size_t)layer * 6 * D + n]; }
        __syncthreads();
    }
}

__device__ __forceinline__ void load_row(const float* row, int lane, f32x4 (&v)[4]) {
    const GAS f32x4* p = (const GAS f32x4*)row + lane;
#pragma unroll
    for (int j = 0; j < 4; ++j) v[j] = p[64 * j];
}
__device__ __forceinline__ float row_rstd(const f32x4 (&v)[4]) {
    float s = 0.f;
#pragma unroll
    for (int j = 0; j < 4; ++j) s += (v[j].x * v[j].x + v[j].y * v[j].y) + (v[j].z * v[j].z + v[j].w * v[j].w);
    return 1.0f / sqrtf(wave_sum(s) * (1.0f / D) + NORM_EPS);
}

__device__ __forceinline__ void ph_rstd(const Ctx& C, const float* res, float* rstd) {
    const int gw = C.bid * NWAVES + C.wave, NGW = C.G * NWAVES;
    for (int r = gw; r < MROWS; r += NGW) { f32x4 v[4]; load_row(res + (size_t)r * D, C.lane, v); const float s = row_rstd(v); if (C.lane == 0) rstd[r] = s; }
}

__device__ __forceinline__ void ph_norm_mod_bf16(const Ctx& C, const float* res, const float* g, const float* modl, int i_shift, int i_scale, bf16_t* hb) {
    const int gw = C.bid * NWAVES + C.wave, NGW = C.G * NWAVES;
    for (int r = gw; r < MROWS; r += NGW) {
        f32x4 v[4]; load_row(res + (size_t)r * D, C.lane, v); const float s = row_rstd(v);
        const int b = row_bidx(r);
        const GAS f32x4* g4 = (const GAS f32x4*)g + C.lane; const GAS f32x4* sh4 = (const GAS f32x4*)(modl + (size_t)(b * 6 + i_shift) * D) + C.lane; const GAS f32x4* sc4 = (const GAS f32x4*)(modl + (size_t)(b * 6 + i_scale) * D) + C.lane;
        GAS v2u* o = (GAS v2u*)(hb + (size_t)r * D) + C.lane;
#pragma unroll
        for (int j = 0; j < 4; ++j) { const f32x4 gg = g4[64 * j], sh = sh4[64 * j], sc = sc4[64 * j];
            const f32x4 h = v[j] * s * gg * (sc + 1.0f) + sh;
            v2u w; w.x = pk2(h.x, h.y); w.y = pk2(h.z, h.w); o[64 * j] = w; }
    }
}

__device__ __forceinline__ void ph_final(const Ctx& C, const float* res, const float* g, float* out) {
    const int gw = C.bid * NWAVES + C.wave, NGW = C.G * NWAVES;
    for (int r = gw; r < NLAT; r += NGW) {
        f32x4 v[4]; load_row(res + (size_t)(NCTX + r) * D, C.lane, v); const float s = row_rstd(v);
        const GAS f32x4* g4 = (const GAS f32x4*)g + C.lane; GAS f32x4* o = (GAS f32x4*)(out + (size_t)r * D) + C.lane;
#pragma unroll
        for (int j = 0; j < 4; ++j) o[64 * j] = v[j] * s * g4[64 * j];
    }
}

struct CvtJob { const float* src; bf16_t* dst; int K, N, sld, ldd, roff, coff, nseg, nstride; };
__device__ __forceinline__ int cvt_items(const CvtJob& j) { return ((j.K + 63) / 64) * ((j.N + 63) / 64); }
__device__ __forceinline__ void cvt_item(const Ctx& C, const CvtJob& j, int item) {
    LAS float* t = (LAS float*)C.lds;
    const int nb = (j.N + 63) / 64, k0 = (item / nb) * 64, n0 = (item % nb) * 64;
    {   const int nn = C.tid & 63, kk0 = C.tid >> 6;
#pragma unroll
        for (int q = 0; q < 8; ++q) { const int kk = kk0 + 8 * q, k = k0 + kk, n = n0 + nn; t[kk * 65 + nn] = (k < j.K && n < j.N) ? ((const GAS float*)j.src)[(size_t)k * j.sld + n] : 0.f; } }
    __syncthreads();
    {   const int kq = C.tid & 15, nn0 = C.tid >> 4;
#pragma unroll
        for (int q = 0; q < 2; ++q) { const int nn = nn0 + 32 * q, n = n0 + nn, k = k0 + 4 * kq;
            if (n < j.N && k < j.K) { const int r = j.roff + (n / j.nseg) * j.nstride + (n % j.nseg);
                v2u w; w.x = pk2(t[(4 * kq + 0) * 65 + nn], t[(4 * kq + 1) * 65 + nn]); w.y = pk2(t[(4 * kq + 2) * 65 + nn], t[(4 * kq + 3) * 65 + nn]);
                *(GAS v2u*)(j.dst + (size_t)r * j.ldd + j.coff + k) = w; } } }
    __syncthreads();
}
template <int NJ> __device__ __forceinline__ void cvt_run(const Ctx& C, const CvtJob (&jobs)[NJ]) {
    int base = 0;
#pragma unroll
    for (int q = 0; q < NJ; ++q) { const int ni = cvt_items(jobs[q]);
        int first = (C.bid - base % C.G + C.G) % C.G;
        for (int it = first; it < ni; it += C.G) cvt_item(C, jobs[q], it);
        base += ni; }
}
struct SchedPlain {
    const bf16_t* A; const bf16_t* Bt; int lda, ldb, nM, nN, G, c;
    __device__ __forceinline__ bool next(int i, Unit& u) const { const bool ok = pg8::static_unit(nM, nN, G, c, i, u.pm, u.pn); u.aux = u.pn; return ok; }
    __device__ __forceinline__ const char* a_ptr(const Unit& u) const { return (const char*)(A + (size_t)u.pm * 256 * lda); }
    __device__ __forceinline__ const char* b_ptr(const Unit& u) const { return (const char*)(Bt + (size_t)u.pn * 256 * ldb); }
};

typedef f32x4 AccT[2][2][4][2];

struct EpiF32RowBias {
    static constexpr bool PERM = false;
    float* Cp; int ldc; const float* rbias;
    __device__ __forceinline__ void operator()(const AccT& acc, const Unit& u, int wr, int wc, int fr, int fq) const {
        const int row0 = u.pm * 256 + wr * 64 + fr, col0 = u.aux * 256 + wc * 32 + 4 * fq;
#pragma unroll
        for (int ai = 0; ai < 2; ++ai)
#pragma unroll
            for (int m = 0; m < 4; ++m) { const int row = row0 + ai * 128 + m * 16; const float b = rbias ? rbias[row] : 0.f; GAS float* rowp = (GAS float*)Cp + (size_t)row * ldc + col0;
#pragma unroll
                for (int bj = 0; bj < 2; ++bj)
#pragma unroll
                    for (int n = 0; n < 2; ++n) *(GAS f32x4*)(rowp + bj * 128 + n * 16) = acc[ai][bj][m][n] + b; }
    }
};

struct EpiRes {
    static constexpr bool PERM = false;
    float* res; const float* modl; int gi; const float* bias;
    __device__ __forceinline__ void operator()(const AccT& acc, const Unit& u, int wr, int wc, int fr, int fq) const {
        const int row0 = u.pm * 256 + wr * 64 + fr, col0 = u.pn * 256 + wc * 32 + 4 * fq;
        const int b = u.pm < 2 ? 0 : (u.pm < 66 ? 1 : 2);
        const GAS float* gate = (const GAS float*)modl + (size_t)(b * 6 + gi) * D;
        f32x4 gv[2][2], bv[2][2];
#pragma unroll
        for (int bj = 0; bj < 2; ++bj)
#pragma unroll
            for (int n = 0; n < 2; ++n) { gv[bj][n] = *(const GAS f32x4*)(gate + col0 + bj * 128 + n * 16); bv[bj][n] = bias ? *(const GAS f32x4*)((const GAS float*)bias + col0 + bj * 128 + n * 16) : (f32x4){0.f, 0.f, 0.f, 0.f}; }
#pragma unroll
        for (int ai = 0; ai < 2; ++ai)
#pragma unroll
            for (int m = 0; m < 4; ++m) { GAS float* rowp = (GAS float*)res + (size_t)(row0 + ai * 128 + m * 16) * D + col0;
#pragma unroll
                for (int bj = 0; bj < 2; ++bj)
#pragma unroll
                    for (int n = 0; n < 2; ++n) { GAS f32x4* p = (GAS f32x4*)(rowp + bj * 128 + n * 16); *p = *p + gv[bj][n] * (acc[ai][bj][m][n] + bv[bj][n]); } }
    }
};

struct EpiSwiGLU {
    static constexpr bool PERM = true;
    bf16_t* O; int ldo;
    __device__ __forceinline__ void operator()(const AccT& acc, const Unit& u, int wr, int wc, int fr, int fq) const {
        const int row0 = u.pm * 256 + wr * 64 + fr, col0 = u.aux * 128 + wc * 32 + 8 * fq;
#pragma unroll
        for (int ai = 0; ai < 2; ++ai)
#pragma unroll
            for (int m = 0; m < 4; ++m) { GAS bf16_t* rowp = (GAS bf16_t*)O + (size_t)(row0 + ai * 128 + m * 16) * ldo + col0;
                float o[8];
#pragma unroll
                for (int n = 0; n < 2; ++n)
#pragma unroll
                    for (int j = 0; j < 4; ++j) { const float g = acc[ai][0][m][n][j], up = acc[ai][1][m][n][j]; o[n * 4 + j] = siluf_(g) * up; }
                v4u w; w.x = pk2(o[0], o[1]); w.y = pk2(o[2], o[3]); w.z = pk2(o[4], o[5]); w.w = pk2(o[6], o[7]);
                *(GAS v4u*)rowp = w; }
    }
};
constexpr int FN = 16384;
constexpr int HY_NPOS = SEQ + CTXL;
__device__ __forceinline__ int pidx(int p) { return p + ((p >> 6) << 2); }
__device__ __forceinline__ f32x2 cmul(f32x2 a, f32x2 b) { return (f32x2){a.x * b.x - a.y * b.y, a.x * b.y + a.y * b.x}; }
__device__ __forceinline__ f32x2 cmulc(f32x2 a, f32x2 b) { return (f32x2){a.x * b.x + a.y * b.y, a.y * b.x - a.x * b.y}; }

#define W16C_ {1.0f, 0.92387953251f, 0.70710678119f, 0.38268343237f, 0.0f, -0.38268343237f, -0.70710678119f, -0.92387953251f}
#define W16S_ {0.0f, -0.38268343237f, -0.70710678119f, -0.92387953251f, -1.0f, -0.92387953251f, -0.70710678119f, -0.38268343237f}

template <bool INV> __device__ __forceinline__ void fft_pass16(LAS f32x2* X, const int S, const int lgS, const int tid) {
    constexpr float wc[8] = W16C_, ws[8] = W16S_;
#pragma unroll 1
    for (int gi = 0; gi < 2; ++gi) {
        const int g = tid + gi * 512, blk = g >> lgS, q = g & (S - 1), base = blk * 16 * S + q;
        f32x2 e[16];
#pragma unroll
        for (int m = 0; m < 16; ++m) e[m] = X[pidx(base + m * S)];
        float sn, cs; sincospif(-(float)q / (8.0f * (float)S), &sn, &cs);
        const f32x2 w1 = (f32x2){cs, sn}, w2 = cmul(w1, w1), w4 = cmul(w2, w2), w8 = cmul(w4, w4);
        if (!INV) {
#pragma unroll
            for (int m = 0; m < 8; ++m) { const f32x2 a = e[m], b = e[m + 8]; e[m] = a + b; e[m + 8] = cmul(a - b, cmul(w1, (f32x2){wc[m], ws[m]})); }
#pragma unroll
            for (int h = 0; h < 16; h += 8)
#pragma unroll
                for (int m = 0; m < 4; ++m) { const f32x2 a = e[h + m], b = e[h + m + 4]; e[h + m] = a + b; e[h + m + 4] = cmul(a - b, cmul(w2, (f32x2){wc[2 * m], ws[2 * m]})); }
#pragma unroll
            for (int h = 0; h < 16; h += 4)
#pragma unroll
                for (int m = 0; m < 2; ++m) { const f32x2 a = e[h + m], b = e[h + m + 2]; e[h + m] = a + b; e[h + m + 2] = cmul(a - b, cmul(w4, (f32x2){wc[4 * m], ws[4 * m]})); }
#pragma unroll
            for (int h = 0; h < 16; h += 2) { const f32x2 a = e[h], b = e[h + 1]; e[h] = a + b; e[h + 1] = cmul(a - b, w8); }
        } else {
#pragma unroll
            for (int h = 0; h < 16; h += 2) { const f32x2 a = e[h], b = cmulc(e[h + 1], w8); e[h] = a + b; e[h + 1] = a - b; }
#pragma unroll
            for (int h = 0; h < 16; h += 4)
#pragma unroll
                for (int m = 0; m < 2; ++m) { const f32x2 a = e[h + m], b = cmulc(e[h + m + 2], cmul(w4, (f32x2){wc[4 * m], ws[4 * m]})); e[h + m] = a + b; e[h + m + 2] = a - b; }
#pragma unroll
            for (int h = 0; h < 16; h += 8)
#pragma unroll
                for (int m = 0; m < 4; ++m) { const f32x2 a = e[h + m], b = cmulc(e[h + m + 4], cmul(w2, (f32x2){wc[2 * m], ws[2 * m]})); e[h + m] = a + b; e[h + m + 4] = a - b; }
#pragma unroll
            for (int m = 0; m < 8; ++m) { const f32x2 a = e[m], b = cmulc(e[m + 8], cmul(w1, (f32x2){wc[m], ws[m]})); e[m] = a + b; e[m + 8] = a - b; }
        }
#pragma unroll
        for (int m = 0; m < 16; ++m) X[pidx(base + m * S)] = e[m];
    }
}
template <bool INV> __device__ __forceinline__ void fft_pass4(LAS f32x2* X, const int tid) {
#pragma unroll 2
    for (int gi = 0; gi < 8; ++gi) {
        const int base = pidx(4 * (tid + gi * 512));
        f32x2 e0 = X[base], e1 = X[base + 1], e2 = X[base + 2], e3 = X[base + 3];
        if (!INV) {
            f32x2 a = e0, b = e2; e0 = a + b; e2 = a - b;
            a = e1; b = e3; e1 = a + b; { const f32x2 d = a - b; e3 = (f32x2){d.y, -d.x}; }
            a = e0; b = e1; e0 = a + b; e1 = a - b;
            a = e2; b = e3; e2 = a + b; e3 = a - b;
        } else {
            f32x2 a = e0, b = e1; e0 = a + b; e1 = a - b;
            a = e2; b = e3; e2 = a + b; e3 = a - b;
            a = e0; b = e2; e0 = a + b; e2 = a - b;
            a = e1; b = (f32x2){-e3.y, e3.x}; e1 = a + b; e3 = a - b;
        }
        X[base] = e0; X[base + 1] = e1; X[base + 2] = e2; X[base + 3] = e3;
    }
}
__device__ __forceinline__ void fft_fwd(LAS f32x2* X, int tid) {
    fft_pass16<false>(X, 1024, 10, tid); __syncthreads(); fft_pass16<false>(X, 64, 6, tid); __syncthreads(); fft_pass16<false>(X, 4, 2, tid); __syncthreads(); fft_pass4<false>(X, tid); __syncthreads();
}
__device__ __forceinline__ void fft_inv(LAS f32x2* X, int tid) {
    fft_pass4<true>(X, tid); __syncthreads(); fft_pass16<true>(X, 4, 2, tid); __syncthreads(); fft_pass16<true>(X, 64, 6, tid); __syncthreads(); fft_pass16<true>(X, 1024, 10, tid); __syncthreads();
}

__device__ __forceinline__ float conv3(const GAS float* seq, int n, int L, float w0, float w1, float w2, float cb) {
    const float p0 = n > 0 ? seq[n - 1] : 0.f, p1 = seq[n], p2 = n < L - 1 ? seq[n + 1] : 0.f;
    return w0 * p0 + w1 * p1 + w2 * p2 + cb;
}

__device__ __forceinline__ void ph_hy_filter_mlp(const Ctx& C, const float* w1, const float* b1, const float* w2, const float* b2, const float* w3, const float* b3, const float* freq, bf16_t* HB) {
    const int gw = C.bid * NWAVES + C.wave, NGW = C.G * NWAVES, j = C.lane;
    const GAS float* W1 = (const GAS float*)w1; const GAS float* W2 = (const GAS float*)w2; const GAS float* W3 = (const GAS float*)w3;
    const float f0 = freq[j], f1 = freq[64 + j], f2 = freq[128 + j], bb1 = b1[j], bb2 = b2[j], bb3 = b3[j];
    for (int p = gw; p < HY_NPOS; p += NGW) {
        const int L = p < SEQ ? SEQ : CTXL; const int pos = p < SEQ ? p : p - SEQ;
        const float fpos = (float)pos, t = fpos / (float)(L - 1);
        const float a = (float)(6.283185307179586 / (double)L) * fpos;
        float z = 0.f;
        if (j == 0) z = t;
        else if (j <= 32) { const int bi = (j - 1) & 15; const float band = 1e-4f + (float)bi * ((15.0f - 1e-4f) / 15.0f); const float ang = a * band; z = (j <= 16) ? cosf(ang) : -sinf(ang); }
        float acc = bb1;
#pragma unroll
        for (int i = 0; i < 33; ++i) acc += __shfl(z, i) * W1[i * 64 + j];
        float h = sinf(f0 * acc);
        acc = bb2;
#pragma unroll 16
        for (int i = 0; i < 64; ++i) acc += __shfl(h, i) * W2[i * 64 + j];
        h = sinf(f1 * acc);
        acc = bb3;
#pragma unroll 16
        for (int i = 0; i < 64; ++i) acc += __shfl(h, i) * W3[i * 64 + j];
        h = sinf(f2 * acc);
        const unsigned hi = f2bf(h); const unsigned lo = f2bf(h - bf2f(hi));
        GAS bf16_t* o = (GAS bf16_t*)HB + (size_t)p * 256;
        o[j] = (bf16_t)hi; o[64 + j] = (bf16_t)lo; o[128 + j] = (bf16_t)hi; o[192 + j] = 0;
    }
}
__device__ __forceinline__ void ph_hy_w4split(const Ctx& C, const float* w4, bf16_t* AW) {
    for (int i = C.bid * NTHR + C.tid; i < 64 * 4096; i += C.G * NTHR) { const int k = i >> 12, n = i & 4095; const float w = w4[i];
        const unsigned hi = f2bf(w), lo = f2bf(w - bf2f(hi)); GAS bf16_t* o = (GAS bf16_t*)AW + (size_t)n * 256;
        o[k] = (bf16_t)hi; o[64 + k] = (bf16_t)hi; o[128 + k] = (bf16_t)lo; o[192 + k] = 0; }
}
struct EpiHyFilt {
    static constexpr bool PERM = false;
    float* F;
    __device__ __forceinline__ void operator()(const AccT& acc, const Unit& u, int wr, int wc, int fr, int fq) const {
        const int row0 = u.pm * 256 + wr * 64 + fr, col0 = u.pn * 256 + wc * 32 + 4 * fq;
        const float d0 = -15.350567286626973f, d1 = -3.0701134573253946f;
#pragma unroll
        for (int ai = 0; ai < 2; ++ai)
#pragma unroll
            for (int m = 0; m < 4; ++m) { const int row = row0 + ai * 128 + m * 16, ch = row & 1023;
                const float ad = fabsf(d0 + (d1 - d0) * ((float)ch / 1023.0f));
                GAS float* rowp = (GAS float*)F + (size_t)row * HY_NPOS + col0;
#pragma unroll
                for (int bj = 0; bj < 2; ++bj)
#pragma unroll
                    for (int n = 0; n < 2; ++n) { const int c0 = col0 + bj * 128 + n * 16; f32x4 o;
#pragma unroll
                        for (int jj = 0; jj < 4; ++jj) { const int p = c0 + jj; const float t = p < SEQ ? (float)p / (float)(SEQ - 1) : (float)(p - SEQ) / (float)(CTXL - 1); o[jj] = acc[ai][bj][m][n][jj] * __expf(-t * ad); }
                        *(GAS f32x4*)(rowp + bj * 128 + n * 16) = o; } }
    }
};

__device__ __forceinline__ void ph_hy_conv(const Ctx& C, const float* PROJT, const float* FILT, const float* cw, const float* cbias, const float* skip, float* YT, f32x2* SCR) {
    LAS f32x2* X = (LAS f32x2*)C.lds;
    GAS f32x2* U = (GAS f32x2*)SCR + (size_t)C.bid * 3 * FN; GAS f32x2* R1 = U + FN; GAS f32x2* KS = U + 2 * FN;
    const int tid = C.tid;
    for (int ch = C.bid; ch < D; ch += C.G) {
        const GAS float* px1 = (const GAS float*)PROJT + (size_t)ch * MROWS; const GAS float* px2 = (const GAS float*)PROJT + (size_t)(D + ch) * MROWS; const GAS float* pv = (const GAS float*)PROJT + (size_t)(2 * D + ch) * MROWS;
        const float a0 = cw[ch], a1 = cw[3 * D + ch], a2 = cw[6 * D + ch], ab = cbias[ch];
        const float b0 = cw[D + ch], b1 = cw[3 * D + D + ch], b2 = cw[6 * D + D + ch], bb = cbias[D + ch];
        const float v0 = cw[2 * D + ch], v1 = cw[3 * D + 2 * D + ch], v2 = cw[6 * D + 2 * D + ch], vb = cbias[2 * D + ch];
        {   LAS float* gf = (LAS float*)C.lds;
            LAS float* us = gf + 1024;
            LAS float* zs = us + 512;
            for (int i = tid; i < 1024; i += NTHR) gf[i] = ((const GAS float*)FILT)[(size_t)((i >> 8) * D + ch) * HY_NPOS + SEQ + (i & 255)];
            const int b = tid >> 8, t = tid & 255;
            us[tid] = conv3(pv + b * CTXL, t, CTXL, v0, v1, v2, vb);
            __syncthreads();
            float y = skip[ch] * us[tid];
            for (int s = 0; s < CTXL; ++s) { const float g = s <= t ? gf[t - s] : gf[256 + s - t]; y += g * us[b * 256 + s]; }
            zs[tid] = y * conv3(px1 + b * CTXL, t, CTXL, a0, a1, a2, ab);
            __syncthreads();
            float y2 = skip[D + ch] * zs[tid];
            for (int s = 0; s < CTXL; ++s) { const float g = s <= t ? gf[512 + t - s] : gf[768 + s - t]; y2 += g * zs[b * 256 + s]; }
            ((GAS float*)YT)[(size_t)ch * MROWS + b * CTXL + t] = y2 * conv3(px2 + b * CTXL, t, CTXL, b0, b1, b2, bb);
            __syncthreads();
        }
        const GAS float* lv0 = pv + NCTX; const GAS float* lv1 = pv + NCTX + SEQ;
        for (int n = tid; n < FN; n += NTHR) U[n] = (f32x2){conv3(lv0, n, SEQ, v0, v1, v2, vb), conv3(lv1, n, SEQ, v0, v1, v2, vb)};
        for (int o = 0; o < 2; ++o) {
            const GAS float* hf = (const GAS float*)FILT + (size_t)((o * 2 + 0) * D + ch) * HY_NPOS; const GAS float* hb = (const GAS float*)FILT + (size_t)((o * 2 + 1) * D + ch) * HY_NPOS;
            const float sk = skip[o * D + ch];
            for (int n = tid; n < FN; n += NTHR) { const float f = hf[n], r = n ? hb[FN - n] : 0.f; X[pidx(n)] = (f32x2){f + r, 0.f}; }
            __syncthreads(); fft_fwd(X, tid);
            for (int n = tid; n < FN; n += NTHR) KS[n] = X[pidx(n)];
            VM_WAIT(); __syncthreads();
            for (int n = tid; n < FN; n += NTHR) X[pidx(n)] = U[n];
            __syncthreads(); fft_fwd(X, tid);
            for (int n = tid; n < FN; n += NTHR) { const int p = pidx(n); X[p] = cmul(X[p], KS[n]); }
            __syncthreads(); fft_inv(X, tid);
            for (int n = tid; n < FN; n += NTHR) R1[n] = X[pidx(n)];
            __syncthreads();
            for (int n = tid; n < FN; n += NTHR) { const float f = hf[n], r = n ? hb[FN - n] : 0.f; float sn, cs; sincospif(-(float)n * (1.0f / (float)FN), &sn, &cs); const float d = f - r; X[pidx(n)] = (f32x2){d * cs, d * sn}; }
            __syncthreads(); fft_fwd(X, tid);
            for (int n = tid; n < FN; n += NTHR) KS[n] = X[pidx(n)];
            VM_WAIT(); __syncthreads();
            for (int n = tid; n < FN; n += NTHR) { float sn, cs; sincospif(-(float)n * (1.0f / (float)FN), &sn, &cs); X[pidx(n)] = cmul(U[n], (f32x2){cs, sn}); }
            __syncthreads(); fft_fwd(X, tid);
            for (int n = tid; n < FN; n += NTHR) { const int p = pidx(n); X[p] = cmul(X[p], KS[n]); }
            __syncthreads(); fft_inv(X, tid);
            VM_WAIT(); __syncthreads();
            for (int n = tid; n < FN; n += NTHR) {
                float sn, cs; sincospif(-(float)n * (1.0f / (float)FN), &sn, &cs);
                const f32x2 r2 = cmulc(X[pidx(n)], (f32x2){cs, sn}); const f32x2 u = U[n]; const f32x2 r1 = R1[n];
                const f32x2 y = (r1 + r2) * (0.5f / (float)FN) + u * sk;
                if (o == 0) U[n] = (f32x2){y.x * conv3(px1 + NCTX, n, SEQ, a0, a1, a2, ab), y.y * conv3(px1 + NCTX + SEQ, n, SEQ, a0, a1, a2, ab)};
                else { ((GAS float*)YT)[(size_t)ch * MROWS + NCTX + n] = y.x * conv3(px2 + NCTX, n, SEQ, b0, b1, b2, bb); ((GAS float*)YT)[(size_t)ch * MROWS + NCTX + SEQ + n] = y.y * conv3(px2 + NCTX + SEQ, n, SEQ, b0, b1, b2, bb); }
            }
            VM_WAIT(); __syncthreads();
        }
    }
}

__device__ __forceinline__ void ph_hy_transpose(const Ctx& C, const float* YT, bf16_t* YB) {
    LAS float* t = (LAS float*)C.lds;
    const int NIT = (D / 64) * (MROWS / 64);
    for (int it = C.bid; it < NIT; it += C.G) {
        const int c0 = (it % (D / 64)) * 64, t0 = (it / (D / 64)) * 64;
        {   const int tt = C.tid & 63, cc0 = C.tid >> 6;
#pragma unroll
            for (int q = 0; q < 8; ++q) { const int cc = cc0 + 8 * q; t[cc * 65 + tt] = ((const GAS float*)YT)[(size_t)(c0 + cc) * MROWS + t0 + tt]; } }
        __syncthreads();
        {   const int cq = C.tid & 15, tt0 = C.tid >> 4;
#pragma unroll
            for (int q = 0; q < 2; ++q) { const int tt = tt0 + 32 * q; v2u w; w.x = pk2(t[(4 * cq + 0) * 65 + tt], t[(4 * cq + 1) * 65 + tt]); w.y = pk2(t[(4 * cq + 2) * 65 + tt], t[(4 * cq + 3) * 65 + tt]);
                *(GAS v2u*)((GAS bf16_t*)YB + (size_t)(t0 + tt) * D + c0 + 4 * cq) = w; } }
        __syncthreads();
    }
}
constexpr int RW_H = 16, RW_N = 64;
constexpr int NSTEP = CTXL + SEQ;

__device__ __forceinline__ void ph_rw_mix(const Ctx& C, const float* res, const float* rstd, const float* g, const float* modl, const float* mu, bf16_t* X6) {
    const int gw = C.bid * NWAVES + C.wave, NGW = C.G * NWAVES, lane = C.lane;
    for (int r = gw; r < MROWS; r += NGW) {
        int nb[4]; bool ok[4];
        if (r < NCTX) { const int t = r & 255; nb[0] = nb[1] = r - 1; ok[0] = ok[1] = t > 0; nb[2] = nb[3] = r + 1; ok[2] = ok[3] = t < 255; }
        else { const int l = (r - NCTX) & (SEQ - 1), gy = l >> 6, gx = l & 63; nb[0] = r - 1; ok[0] = gx > 0; nb[1] = r + 1; ok[1] = gx < 63; nb[2] = r - 64; ok[2] = gy > 0; nb[3] = r + 64; ok[3] = gy < 255; }
        const int b = row_bidx(r);
        const float so = rstd[r];
        const GAS f32x4* own = (const GAS f32x4*)(res + (size_t)r * D) + lane;
        const GAS f32x4* g4 = (const GAS f32x4*)g + lane; const GAS f32x4* sh4 = (const GAS f32x4*)(modl + (size_t)(b * 6 + 0) * D) + lane; const GAS f32x4* sc4 = (const GAS f32x4*)(modl + (size_t)(b * 6 + 1) * D) + lane;
#pragma unroll
        for (int j = 0; j < 4; ++j) {
            const f32x4 gg = g4[64 * j] * (sc4[64 * j] + 1.0f), sh = sh4[64 * j];
            const f32x4 ho = own[64 * j] * so * gg + sh;
            f32x4 hn = (f32x4){0.f, 0.f, 0.f, 0.f};
            if (ok[j]) { const float sn = rstd[nb[j]]; hn = ((const GAS f32x4*)(res + (size_t)nb[j] * D) + lane)[64 * j] * sn * gg + sh; }
            const f32x4 xx = hn - ho;
#pragma unroll
            for (int m = 0; m < 6; ++m) { const f32x4 mm = ((const GAS f32x4*)(mu + (size_t)m * D) + lane)[64 * j]; const f32x4 x = ho + xx * mm;
                v2u w; w.x = pk2(x.x, x.y); w.y = pk2(x.z, x.w); ((GAS v2u*)(X6 + ((size_t)m * MROWS + r) * D) + lane)[64 * j] = w; }
        }
    }
}

struct SchedRw1 {
    const bf16_t* X6; const bf16_t* Wrkv; const bf16_t* Ldn; int nN, G, c;
    __device__ __forceinline__ bool next(int i, Unit& u) const { const bool ok = pg8::static_unit(PMT, nN, G, c, i, u.pm, u.pn); u.aux = 0; return ok; }
    __device__ __forceinline__ const char* a_ptr(const Unit& u) const { const int am = u.pn < 4 ? 0 : u.pn < 8 ? 2 : u.pn < 12 ? 3 : u.pn == 12 ? 1 : u.pn == 13 ? 4 : u.pn == 14 ? 5 : 3;
        return (const char*)(X6 + ((size_t)am * MROWS + (size_t)u.pm * 256) * D); }
    __device__ __forceinline__ const char* b_ptr(const Unit& u) const { return u.pn < 12 ? (const char*)(Wrkv + (size_t)u.pn * 256 * D) : (const char*)(Ldn + (size_t)(u.pn - 12) * 256 * D); }
};
__device__ __forceinline__ float act_sel(float x, int act) { const float e = __expf(act == 1 ? 2.0f * x : -x); const float t = 1.0f - 2.0f / (e + 1.0f), s = 1.0f / (1.0f + e); return act == 1 ? t : (act == 2 ? s : x); }
struct EpiRw1 {
    static constexpr bool PERM = true;
    bf16_t* Rb; bf16_t* Kb; bf16_t* Vb; bf16_t* LD;
    __device__ __forceinline__ void operator()(const AccT& acc, const Unit& u, int wr, int wc, int fr, int fq) const {
        const int row0 = u.pm * 256 + wr * 64 + fr;
        const int grp = u.pn >> 2;
        const size_t doff = (size_t)(grp == 0) * (size_t)Rb + (size_t)(grp == 1) * (size_t)Kb + (size_t)(grp == 2) * (size_t)Vb + (size_t)(grp == 3) * (size_t)LD;
        bf16_t* dst = (bf16_t*)doff;
        const int colt = (u.pn & 3) * 256; const int act = (u.pn == 12) ? 1 : ((u.pn == 14) ? 2 : 0);
        const int col0 = colt + wc * 32 + 8 * fq;
        if (act == 0) {
#pragma unroll
            for (int ai = 0; ai < 2; ++ai)
#pragma unroll
                for (int m = 0; m < 4; ++m) { GAS bf16_t* rowp = (GAS bf16_t*)dst + (size_t)(row0 + ai * 128 + m * 16) * D + col0;
#pragma unroll
                    for (int bj = 0; bj < 2; ++bj) { const f32x4 p = acc[ai][bj][m][0], q = acc[ai][bj][m][1];
                        v4u w; w.x = pk2(p[0], p[1]); w.y = pk2(p[2], p[3]); w.z = pk2(q[0], q[1]); w.w = pk2(q[2], q[3]);
                        *(GAS v4u*)(rowp + bj * 128) = w; } }
        } else {
#pragma unroll
            for (int ai = 0; ai < 2; ++ai)
#pragma unroll
                for (int m = 0; m < 4; ++m) { GAS bf16_t* rowp = (GAS bf16_t*)dst + (size_t)(row0 + ai * 128 + m * 16) * D + col0;
#pragma unroll
                    for (int bj = 0; bj < 2; ++bj) { const f32x4 p = acc[ai][bj][m][0], q = acc[ai][bj][m][1];
                        v4u w; w.x = pk2(act_sel(p[0], act), act_sel(p[1], act)); w.y = pk2(act_sel(p[2], act), act_sel(p[3], act)); w.z = pk2(act_sel(q[0], act), act_sel(q[1], act)); w.w = pk2(act_sel(q[2], act), act_sel(q[3], act));
                        *(GAS v4u*)(rowp + bj * 128) = w; } }
        }
    }
};

struct SchedRw2 {
    const bf16_t* LD; const bf16_t* Lup; int nN, G, c;
    __device__ __forceinline__ bool next(int i, Unit& u) const { const bool ok = pg8::static_unit(PMT, nN, G, c, i, u.pm, u.pn); u.aux = 0; return ok; }
    __device__ __forceinline__ const char* a_ptr(const Unit& u) const { const int grp = u.pn < 8 ? 0 : u.pn < 16 ? 1 : u.pn < 20 ? 2 : 3; return (const char*)(LD + (size_t)u.pm * 256 * D + grp * 256); }
    __device__ __forceinline__ const char* b_ptr(const Unit& u) const { return (const char*)(Lup + (size_t)u.pn * 256 * 256); }
};
struct EpiRw2 {
    static constexpr bool PERM = false;
    float* DEC; bf16_t* ASIG; bf16_t* Gb; bf16_t* Vb; const bf16_t* VF; const float* w0; const float* a0; const float* v0;
    __device__ __forceinline__ void operator()(const AccT& acc, const Unit& u, int wr, int wc, int fr, int fq) const {
        const int row0 = u.pm * 256 + wr * 64 + fr;
        const int pn = u.pn, colt = (pn & 3) * 256 + wc * 32 + 4 * fq;
        const GAS float* cbp = pn < 8 ? (const GAS float*)w0 + (pn >> 2) * D : (pn < 16 ? (const GAS float*)a0 + ((pn - 8) >> 2) * D : (const GAS float*)v0);
        const float cbs = (pn >= 16 && pn < 20) ? 0.f : 1.f;
        const int mode = pn < 8 ? 0 : (pn < 16 ? 1 : (pn < 20 ? 2 : 3));
        const size_t dsel = (size_t)((pn < 8 ? pn : pn - 8) >> 2) * MROWS;
#pragma unroll
        for (int ai = 0; ai < 2; ++ai)
#pragma unroll
            for (int m = 0; m < 4; ++m) { const size_t row = (size_t)(row0 + ai * 128 + m * 16);
#pragma unroll
                for (int bj = 0; bj < 2; ++bj)
#pragma unroll
                    for (int n = 0; n < 2; ++n) { const int col = colt + bj * 128 + n * 16;
                        const f32x4 x = acc[ai][bj][m][n] + *(const GAS f32x4*)(cbp + col) * cbs;
                        if (mode == 0) { f32x4 o;
#pragma unroll
                            for (int j = 0; j < 4; ++j) { const float z = -x[j]; const float sp = z > 20.f ? z : __logf(1.0f + __expf(z)); o[j] = -__expf(-sp - 0.5f); }
                            *(GAS f32x4*)((GAS float*)DEC + (dsel + row) * D + col) = o; }
                        else if (mode == 1) { v2u w; w.x = pk2(sigmoidf_(x[0]), sigmoidf_(x[1])); w.y = pk2(sigmoidf_(x[2]), sigmoidf_(x[3]));
                            *(GAS v2u*)((GAS bf16_t*)ASIG + (dsel + row) * D + col) = w; }
                        else if (mode == 2) { v2u w; w.x = pk2(x[0], x[1]); w.y = pk2(x[2], x[3]); *(GAS v2u*)((GAS bf16_t*)Gb + row * D + col) = w; }
                        else { GAS v2u* vp = (GAS v2u*)((GAS bf16_t*)Vb + row * D + col); const v2u vv = *vp; const v2u ff = *(const GAS v2u*)((const GAS bf16_t*)VF + row * D + col);
                            const float o0 = bflo(vv.x) + (bflo(ff.x) - bflo(vv.x)) * sigmoidf_(x[0]), o1 = bfhi(vv.x) + (bfhi(ff.x) - bfhi(vv.x)) * sigmoidf_(x[1]);
                            const float o2 = bflo(vv.y) + (bflo(ff.y) - bflo(vv.y)) * sigmoidf_(x[2]), o3 = bfhi(vv.y) + (bfhi(ff.y) - bfhi(vv.y)) * sigmoidf_(x[3]);
                            v2u w; w.x = pk2(o0, o1); w.y = pk2(o2, o3); *vp = w; } }
                asm volatile("" ::: "memory"); }
    }
};

__device__ __forceinline__ int rw_step_row(int d, int b, int s) {
    if (s < CTXL) return b * CTXL + (d == 0 ? s : CTXL - 1 - s);
    const int l = s - CTXL; return NCTX + b * SEQ + (d == 0 ? l : SEQ - 1 - l);
}
__device__ __forceinline__ float dpp_xor1(float v) { return __builtin_bit_cast(float, __builtin_amdgcn_update_dpp(0, __builtin_bit_cast(int, v), 0xB1, 0xf, 0xf, false)); }
__device__ __forceinline__ float dpp_xor2(float v) { return __builtin_bit_cast(float, __builtin_amdgcn_update_dpp(0, __builtin_bit_cast(int, v), 0x4E, 0xf, 0xf, false)); }
__device__ __forceinline__ float dpp_hmirror(float v) { return __builtin_bit_cast(float, __builtin_amdgcn_update_dpp(0, __builtin_bit_cast(int, v), 0x141, 0xf, 0xf, false)); }
__device__ __forceinline__ float sum8(float v) { v += dpp_xor1(v); v += dpp_xor2(v); v += dpp_hmirror(v); return v; }

__device__ __forceinline__ void ph_rw_scan_seq(const Ctx& C, const bf16_t* Rb, const bf16_t* Kb, const bf16_t* Vb, const float* DEC, const bf16_t* ASIG, const float* k_k, const float* k_a, const float* r_k, float* Y, float* BON) {
    constexpr int T = 32;
    LAS float* sw = (LAS float*)C.lds;
    LAS float* sa = sw + T * 64; LAS float* sb = sa + T * 64; LAS float* sk = sb + T * 64; LAS float* sr = sk + T * 64; LAS float* sv = sr + T * 64; LAS float* sy = sv + T * 64;
    for (int chain = C.bid; chain < 64; chain += C.G) {
        const int d = chain >> 5, b = (chain >> 4) & 1, h = chain & 15;
        const int v = C.tid >> 3, seg = C.tid & 7;
        float S[8];
#pragma unroll
        for (int j = 0; j < 8; ++j) S[j] = 0.f;
        const int hc = h * 64 + C.lane;
        const float kkw = k_k[hc], kaw = k_a[hc], rkw = r_k[hc];
        for (int s0 = 0; s0 < NSTEP; s0 += T) {
            for (int tt = C.wave; tt < T; tt += NWAVES) {
                const int row = rw_step_row(d, b, s0 + tt); const size_t o = (size_t)row * D + hc;
                const float kx = bf2f(((const GAS bf16_t*)Kb)[o]), rx = bf2f(((const GAS bf16_t*)Rb)[o]), vx = bf2f(((const GAS bf16_t*)Vb)[o]);
                const float lw = ((const GAS float*)DEC)[(size_t)d * MROWS * D + o], as = bf2f(((const GAS bf16_t*)ASIG)[(size_t)d * MROWS * D + o]);
                const float kk = kx * kkw; const float nrm = sqrtf(wave_sum(kk * kk)); const float kkn = kk / fmaxf(nrm, 1e-12f);
                const float kd = kx * (1.0f + (as - 1.0f) * kaw);
                const float bon = wave_sum(rx * kd * rkw);
                if (C.lane == 0) BON[((size_t)d * MROWS + row) * RW_H + h] = bon;
                const int li = tt * 64 + C.lane;
                sw[li] = __expf(lw); sa[li] = -kkn; sb[li] = kkn * as; sk[li] = kd; sr[li] = rx; sv[li] = vx;
            }
            __syncthreads();
#pragma unroll 2
            for (int tt = 0; tt < T; ++tt) {
                const LAS f32x4* pw = (const LAS f32x4*)(sw + tt * 64 + seg * 8); const LAS f32x4* pa = (const LAS f32x4*)(sa + tt * 64 + seg * 8); const LAS f32x4* pb = (const LAS f32x4*)(sb + tt * 64 + seg * 8);
                const LAS f32x4* pk = (const LAS f32x4*)(sk + tt * 64 + seg * 8); const LAS f32x4* pr = (const LAS f32x4*)(sr + tt * 64 + seg * 8);
                const f32x4 a0 = pa[0], a1 = pa[1], w0 = pw[0], w1 = pw[1], b0 = pb[0], b1 = pb[1], k0 = pk[0], k1 = pk[1], r0 = pr[0], r1 = pr[1];
                const float vv = sv[tt * 64 + v];
                float dot = (S[0] * a0.x + S[1] * a0.y) + (S[2] * a0.z + S[3] * a0.w) + (S[4] * a1.x + S[5] * a1.y) + (S[6] * a1.z + S[7] * a1.w);
                dot = sum8(dot);
                S[0] = S[0] * w0.x + dot * b0.x + vv * k0.x; S[1] = S[1] * w0.y + dot * b0.y + vv * k0.y; S[2] = S[2] * w0.z + dot * b0.z + vv * k0.z; S[3] = S[3] * w0.w + dot * b0.w + vv * k0.w;
                S[4] = S[4] * w1.x + dot * b1.x + vv * k1.x; S[5] = S[5] * w1.y + dot * b1.y + vv * k1.y; S[6] = S[6] * w1.z + dot * b1.z + vv * k1.z; S[7] = S[7] * w1.w + dot * b1.w + vv * k1.w;
                float y = (S[0] * r0.x + S[1] * r0.y) + (S[2] * r0.z + S[3] * r0.w) + (S[4] * r1.x + S[5] * r1.y) + (S[6] * r1.z + S[7] * r1.w);
                y = sum8(y);
                if (seg == 0) sy[tt * 64 + v] = y;
            }
            __syncthreads();
            for (int i = C.tid; i < T * 64; i += NTHR) { const int tt = i >> 6, c = i & 63; const int row = rw_step_row(d, b, s0 + tt); ((GAS float*)Y)[((size_t)d * MROWS + row) * D + h * 64 + c] = sy[i]; }
            __syncthreads();
        }
    }
}

__device__ __forceinline__ void ph_rw_post(const Ctx& C, const float* Y, const float* BON, const bf16_t* Vb, const bf16_t* Gb, const float* lnw, const float* lnb, bf16_t* YB) {
    const int gw = C.bid * NWAVES + C.wave, NGW = C.G * NWAVES, lane = C.lane;
    for (int r = gw; r < MROWS; r += NGW) {
        const GAS f32x4* y0 = (const GAS f32x4*)(Y + (size_t)r * D) + lane; const GAS f32x4* y1 = (const GAS f32x4*)(Y + ((size_t)MROWS + r) * D) + lane;
#pragma unroll
        for (int j = 0; j < 4; ++j) {
            const f32x4 y = y0[64 * j] + y1[64 * j];
            float s = (y.x + y.y) + (y.z + y.w);
            s += __shfl_xor(s, 1); s += __shfl_xor(s, 2); s += __shfl_xor(s, 4); s += __shfl_xor(s, 8);
            const float mean = s * (1.0f / 64.0f); const f32x4 dd = y - mean;
            float q = (dd.x * dd.x + dd.y * dd.y) + (dd.z * dd.z + dd.w * dd.w);
            q += __shfl_xor(q, 1); q += __shfl_xor(q, 2); q += __shfl_xor(q, 4); q += __shfl_xor(q, 8);
            const float rs = 1.0f / sqrtf(q * (1.0f / 64.0f) + 64e-5f);
            const int hd = 4 * j + (lane >> 4);
            const float bon = BON[(size_t)r * RW_H + hd] + BON[((size_t)MROWS + r) * RW_H + hd];
            const f32x4 lw = ((const GAS f32x4*)lnw + lane)[64 * j], lb = ((const GAS f32x4*)lnb + lane)[64 * j];
            const v2u vv = ((const GAS v2u*)(Vb + (size_t)r * D) + lane)[64 * j], gg = ((const GAS v2u*)(Gb + (size_t)r * D) + lane)[64 * j];
            const f32x4 vf = (f32x4){bflo(vv.x), bfhi(vv.x), bflo(vv.y), bfhi(vv.y)}, gf = (f32x4){bflo(gg.x), bfhi(gg.x), bflo(gg.y), bfhi(gg.y)};
            const f32x4 o = (dd * rs * lw + lb + vf * bon) * gf;
            v2u w; w.x = pk2(o.x, o.y); w.y = pk2(o.z, o.w); ((GAS v2u*)(YB + (size_t)r * D) + lane)[64 * j] = w;
        }
    }
}
constexpr int HG_H = 8, HG_DK = 128;
__device__ __forceinline__ void ph_hg_lb(const Ctx& C, const float* hg_lb, int layer, float* LB) {
    for (int i = C.bid * NTHR + C.tid; i < 2 * D; i += C.G * NTHR) {
        float x[DEPTH], mx = -3.0e38f;
#pragma unroll
        for (int l = 0; l < DEPTH; ++l) { x[l] = hg_lb[(size_t)l * 2 * D + i]; mx = fmaxf(mx, x[l]); }
        float den = 0.f, num = 0.f;
#pragma unroll
        for (int l = 0; l < DEPTH; ++l) { const float e = __expf(x[l] - mx); den += e; if (l >= 1 && l <= layer) num += e; }
        LB[i] = num / den;
    }
}
struct EpiHg {
    static constexpr bool PERM = false;
    bf16_t* QVG; float* FG; const float* LB;
    __device__ __forceinline__ void operator()(const AccT& acc, const Unit& u, int wr, int wc, int fr, int fq) const {
        const int row0 = u.pm * 256 + wr * 64 + fr, grp = u.pn >> 2, colt = (u.pn & 3) * 256 + wc * 32 + 4 * fq;
        const int isf = (grp == 1 || grp == 2) ? 1 : 0, d = grp == 2 ? 1 : 0, bsel = grp == 0 ? 0 : (grp == 3 ? 1 : 2), act = grp != 3;
#pragma unroll
        for (int ai = 0; ai < 2; ++ai)
#pragma unroll
            for (int m = 0; m < 4; ++m) { const size_t row = (size_t)(row0 + ai * 128 + m * 16);
#pragma unroll
                for (int bj = 0; bj < 2; ++bj)
#pragma unroll
                    for (int n = 0; n < 2; ++n) { const int col = colt + bj * 128 + n * 16; const f32x4 x = acc[ai][bj][m][n];
                        if (isf) { const f32x4 lb = *(const GAS f32x4*)((const GAS float*)LB + d * D + col); f32x4 o;
#pragma unroll
                            for (int j = 0; j < 4; ++j) o[j] = lb[j] + (1.0f - lb[j]) * sigmoidf_(x[j]);
                            *(GAS f32x4*)((GAS float*)FG + ((size_t)d * MROWS + row) * D + col) = o; }
                        else { v2u w; if (act) { w.x = pk2(siluf_(x[0]), siluf_(x[1])); w.y = pk2(siluf_(x[2]), siluf_(x[3])); } else { w.x = pk2(x[0], x[1]); w.y = pk2(x[2], x[3]); }
                            *(GAS v2u*)((GAS bf16_t*)QVG + ((size_t)bsel * MROWS + row) * D + col) = w; } }
                asm volatile("" ::: "memory"); }
    }
};
__device__ __forceinline__ void ph_hg_scan_seq(const Ctx& C, const bf16_t* QVG, const float* FG, float* O) {
    constexpr int T = 32;
    LAS float* sf = (LAS float*)C.lds;
    LAS float* sk = sf + T * 128; LAS float* sq = sk + T * 128; LAS float* sv = sq + T * 128; LAS float* so = sv + T * 64;
    const bf16_t* Qb = QVG; const bf16_t* Vb = QVG + (size_t)MROWS * D;
    for (int item = C.bid; item < 64; item += C.G) {
        const int chain = item >> 1, vh = item & 1, d = chain >> 4, b = (chain >> 3) & 1, h = chain & 7;
        const int v = C.tid >> 3, seg = C.tid & 7;
        float S[16];
#pragma unroll
        for (int j = 0; j < 16; ++j) S[j] = 0.f;
        for (int s0 = 0; s0 < NSTEP; s0 += T) {
            for (int i = C.tid; i < T * 128; i += NTHR) { const int tt = i >> 7, c = i & 127; const int row = rw_step_row(d, b, s0 + tt); const size_t o = (size_t)row * D + h * 128 + c;
                const float f = ((const GAS float*)FG)[(size_t)d * MROWS * D + o]; sf[i] = f; sk[i] = 1.0f - f; sq[i] = bf2f(((const GAS bf16_t*)Qb)[o]);
                if ((c >> 6) == vh) sv[tt * 64 + (c & 63)] = bf2f(((const GAS bf16_t*)Vb)[o]); }
            __syncthreads();
#pragma unroll 2
            for (int tt = 0; tt < T; ++tt) {
                const LAS f32x4* pf = (const LAS f32x4*)(sf + tt * 128 + seg * 16); const LAS f32x4* pk = (const LAS f32x4*)(sk + tt * 128 + seg * 16); const LAS f32x4* pq = (const LAS f32x4*)(sq + tt * 128 + seg * 16);
                const float vv = sv[tt * 64 + v]; float y = 0.f;
#pragma unroll
                for (int jj = 0; jj < 4; ++jj) { const f32x4 f = pf[jj], k = pk[jj], q = pq[jj];
#pragma unroll
                    for (int i = 0; i < 4; ++i) { S[4 * jj + i] = S[4 * jj + i] * f[i] + k[i] * vv; y += S[4 * jj + i] * q[i]; } }
                y = sum8(y);
                if (seg == 0) so[tt * 64 + v] = y;
            }
            __syncthreads();
            for (int i = C.tid; i < T * 64; i += NTHR) { const int tt = i >> 6, c = i & 63; const int row = rw_step_row(d, b, s0 + tt); ((GAS float*)O)[((size_t)d * MROWS + row) * D + h * 128 + vh * 64 + c] = so[i]; }
            __syncthreads();
        }
    }
}
__device__ __forceinline__ void ph_hg_post(const Ctx& C, const float* O, const bf16_t* GS, const float* gn, bf16_t* YB) {
    const int gw = C.bid * NWAVES + C.wave, NGW = C.G * NWAVES, lane = C.lane;
    for (int r = gw; r < MROWS; r += NGW) {
        const GAS f32x4* o0 = (const GAS f32x4*)(O + (size_t)r * D) + lane; const GAS f32x4* o1 = (const GAS f32x4*)(O + ((size_t)MROWS + r) * D) + lane;
#pragma unroll
        for (int j = 0; j < 4; ++j) {
            const f32x4 y = o0[64 * j] + o1[64 * j];
            float q = (y.x * y.x + y.y * y.y) + (y.z * y.z + y.w * y.w);
            q += __shfl_xor(q, 1); q += __shfl_xor(q, 2); q += __shfl_xor(q, 4); q += __shfl_xor(q, 8); q += __shfl_xor(q, 16);
            const float rs = 1.0f / sqrtf(q * (1.0f / 128.0f) + NORM_EPS);
            const f32x4 gw4 = ((const GAS f32x4*)gn)[(lane & 31)];
            const v2u gg = ((const GAS v2u*)(GS + (size_t)r * D) + lane)[64 * j];
            const f32x4 gf = (f32x4){bflo(gg.x), bfhi(gg.x), bflo(gg.y), bfhi(gg.y)};
            const f32x4 o = y * rs * gw4 * gf;
            v2u w; w.x = pk2(o.x, o.y); w.y = pk2(o.z, o.w); ((GAS v2u*)(YB + (size_t)r * D) + lane)[64 * j] = w;
        }
    }
}
constexpr int MOE_MAXROWS = 68608;
constexpr int MOE_MAXT = MOE_MAXROWS / 256;

__device__ __forceinline__ void ph_moe_route(const Ctx& C, const float* res, const float* g, const float* modl, const float* router, bf16_t* H2, int* TOKE, float* TOKG, int* BCNT) {
    LAS float* rt = (LAS float*)C.lds;
    LAS int* cnt = (LAS int*)(rt + D * NEXP);
    for (int i = C.tid; i < D * NEXP; i += NTHR) rt[i] = router[i];
    if (C.tid < NEXP) cnt[C.tid] = 0;
    __syncthreads();
    const int gw = C.bid * NWAVES + C.wave, NGW = C.G * NWAVES, lane = C.lane;
    for (int r = gw; r < MROWS; r += NGW) {
        f32x4 v[4]; load_row(res + (size_t)r * D, lane, v); const float s = row_rstd(v);
        const int b = row_bidx(r);
        const GAS f32x4* g4 = (const GAS f32x4*)g + lane; const GAS f32x4* sh4 = (const GAS f32x4*)(modl + (size_t)(b * 6 + 3) * D) + lane; const GAS f32x4* sc4 = (const GAS f32x4*)(modl + (size_t)(b * 6 + 4) * D) + lane;
        GAS v2u* o = (GAS v2u*)(H2 + (size_t)r * D) + lane;
        float lg[NEXP];
#pragma unroll
        for (int e = 0; e < NEXP; ++e) lg[e] = 0.f;
#pragma unroll
        for (int j = 0; j < 4; ++j) { const f32x4 h = v[j] * s * g4[64 * j] * (sc4[64 * j] + 1.0f) + sh4[64 * j];
            v2u w; w.x = pk2(h.x, h.y); w.y = pk2(h.z, h.w); o[64 * j] = w;
#pragma unroll
            for (int i = 0; i < 4; ++i) { const LAS f32x4* rr = (const LAS f32x4*)(rt + (size_t)(256 * j + 4 * lane + i) * NEXP); const f32x4 r0 = rr[0], r1 = rr[1]; const float hv = h[i];
                lg[0] += hv * r0.x; lg[1] += hv * r0.y; lg[2] += hv * r0.z; lg[3] += hv * r0.w; lg[4] += hv * r1.x; lg[5] += hv * r1.y; lg[6] += hv * r1.z; lg[7] += hv * r1.w; } }
#pragma unroll
        for (int e = 0; e < NEXP; ++e) lg[e] = wave_sum(lg[e]);
        int i0 = 0; float l0 = lg[0];
#pragma unroll
        for (int e = 1; e < NEXP; ++e) if (lg[e] > l0) { l0 = lg[e]; i0 = e; }
        int i1 = -1; float l1 = -3.0e38f;
#pragma unroll
        for (int e = 0; e < NEXP; ++e) if (e != i0 && lg[e] > l1) { l1 = lg[e]; i1 = e; }
        const float g0 = 1.0f / (1.0f + __expf(l1 - l0));
        if (lane == 0) { TOKE[2 * r] = i0; TOKE[2 * r + 1] = i1; TOKG[2 * r] = g0; TOKG[2 * r + 1] = 1.0f - g0; __hip_atomic_fetch_add(&cnt[i0], 1, __ATOMIC_RELAXED, __HIP_MEMORY_SCOPE_WORKGROUP); __hip_atomic_fetch_add(&cnt[i1], 1, __ATOMIC_RELAXED, __HIP_MEMORY_SCOPE_WORKGROUP); }
    }
    __syncthreads();
    if (C.tid < NEXP) BCNT[C.bid * NEXP + C.tid] = cnt[C.tid];
    __syncthreads();
}
__device__ __forceinline__ void ph_moe_scatter(const Ctx& C, const bf16_t* H2, const int* TOKE, const int* BCNT, int* DEST, int* TILE, bf16_t* ABUF) {
    LAS int* cur = (LAS int*)C.lds;
    if (C.tid < NEXP) { int tot = 0, mine = 0; for (int b = 0; b < C.G; ++b) { const int c = BCNT[b * NEXP + C.tid]; tot += c; mine += (b < C.bid) ? c : 0; } cur[16 + C.tid] = tot; cur[24 + C.tid] = mine; }
    __syncthreads();
    if (C.tid == 0) { int st = 0; for (int e = 0; e < NEXP; ++e) { const int nt = (cur[16 + e] + 255) >> 8; cur[8 + e] = st; cur[e] = st * 256 + cur[24 + e]; if (C.bid == 0) for (int q = 0; q < nt; ++q) TILE[st + q] = e; st += nt; } if (C.bid == 0) TILE[MOE_MAXT] = st; }
    __syncthreads();
    const int gw = C.bid * NWAVES + C.wave, NGW = C.G * NWAVES, lane = C.lane;
    for (int r = gw; r < MROWS; r += NGW) {
        int p0 = 0, p1 = 0;
        if (lane == 0) { p0 = __hip_atomic_fetch_add(&cur[TOKE[2 * r]], 1, __ATOMIC_RELAXED, __HIP_MEMORY_SCOPE_WORKGROUP); p1 = __hip_atomic_fetch_add(&cur[TOKE[2 * r + 1]], 1, __ATOMIC_RELAXED, __HIP_MEMORY_SCOPE_WORKGROUP); DEST[2 * r] = p0; DEST[2 * r + 1] = p1; }
        p0 = __shfl(p0, 0); p1 = __shfl(p1, 0);
        const GAS v4u* src = (const GAS v4u*)(H2 + (size_t)r * D) + lane; const v4u a = src[0], b = src[64];
        GAS v4u* d0 = (GAS v4u*)(ABUF + (size_t)p0 * D) + lane; GAS v4u* d1 = (GAS v4u*)(ABUF + (size_t)p1 * D) + lane;
        d0[0] = a; d0[64] = b; d1[0] = a; d1[64] = b;
    }
}
struct SchedMoe {
    const bf16_t* A; const bf16_t* Bt; const int* TILE; int lda, ldb, npl  , G, c;
    __device__ __forceinline__ bool next(int i, Unit& u) const { const int nt = TILE[MOE_MAXT]; const long L = (long)i * G + c; if (L >= (long)nt * npl) return false;
        u.pm = (int)(L / npl); u.aux = (int)(L % npl); u.pn = TILE[u.pm] * npl + u.aux; return true; }
    __device__ __forceinline__ const char* a_ptr(const Unit& u) const { return (const char*)(A + (size_t)u.pm * 256 * lda); }
    __device__ __forceinline__ const char* b_ptr(const Unit& u) const { return (const char*)(Bt + (size_t)u.pn * 256 * ldb); }
};
__device__ __forceinline__ void ph_moe_combine(const Ctx& C, float* res, const float* modl, const float* OUT, const int* DEST, const float* TOKG) {
    const int gw = C.bid * NWAVES + C.wave, NGW = C.G * NWAVES, lane = C.lane;
    for (int r = gw; r < MROWS; r += NGW) {
        const int d0 = DEST[2 * r], d1 = DEST[2 * r + 1]; const float g0 = TOKG[2 * r], g1 = TOKG[2 * r + 1]; const int b = row_bidx(r);
        const GAS f32x4* o0 = (const GAS f32x4*)(OUT + (size_t)d0 * D) + lane; const GAS f32x4* o1 = (const GAS f32x4*)(OUT + (size_t)d1 * D) + lane;
        const GAS f32x4* gt = (const GAS f32x4*)(modl + (size_t)(b * 6 + 5) * D) + lane; GAS f32x4* rp = (GAS f32x4*)(res + (size_t)r * D) + lane;
#pragma unroll
        for (int j = 0; j < 4; ++j) rp[64 * j] = rp[64 * j] + gt[64 * j] * (o0[64 * j] * g0 + o1[64 * j] * g1);
    }
}
constexpr size_t HY_H = 0;
constexpr size_t HY_PROJT = al256(HY_H + SZ_ACT_BF);
constexpr size_t HY_HB = al256(HY_PROJT + (size_t)3 * D * MROWS * 4);
constexpr size_t HY_FILT = al256(HY_HB + (size_t)HY_NPOS * 256 * 2);
constexpr size_t HY_YT = al256(HY_FILT + (size_t)4096 * HY_NPOS * 4);
constexpr size_t HY_YB = al256(HY_YT + (size_t)D * MROWS * 4);
constexpr size_t HY_SCR = al256(HY_YB + SZ_ACT_BF);
constexpr size_t HY_END = HY_SCR + (size_t)256 * 3 * FN * 8;
static_assert(HY_END <= ARENA_BYTES, "hyena arena");
constexpr size_t HYW_WIN = 0, HYW_WO = (size_t)3 * D * D * 2;

__device__ __forceinline__ void hy_phase_a(const Ctx& C, const Args& args, unsigned char* ws, int layer) {
    bf16_t* WinT = (bf16_t*)(ws + WS_WREG + HYW_WIN); bf16_t* WoT = (bf16_t*)(ws + WS_WREG + HYW_WO);
    const CvtJob jobs[2] = { {args.in[I_HY_WIN], WinT, D, 3 * D, 3 * D, D, 0, 0, 3 * D, 0}, {args.in[I_HY_WO], WoT, D, D, D, D, 0, 0, D, 0} };
    cvt_run(C, jobs);
    ph_hy_w4split(C, args.in[I_HY_FW4], (bf16_t*)(ws + WS_ZREG + Z_AW));
    ph_hy_filter_mlp(C, args.in[I_HY_FW1], args.in[I_HY_FB1], args.in[I_HY_FW2], args.in[I_HY_FB2], args.in[I_HY_FW3], args.in[I_HY_FB3], args.in[I_HY_FREQ], (bf16_t*)(ws + WS_ARENA + HY_HB));
    ph_norm_mod_bf16(C, (const float*)(ws + WS_RES), args.in[I_NORMG] + (size_t)(layer * 2 + 0) * D, (const float*)(ws + WS_MOD) + (size_t)layer * 18 * D, 0, 1, (bf16_t*)(ws + WS_ARENA + HY_H));
}
__device__ __forceinline__ void hy_phase_b(const Ctx& C, const Args& args, unsigned char* ws) {
    {   SchedPlain S{(const bf16_t*)(ws + WS_WREG + HYW_WIN), (const bf16_t*)(ws + WS_ARENA + HY_H), D, D, 3 * D / 256, PMT, C.G, C.bid};
        EpiF32RowBias E{(float*)(ws + WS_ARENA + HY_PROJT), MROWS, args.in[I_HY_BIN]};
        pg8::gemm_phase(C.lds, D, D, D, S, E); }
    {   SchedPlain S{(const bf16_t*)(ws + WS_ZREG + Z_AW), (const bf16_t*)(ws + WS_ARENA + HY_HB), 256, 256, 4096 / 256, HY_NPOS / 256, C.G, C.bid};
        EpiHyFilt E{(float*)(ws + WS_ARENA + HY_FILT)};
        pg8::gemm_phase(C.lds, 256, 256, 256, S, E); }
}
__device__ __forceinline__ void hy_phase_wo(const Ctx& C, const Args& args, unsigned char* ws, int layer) {
    SchedPlain S{(const bf16_t*)(ws + WS_ARENA + HY_YB), (const bf16_t*)(ws + WS_WREG + HYW_WO), D, D, PMT, D / 256, C.G, C.bid};
    EpiRes E{(float*)(ws + WS_RES), (const float*)(ws + WS_MOD) + (size_t)layer * 18 * D, 2, args.in[I_HY_BO]};
    pg8::gemm_phase(C.lds, D, D, D, S, E);
}

constexpr size_t RW_X6 = 0;
constexpr size_t RW_Y = 0;
constexpr size_t RW_YB = al256(RW_Y + 2 * SZ_ACT_F32);
constexpr size_t RW_RKV = al256(RW_X6 + 6 * SZ_ACT_BF);
constexpr size_t RW_LD = al256(RW_RKV + 3 * SZ_ACT_BF);
constexpr size_t RW_DEC = al256(RW_LD + SZ_ACT_BF);
constexpr size_t RW_ASIG = al256(RW_DEC + 2 * SZ_ACT_F32);
constexpr size_t RW_G = al256(RW_ASIG + 2 * SZ_ACT_BF);
constexpr size_t RW_BON = al256(RW_G + SZ_ACT_BF);
constexpr size_t RW_END = RW_BON + (size_t)2 * MROWS * RW_H * 4;
static_assert(RW_YB + SZ_ACT_BF <= RW_RKV && RW_END <= ARENA_BYTES, "rwkv arena");
constexpr size_t RWW_RKV = 0, RWW_WO = (size_t)3 * D * D * 2;

struct RwP { int layer, slot; };
__device__ __forceinline__ bf16_t* rw_vbuf(unsigned char* ws, int slot) { return slot == 0 ? (bf16_t*)(ws + WS_VFIRST) : (bf16_t*)(ws + WS_ARENA + RW_RKV + 2 * SZ_ACT_BF); }

__device__ __forceinline__ void rw_phase_a(const Ctx& C, const Args& args, unsigned char* ws, int layer, int slot) {
    bf16_t* Wrkv = (bf16_t*)(ws + WS_WREG + RWW_RKV); bf16_t* WoT = (bf16_t*)(ws + WS_WREG + RWW_WO);
    bf16_t* Ldn = (bf16_t*)(ws + WS_ZREG + slot * Z_SLOT + Z_LDN); bf16_t* Lup = (bf16_t*)(ws + WS_ZREG + slot * Z_SLOT + Z_LUP);
    const float* wrkv = args.in[I_RW_WRKV] + (size_t)slot * 3 * D * D;
    const float* w1 = args.in[I_RW_W1] + (size_t)slot * 2 * D * 64; const float* a1 = args.in[I_RW_A1] + (size_t)slot * 2 * D * 64;
    const float* w2 = args.in[I_RW_W2] + (size_t)slot * 2 * 64 * D; const float* a2 = args.in[I_RW_A2] + (size_t)slot * 2 * 64 * D;
    const CvtJob jobs[14] = {
        {wrkv, Wrkv, D, D, D, D, 0, 0, D, 0}, {wrkv + (size_t)D * D, Wrkv, D, D, D, D, D, 0, D, 0}, {wrkv + (size_t)2 * D * D, Wrkv, D, D, D, D, 2 * D, 0, D, 0},
        {args.in[I_RW_WO] + (size_t)slot * D * D, WoT, D, D, D, D, 0, 0, D, 0},
        {w1, Ldn, D, 64, 64, D, 0, 0, 64, 0}, {w1 + (size_t)D * 64, Ldn, D, 64, 64, D, 64, 0, 64, 0},
        {a1, Ldn, D, 64, 64, D, 256, 0, 64, 0}, {a1 + (size_t)D * 64, Ldn, D, 64, 64, D, 256 + 64, 0, 64, 0},
        {args.in[I_RW_G1] + (size_t)slot * D * 160, Ldn, D, 160, 160, D, 512, 0, 160, 0},
        {w2, Lup, 64, D, D, 256, 0, 0, D, 0}, {w2 + (size_t)64 * D, Lup, 64, D, D, 256, D, 64, D, 0},
        {a2, Lup, 64, D, D, 256, 2 * D, 0, D, 0}, {a2 + (size_t)64 * D, Lup, 64, D, D, 256, 3 * D, 64, D, 0},
        {args.in[I_RW_G2] + (size_t)slot * 160 * D, Lup, 160, D, D, 256, 4 * D, 0, D, 0} };
    cvt_run(C, jobs);
    if (slot > 0) { const CvtJob jv[2] = { {args.in[I_RW_V1] + (size_t)(slot - 1) * D * 32, Ldn, D, 32, 32, D, 768, 0, 32, 0}, {args.in[I_RW_V2] + (size_t)(slot - 1) * 32 * D, Lup, 32, D, D, 256, 5 * D, 0, D, 0} }; cvt_run(C, jv); }
    ph_rstd(C, (const float*)(ws + WS_RES), (float*)(ws + WS_RSTD));
}
__device__ __forceinline__ void rw_phase_mix(const Ctx& C, const Args& args, unsigned char* ws, int layer, int slot) {
    ph_rw_mix(C, (const float*)(ws + WS_RES), (const float*)(ws + WS_RSTD), args.in[I_NORMG] + (size_t)(layer * 2) * D, (const float*)(ws + WS_MOD) + (size_t)layer * 18 * D, args.in[I_RW_MU] + (size_t)slot * 6 * D, (bf16_t*)(ws + WS_ARENA + RW_X6));
}
__device__ __forceinline__ void rw_phase_g1(const Ctx& C, const Args& args, unsigned char* ws, int layer, int slot) {
    SchedRw1 S{(const bf16_t*)(ws + WS_ARENA + RW_X6), (const bf16_t*)(ws + WS_WREG + RWW_RKV), (const bf16_t*)(ws + WS_ZREG + slot * Z_SLOT + Z_LDN), slot > 0 ? 16 : 15, C.G, C.bid};
    EpiRw1 E{(bf16_t*)(ws + WS_ARENA + RW_RKV), (bf16_t*)(ws + WS_ARENA + RW_RKV + SZ_ACT_BF), rw_vbuf(ws, slot), (bf16_t*)(ws + WS_ARENA + RW_LD)};
    pg8::gemm_phase(C.lds, D, D, D, S, E);
}
__device__ __forceinline__ void rw_phase_g2(const Ctx& C, const Args& args, unsigned char* ws, int layer, int slot) {
    SchedRw2 S{(const bf16_t*)(ws + WS_ARENA + RW_LD), (const bf16_t*)(ws + WS_ZREG + slot * Z_SLOT + Z_LUP), slot > 0 ? 24 : 20, C.G, C.bid};
    EpiRw2 E{(float*)(ws + WS_ARENA + RW_DEC), (bf16_t*)(ws + WS_ARENA + RW_ASIG), (bf16_t*)(ws + WS_ARENA + RW_G), rw_vbuf(ws, slot), (const bf16_t*)(ws + WS_VFIRST),
             args.in[I_RW_W0] + (size_t)slot * 2 * D, args.in[I_RW_A0] + (size_t)slot * 2 * D, args.in[I_RW_V0] + (size_t)(slot > 0 ? slot - 1 : 0) * D};
    pg8::gemm_phase(C.lds, 256, D, 256, S, E);
}
__device__ __forceinline__ void rw_phase_scan(const Ctx& C, const Args& args, unsigned char* ws, int layer, int slot) {
    ph_rw_scan_seq(C, (const bf16_t*)(ws + WS_ARENA + RW_RKV), (const bf16_t*)(ws + WS_ARENA + RW_RKV + SZ_ACT_BF), rw_vbuf(ws, slot), (const float*)(ws + WS_ARENA + RW_DEC), (const bf16_t*)(ws + WS_ARENA + RW_ASIG),
                   args.in[I_RW_KK] + (size_t)slot * D, args.in[I_RW_KA] + (size_t)slot * D, args.in[I_RW_RK] + (size_t)slot * D, (float*)(ws + WS_ARENA + RW_Y), (float*)(ws + WS_ARENA + RW_BON));
}
__device__ __forceinline__ void rw_phase_post(const Ctx& C, const Args& args, unsigned char* ws, int layer, int slot) {
    ph_rw_post(C, (const float*)(ws + WS_ARENA + RW_Y), (const float*)(ws + WS_ARENA + RW_BON), rw_vbuf(ws, slot), (const bf16_t*)(ws + WS_ARENA + RW_G), args.in[I_RW_LNW] + (size_t)slot * D, args.in[I_RW_LNB] + (size_t)slot * D, (bf16_t*)(ws + WS_ARENA + RW_YB));
}
__device__ __forceinline__ void rw_phase_wo(const Ctx& C, const Args& args, unsigned char* ws, int layer, int slot) {
    SchedPlain S{(const bf16_t*)(ws + WS_ARENA + RW_YB), (const bf16_t*)(ws + WS_WREG + RWW_WO), D, D, PMT, D / 256, C.G, C.bid};
    EpiRes E{(float*)(ws + WS_RES), (const float*)(ws + WS_MOD) + (size_t)layer * 18 * D, 2, nullptr};
    pg8::gemm_phase(C.lds, D, D, D, S, E);
}

constexpr size_t FF_H2 = 0, FF_ACT = al256(SZ_ACT_BF);
constexpr size_t FFW_13 = 0, FFW_2 = (size_t)2 * FFN * D * 2;
__device__ __forceinline__ void ff_phase_a(const Ctx& C, const Args& args, unsigned char* ws, int layer) {
    const float* w13 = args.in[I_FFN_W13] + (size_t)(layer / 2) * D * 2 * FFN; const float* w2 = args.in[I_FFN_W2] + (size_t)(layer / 2) * FFN * D;
    bf16_t* W13T = (bf16_t*)(ws + WS_WREG + FFW_13); bf16_t* W2T = (bf16_t*)(ws + WS_WREG + FFW_2);
    const CvtJob jobs[3] = { {w13, W13T, D, FFN, 2 * FFN, D, 0, 0, 128, 256}, {w13 + FFN, W13T, D, FFN, 2 * FFN, D, 128, 0, 128, 256}, {w2, W2T, FFN, D, D, FFN, 0, 0, D, 0} };
    cvt_run(C, jobs);
    ph_norm_mod_bf16(C, (const float*)(ws + WS_RES), args.in[I_NORMG] + (size_t)(layer * 2 + 1) * D, (const float*)(ws + WS_MOD) + (size_t)layer * 18 * D, 3, 4, (bf16_t*)(ws + WS_ARENA + FF_H2));
}
__device__ __forceinline__ void ff_phase_g1(const Ctx& C, unsigned char* ws) {
    SchedPlain S{(const bf16_t*)(ws + WS_ARENA + FF_H2), (const bf16_t*)(ws + WS_WREG + FFW_13), D, D, PMT, 2 * FFN / 256, C.G, C.bid};
    EpiSwiGLU E{(bf16_t*)(ws + WS_ARENA + FF_ACT), FFN};
    pg8::gemm_phase(C.lds, D, D, D, S, E);
}
__device__ __forceinline__ void ff_phase_g2(const Ctx& C, unsigned char* ws, int layer) {
    SchedPlain S{(const bf16_t*)(ws + WS_ARENA + FF_ACT), (const bf16_t*)(ws + WS_WREG + FFW_2), FFN, FFN, PMT, D / 256, C.G, C.bid};
    EpiRes E{(float*)(ws + WS_RES), (const float*)(ws + WS_MOD) + (size_t)layer * 18 * D, 5, nullptr};
    pg8::gemm_phase(C.lds, FFN, FFN, FFN, S, E);
}
constexpr size_t MO_H2 = 0;
constexpr size_t MO_ABUF = al256(MO_H2 + SZ_ACT_BF);
constexpr size_t MO_ACT = al256(MO_ABUF + (size_t)MOE_MAXROWS * D * 2);
constexpr size_t MO_OUT = al256(MO_ACT + (size_t)MOE_MAXROWS * EDIM * 2);
constexpr size_t MO_TOKE = al256(MO_OUT + (size_t)MOE_MAXROWS * D * 4);
constexpr size_t MO_TOKG = al256(MO_TOKE + (size_t)MROWS * 8);
constexpr size_t MO_DEST = al256(MO_TOKG + (size_t)MROWS * 8);
constexpr size_t MO_BCNT = al256(MO_DEST + (size_t)MROWS * 8);
constexpr size_t MO_TILE = al256(MO_BCNT + (size_t)1024 * NEXP * 4);
constexpr size_t MO_END = MO_TILE + 4096;
static_assert(MO_END <= ARENA_BYTES, "moe arena");
constexpr size_t MOW_13 = 0, MOW_2 = (size_t)NEXP * 2 * EDIM * D * 2;
static_assert(MOW_2 + (size_t)NEXP * D * EDIM * 2 <= WREG_BYTES, "moe weights");
__device__ __forceinline__ void mo_phase_a(const Ctx& C, const Args& args, unsigned char* ws, int layer) {
    const float* w13 = args.in[I_MOE_W13] + (size_t)(layer / 2) * NEXP * D * 2 * EDIM; const float* w2 = args.in[I_MOE_W2] + (size_t)(layer / 2) * NEXP * EDIM * D;
    bf16_t* W13T = (bf16_t*)(ws + WS_WREG + MOW_13); bf16_t* W2T = (bf16_t*)(ws + WS_WREG + MOW_2);
#pragma unroll 1
    for (int e = 0; e < NEXP; ++e) {
        const CvtJob jobs[3] = { {w13 + (size_t)e * D * 2 * EDIM, W13T + (size_t)e * 2 * EDIM * D, D, EDIM, 2 * EDIM, D, 0, 0, 128, 256}, {w13 + (size_t)e * D * 2 * EDIM + EDIM, W13T + (size_t)e * 2 * EDIM * D, D, EDIM, 2 * EDIM, D, 128, 0, 128, 256},
                                 {w2 + (size_t)e * EDIM * D, W2T + (size_t)e * D * EDIM, EDIM, D, D, EDIM, 0, 0, D, 0} };
        cvt_run(C, jobs); }
    ph_moe_route(C, (const float*)(ws + WS_RES), args.in[I_NORMG] + (size_t)(layer * 2 + 1) * D, (const float*)(ws + WS_MOD) + (size_t)layer * 18 * D, args.in[I_MOE_ROUTER] + (size_t)(layer / 2) * D * NEXP,
                 (bf16_t*)(ws + WS_ARENA + MO_H2), (int*)(ws + WS_ARENA + MO_TOKE), (float*)(ws + WS_ARENA + MO_TOKG), (int*)(ws + WS_ARENA + MO_BCNT));
}
__device__ __forceinline__ void mo_phase_b(const Ctx& C, unsigned char* ws) {
    ph_moe_scatter(C, (const bf16_t*)(ws + WS_ARENA + MO_H2), (const int*)(ws + WS_ARENA + MO_TOKE), (const int*)(ws + WS_ARENA + MO_BCNT), (int*)(ws + WS_ARENA + MO_DEST), (int*)(ws + WS_ARENA + MO_TILE), (bf16_t*)(ws + WS_ARENA + MO_ABUF));
}
__device__ __forceinline__ void mo_phase_g1(const Ctx& C, unsigned char* ws) {
    SchedMoe S{(const bf16_t*)(ws + WS_ARENA + MO_ABUF), (const bf16_t*)(ws + WS_WREG + MOW_13), (const int*)(ws + WS_ARENA + MO_TILE), D, D, 2 * EDIM / 256, C.G, C.bid};
    EpiSwiGLU E{(bf16_t*)(ws + WS_ARENA + MO_ACT), EDIM};
    pg8::gemm_phase(C.lds, D, D, D, S, E);
}
__device__ __forceinline__ void mo_phase_g2(const Ctx& C, unsigned char* ws) {
    SchedMoe S{(const bf16_t*)(ws + WS_ARENA + MO_ACT), (const bf16_t*)(ws + WS_WREG + MOW_2), (const int*)(ws + WS_ARENA + MO_TILE), EDIM, EDIM, D / 256, C.G, C.bid};
    EpiF32RowBias E{(float*)(ws + WS_ARENA + MO_OUT), D, nullptr};
    pg8::gemm_phase(C.lds, EDIM, EDIM, EDIM, S, E);
}
__device__ __forceinline__ void mo_phase_c(const Ctx& C, unsigned char* ws, int layer) {
    ph_moe_combine(C, (float*)(ws + WS_RES), (const float*)(ws + WS_MOD) + (size_t)layer * 18 * D, (const float*)(ws + WS_ARENA + MO_OUT), (const int*)(ws + WS_ARENA + MO_DEST), (const float*)(ws + WS_ARENA + MO_TOKG));
}

constexpr size_t HG_HB = 0;
constexpr size_t HG_QVG = al256(HG_HB + SZ_ACT_BF);
constexpr size_t HG_FG = al256(HG_QVG + 3 * SZ_ACT_BF);
constexpr size_t HG_O = al256(HG_FG + 2 * SZ_ACT_F32);
constexpr size_t HG_YB = al256(HG_O + 2 * SZ_ACT_F32);
constexpr size_t HG_LB = al256(HG_YB + SZ_ACT_BF);
constexpr size_t HG_END = HG_LB + 2 * D * 4;
static_assert(HG_END <= ARENA_BYTES, "hgrn arena");
constexpr size_t HGW_WIN = 0, HGW_WO = (size_t)5 * D * D * 2;
__device__ __forceinline__ void hg_phase_a(const Ctx& C, const Args& args, unsigned char* ws, int layer, int slot) {
    const CvtJob jobs[2] = { {args.in[I_HG_WIN] + (size_t)slot * D * 5 * D, (bf16_t*)(ws + WS_WREG + HGW_WIN), D, 5 * D, 5 * D, D, 0, 0, 5 * D, 0}, {args.in[I_HG_WO] + (size_t)slot * D * D, (bf16_t*)(ws + WS_WREG + HGW_WO), D, D, D, D, 0, 0, D, 0} };
    cvt_run(C, jobs);
    ph_hg_lb(C, args.in[I_HG_LB], layer, (float*)(ws + WS_ARENA + HG_LB));
    ph_norm_mod_bf16(C, (const float*)(ws + WS_RES), args.in[I_NORMG] + (size_t)(layer * 2) * D, (const float*)(ws + WS_MOD) + (size_t)layer * 18 * D, 0, 1, (bf16_t*)(ws + WS_ARENA + HG_HB));
}
__device__ __forceinline__ void hg_phase_g1(const Ctx& C, unsigned char* ws) {
    SchedPlain S{(const bf16_t*)(ws + WS_ARENA + HG_HB), (const bf16_t*)(ws + WS_WREG + HGW_WIN), D, D, PMT, 5 * D / 256, C.G, C.bid};
    EpiHg E{(bf16_t*)(ws + WS_ARENA + HG_QVG), (float*)(ws + WS_ARENA + HG_FG), (const float*)(ws + WS_ARENA + HG_LB)};
    pg8::gemm_phase(C.lds, D, D, D, S, E);
}
__device__ __forceinline__ void hg_phase_scan(const Ctx& C, unsigned char* ws) { ph_hg_scan_seq(C, (const bf16_t*)(ws + WS_ARENA + HG_QVG), (const float*)(ws + WS_ARENA + HG_FG), (float*)(ws + WS_ARENA + HG_O)); }
__device__ __forceinline__ void hg_phase_post(const Ctx& C, const Args& args, unsigned char* ws, int slot) {
    ph_hg_post(C, (const float*)(ws + WS_ARENA + HG_O), (const bf16_t*)(ws + WS_ARENA + HG_QVG + 2 * SZ_ACT_BF), args.in[I_HG_GN] + (size_t)slot * 128, (bf16_t*)(ws + WS_ARENA + HG_YB));
}
__device__ __forceinline__ void hg_phase_wo(const Ctx& C, unsigned char* ws, int layer) {
    SchedPlain S{(const bf16_t*)(ws + WS_ARENA + HG_YB), (const bf16_t*)(ws + WS_WREG + HGW_WO), D, D, PMT, D / 256, C.G, C.bid};
    EpiRes E{(float*)(ws + WS_RES), (const float*)(ws + WS_MOD) + (size_t)layer * 18 * D, 2, nullptr};
    pg8::gemm_phase(C.lds, D, D, D, S, E);
}
enum PhaseId { PH_INIT = 0, PH_RW0_A, PH_RW0_MIX, PH_RW0_G1, PH_RW0_G2, PH_RW0_SCAN, PH_RW0_POST, PH_RW0_WO, PH_FF0_A, PH_FF0_G1, PH_FF0_G2,
               PH_HY_A, PH_HY_B, PH_HY_CONV, PH_HY_TR, PH_HY_WO, PH_MO1_A, PH_MO1_B, PH_MO1_G1, PH_MO1_G2, PH_MO1_C,
               PH_HG_A, PH_HG_G1, PH_HG_SCAN, PH_HG_POST, PH_HG_WO, PH_FF2_A, PH_FF2_G1, PH_FF2_G2,
               PH_RW3_A, PH_RW3_MIX, PH_RW3_G1, PH_RW3_G2, PH_RW3_SCAN, PH_RW3_POST, PH_RW3_WO, PH_MO3_A, PH_MO3_B, PH_MO3_G1, PH_MO3_G2, PH_MO3_C, PH_FINAL, N_PHASES };
#define RW_PROGRAM(P, layer, slot) \
    if (IN(P##_A)) { rw_phase_a(C, args, ws, layer, slot); SEAM(P##_A); } \
    if (IN(P##_MIX)) { rw_phase_mix(C, args, ws, layer, slot); SEAM(P##_MIX); } \
    if (IN(P##_G1)) { rw_phase_g1(C, args, ws, layer, slot); SEAM(P##_G1); } \
    if (IN(P##_G2)) { rw_phase_g2(C, args, ws, layer, slot); SEAM(P##_G2); } \
    if (IN(P##_SCAN)) { rw_phase_scan(C, args, ws, layer, slot); SEAM(P##_SCAN); } \
    if (IN(P##_POST)) { rw_phase_post(C, args, ws, layer, slot); SEAM(P##_POST); } \
    if (IN(P##_WO)) { rw_phase_wo(C, args, ws, layer, slot); SEAM(P##_WO); }
#define HY_PROGRAM \
    if (IN(PH_HY_A)) { hy_phase_a(C, args, ws, 1); SEAM(PH_HY_A); } \
    if (IN(PH_HY_B)) { hy_phase_b(C, args, ws); SEAM(PH_HY_B); } \
    if (IN(PH_HY_CONV)) { ph_hy_conv(C, (const float*)(ws + WS_ARENA + HY_PROJT), (const float*)(ws + WS_ARENA + HY_FILT), args.in[I_HY_CW], args.in[I_HY_CB], args.in[I_HY_SKIP], (float*)(ws + WS_ARENA + HY_YT), (f32x2*)(ws + WS_ARENA + HY_SCR)); SEAM(PH_HY_CONV); } \
    if (IN(PH_HY_TR)) { ph_hy_transpose(C, (const float*)(ws + WS_ARENA + HY_YT), (bf16_t*)(ws + WS_ARENA + HY_YB)); SEAM(PH_HY_TR); } \
    if (IN(PH_HY_WO)) { hy_phase_wo(C, args, ws, 1); SEAM(PH_HY_WO); }
#define FF_PROGRAM(P, layer) \
    if (IN(P##_A)) { ff_phase_a(C, args, ws, layer); SEAM(P##_A); } \
    if (IN(P##_G1)) { ff_phase_g1(C, ws); SEAM(P##_G1); } \
    if (IN(P##_G2)) { ff_phase_g2(C, ws, layer); SEAM(P##_G2); }
#define MO_PROGRAM(P, layer) \
    if (IN(P##_A)) { mo_phase_a(C, args, ws, layer); SEAM(P##_A); } \
    if (IN(P##_B)) { mo_phase_b(C, ws); SEAM(P##_B); } \
    if (IN(P##_G1)) { mo_phase_g1(C, ws); SEAM(P##_G1); } \
    if (IN(P##_G2)) { mo_phase_g2(C, ws); SEAM(P##_G2); } \
    if (IN(P##_C)) { mo_phase_c(C, ws, layer); SEAM(P##_C); }
#define HG_PROGRAM \
    if (IN(PH_HG_A)) { hg_phase_a(C, args, ws, 2, 0); SEAM(PH_HG_A); } \
    if (IN(PH_HG_G1)) { hg_phase_g1(C, ws); SEAM(PH_HG_G1); } \
    if (IN(PH_HG_SCAN)) { hg_phase_scan(C, ws); SEAM(PH_HG_SCAN); } \
    if (IN(PH_HG_POST)) { hg_phase_post(C, args, ws, 0); SEAM(PH_HG_POST); } \
    if (IN(PH_HG_WO)) { hg_phase_wo(C, ws, 2); SEAM(PH_HG_WO); }
#define PHASE_PROGRAM RW_PROGRAM(PH_RW0, 0, 0) FF_PROGRAM(PH_FF0, 0) HY_PROGRAM MO_PROGRAM(PH_MO1, 1) HG_PROGRAM FF_PROGRAM(PH_FF2, 2) RW_PROGRAM(PH_RW3, 3, 1) MO_PROGRAM(PH_MO3, 3)
#ifndef MK_ONE_LAUNCH
#define MK_ONE_LAUNCH 1
#endif

__global__ void __launch_bounds__(NTHR, 2) mega_fwd(Args args) {
    extern __shared__ __attribute__((aligned(16))) unsigned char lds_raw[];
    Ctx C;
    C.lds = (LAS unsigned char*)lds_raw;
    C.tid = threadIdx.x; C.lane = C.tid & 63; C.wave = __builtin_amdgcn_readfirstlane(C.tid >> 6); C.G = gridDim.x; C.bid = blockIdx.x;
    volatile LAS unsigned* MISC = (volatile LAS unsigned*)(C.lds + LDS_MISC);
    if (C.tid < 64) MISC[C.tid] = 0u;
    __syncthreads();
    unsigned char* ws = args.ws;
    unsigned* ctl = (unsigned*)(ws + WS_CTL);
    XcdBarrier bar; bar.bar = ctl + CW_BAR; bar.x = 0; bar.st = nullptr;
    if (MK_ONE_LAUNCH) bar = xcd_barrier_post(ctl + CW_BAR, MISC + 8);
    const int lo = args.ph_lo, hi = args.ph_hi;
#define IN(k) (lo <= (k) && (k) < hi)
#define SEAM(k) do { if (MK_ONE_LAUNCH && IN((k) + 1)) xcd_barrier(bar); else __syncthreads(); } while (0)
    float* RES = (float*)(ws + WS_RES);
    float* MOD = (float*)(ws + WS_MOD);

    if (IN(PH_INIT)) { ph_init_res(C, args.in[I_X], args.in[I_CTX], RES); ph_adaln(C, args.in[I_C], args.in[I_CCTX], args.in[I_ADAW], args.in[I_ADAB], MOD); SEAM(PH_INIT); }

    PHASE_PROGRAM

    if (IN(PH_FINAL)) { ph_final(C, RES, args.in[I_FINALG], args.out); }
#undef IN
#undef SEAM
}

extern "C" void kernel_launch(void* const* d_in, const int* in_sizes, int n_in, void* d_out, int out_size, void* d_ws, size_t ws_size, hipStream_t stream) {
    static int grid = 0;
    if (grid == 0) {
        if (n_in != N_IN || out_size != NLAT * D || ws_size < WS_END) { fprintf(stderr, "kernel_launch: unexpected shapes (n_in %d out %d ws %zu need %zu)\n", n_in, out_size, ws_size, (size_t)WS_END); grid = -1; return; }
        int dev = 0, cus = 0, per_cu = 0;
        if (hipGetDevice(&dev) != hipSuccess || hipDeviceGetAttribute(&cus, hipDeviceAttributeMultiprocessorCount, dev) != hipSuccess) { grid = -1; return; }
        if (hipFuncSetAttribute((const void*)mega_fwd, hipFuncAttributeMaxDynamicSharedMemorySize, LDS_BYTES) != hipSuccess) { fprintf(stderr, "kernel_launch: hipFuncSetAttribute failed\n"); grid = -1; return; }
        if (hipOccupancyMaxActiveBlocksPerMultiprocessor(&per_cu, (const void*)mega_fwd, NTHR, LDS_BYTES) != hipSuccess || per_cu < 1) { fprintf(stderr, "kernel_launch: occupancy query says %d\n", per_cu); }
        (void)hipGetLastError();
        grid = cus;
    }
    if (grid < 0) return;
    (void)hipMemsetAsync((char*)d_ws + WS_CTL, 0, CTL_BYTES + ZREG_BYTES, stream);
    Args a{};
    for (int i = 0; i < N_IN; ++i) a.in[i] = (const float*)d_in[i];
    a.out = (float*)d_out; a.ws = (unsigned char*)d_ws;
#if MK_ONE_LAUNCH
    a.ph_lo = 0; a.ph_hi = N_PHASES;
    hipLaunchKernelGGL(mega_fwd, dim3(grid), dim3(NTHR), LDS_BYTES, stream, a);
#else
    for (int p = 0; p < N_PHASES; ++p) { a.ph_lo = p; a.ph_hi = p + 1; hipLaunchKernelGGL(mega_fwd, dim3(grid), dim3(NTHR), LDS_BYTES, stream, a); }
#endif
}
```

```cpp
#include <hip/hip_runtime.h>
#include <cstdio>
#include <cstdint>

#define GAS __attribute__((address_space(1)))
#define LAS __attribute__((address_space(3)))
typedef unsigned short bf16_t;
typedef unsigned v4u __attribute__((ext_vector_type(4)));
typedef unsigned v2u __attribute__((ext_vector_type(2)));
typedef float f32x4 __attribute__((ext_vector_type(4)));
typedef float f32x2 __attribute__((ext_vector_type(2)));
typedef short bf16x8 __attribute__((ext_vector_type(8)));
typedef GAS unsigned gu32;
#define RLX_AGENT __ATOMIC_RELAXED, __HIP_MEMORY_SCOPE_AGENT
#define LDS_WAIT() asm volatile("s_waitcnt lgkmcnt(0)" ::: "memory")
#define VM_WAIT() asm volatile("s_waitcnt vmcnt(0)" ::: "memory")

constexpr int D = 1024, NB = 2, SEQ = 16384, CTXL = 256, GRIDW = 64;
constexpr int NCTX = NB * CTXL;
constexpr int NLAT = NB * SEQ;
constexpr int MROWS = NCTX + NLAT;
constexpr int PMT = MROWS / 256;
constexpr int DEPTH = 4;
constexpr int FFN = 2816, NEXP = 8, EDIM = 3584;
constexpr int NWAVES = 8, NTHR = 512;
constexpr float NORM_EPS = 1e-6f;

__device__ __forceinline__ unsigned f2bf(float f) { unsigned u = __builtin_bit_cast(unsigned, f); return (u + 0x7fffu + ((u >> 16) & 1u)) >> 16; }
__device__ __forceinline__ unsigned pk2(float lo, float hi) { return f2bf(lo) | (f2bf(hi) << 16); }
__device__ __forceinline__ float bf2f(unsigned b) { return __builtin_bit_cast(float, b << 16); }
__device__ __forceinline__ float bflo(unsigned w) { return __builtin_bit_cast(float, w << 16); }
__device__ __forceinline__ float bfhi(unsigned w) { return __builtin_bit_cast(float, w & 0xffff0000u); }
__device__ __forceinline__ float sigmoidf_(float x) { return 1.0f / (1.0f + __expf(-x)); }
__device__ __forceinline__ float siluf_(float x) { return x / (1.0f + __expf(-x)); }
__device__ __forceinline__ float wave_sum(float v) {
#pragma unroll
    for (int o = 1; o < 64; o <<= 1) v += __shfl_xor(v, o);
    return v;
}
__device__ __forceinline__ int row_bidx(int r) { return r < NCTX ? 0 : 1 + ((r - NCTX) >> 14); }

#define XB_TMO      128
#define XB_XCNT(j)  (256  + 64 * (j))
#define XB_XSUB(j)  (1280 + 64 * (j))
#define XB_XGEN(j)  (2304 + 64 * (j))
#define XB_TOP      3328
#define XB_TOPGEN   3392
#define XCD_BAR_WORDS 3456
#define XB_SPIN_CAP (1u << 20)

__device__ __forceinline__ unsigned xb_ld(unsigned* p)              { return __hip_atomic_load(p, __ATOMIC_RELAXED, __HIP_MEMORY_SCOPE_AGENT); }
__device__ __forceinline__ unsigned xb_add(unsigned* p, unsigned v) { return __hip_atomic_fetch_add(p, v, __ATOMIC_RELAXED, __HIP_MEMORY_SCOPE_AGENT); }
__device__ __forceinline__ unsigned xb_xcc_id() { return (unsigned)__builtin_amdgcn_s_getreg((3 << 11) | 20) & 0xFu; }
#define XB_SPIN(cond, bar) do { unsigned _sp = 0; while (cond) { __builtin_amdgcn_s_sleep(1); \
    if ((++_sp & 255u) == 0u) { if (xb_ld(&(bar)[XB_TMO])) break; if (_sp > XB_SPIN_CAP) { atomicAdd(&(bar)[XB_TMO], 1u); break; } } } } while (0)

struct XcdBarrier { unsigned* bar; unsigned x; volatile LAS unsigned* st; };

__device__ __forceinline__ XcdBarrier xcd_barrier_post(unsigned* bar, volatile LAS unsigned* st) {
    XcdBarrier b; b.bar = bar; b.x = xb_xcc_id(); b.st = st;
    if (threadIdx.x == 0) (void)xb_add(&bar[XB_XCNT(b.x)], 1u);
    return b;
}
__device__ __forceinline__ void xcd_barrier_complete(unsigned* bar, unsigned x, unsigned& nloc, unsigned& nx) {
    const unsigned G = gridDim.x * gridDim.y * gridDim.z;
    unsigned sum, cnt, mine, sp = 0u;
    for (;;) {
        sum = 0u; cnt = 0u; mine = 0u;
#pragma unroll
        for (unsigned j = 0; j < 16; ++j) { const unsigned c = xb_ld(&bar[XB_XCNT(j)]); sum += c; cnt += (c > 0u) ? 1u : 0u; mine = (j == x) ? c : mine; }
        if (sum == G) break;
        __builtin_amdgcn_s_sleep(1);
        if ((++sp & 255u) == 0u) { if (xb_ld(&bar[XB_TMO])) break; if (sp > XB_SPIN_CAP) { atomicAdd(&bar[XB_TMO], 1u); break; } }
    }
    nloc = mine > 0u ? mine : 1u; nx = cnt > 0u ? cnt : 1u;
}
__device__ __forceinline__ void xcd_barrier(const XcdBarrier& b) {
    asm volatile("s_waitcnt vmcnt(0)" ::: "memory");
    __syncthreads();
    if (threadIdx.x == 0) {
        unsigned* bar = b.bar;
        __builtin_amdgcn_s_waitcnt(0);
        unsigned nloc = b.st[0], nx = b.st[1];
        if (nloc == 0u) { xcd_barrier_complete(bar, b.x, nloc, nx); b.st[0] = nloc; b.st[1] = nx; }
        const unsigned old = xb_add(&bar[XB_XSUB(b.x)], 1u);
        const unsigned gen = old / nloc;
        if (old + 1u == (gen + 1u) * nloc) {
            __builtin_amdgcn_fence(__ATOMIC_RELEASE, "agent");
            asm volatile("s_waitcnt vmcnt(0)" ::: "memory");
            const unsigned og = xb_add(&bar[XB_TOP], 1u);
            const unsigned tg = og / nx;
            if (og + 1u == (tg + 1u) * nx) xb_add(&bar[XB_TOPGEN], 1u);
            else XB_SPIN(xb_ld(&bar[XB_TOPGEN]) == tg, bar);
            __builtin_amdgcn_fence(__ATOMIC_ACQUIRE, "agent");
            xb_add(&bar[XB_XGEN(b.x)], 1u);
            asm volatile("s_waitcnt vmcnt(0)" ::: "memory");
        } else {
            XB_SPIN(xb_ld(&bar[XB_XGEN(b.x)]) == gen, bar);
            __builtin_amdgcn_fence(__ATOMIC_ACQUIRE, "agent");
            asm volatile("s_waitcnt vmcnt(0)" ::: "memory");
        }
    }
    __syncthreads();
}
namespace pg8 {
constexpr int BM = 256, BK = 64, HALF = 128, HTB = HALF * BK * 2, STAGE_BYTES = 8 * HTB, NXCD = 8, WGM = 8;
__host__ __device__ __forceinline__ int lds_byte(int r, int c) { const int st = (r >> 4) * 2 + (c >> 5), rr = r & 15, cc = c & 31, ob = rr * 64 + cc * 2; return st * 1024 + (ob ^ (((ob >> 9) & 1) << 5)); }
__host__ __device__ __forceinline__ void stage_rc(int b, int& R, int& C) { const int st = b / 1024, sb = b % 1024, swz = sb ^ (((sb >> 9) & 1) << 5); R = (st >> 1) * 16 + swz / 64; C = (st & 1) * 32 + (swz % 64) / 2; }
__host__ __device__ __forceinline__ int perm32(int rho) { const int n = rho >> 4, i = rho & 15; return 8 * (i >> 2) + 4 * n + (i & 3); }

struct Unit { int pm, pn, aux; };

__device__ __forceinline__ bool static_unit(int nM, int nN, int G, int c, int i, int& pm, int& pn) {
    const int nwg = nM * nN; const long L = (long)i * G + c; if (L >= nwg) return false;
    int wgid = (int)L; { const int q = nwg / NXCD, r = nwg % NXCD, xcd = wgid % NXCD, off = wgid / NXCD; wgid = (xcd < r ? xcd * (q + 1) : r * (q + 1) + (xcd - r) * q) + off; }
    const int nig = WGM * nN, gid = wgid / nig, fm = gid * WGM, gsz = (nM - fm) < WGM ? (nM - fm) : WGM;
    pm = fm + ((wgid % nig) % gsz); pn = (wgid % nig) / gsz; return true;
}

__device__ __forceinline__ unsigned cvt_pk_bf16(float lo, float hi) { unsigned r; asm volatile("v_cvt_pk_bf16_f32 %0, %1, %2" : "=v"(r) : "v"(lo), "v"(hi)); return r; }

template <class Epi, class Sched>
__device__ __forceinline__ void gemm_phase(LAS unsigned char* lds, const int K_, const int lda, const int ldb, const Sched& S, const Epi& E) {
    int K = K_; asm volatile("" : "+s"(K));
    const int tid = threadIdx.x, wid = __builtin_amdgcn_readfirstlane(tid >> 6), lane = tid & 63, wr = wid >> 2, wc = wid & 3, fr = lane & 15, fq = lane >> 4;
    const int nt = K / BK;
    unsigned voffA[2], voffB[2];
#pragma unroll
    for (int i = 0; i < 2; ++i) { int R, C; stage_rc(tid * 16 + i * 8192, R, C); const int Rb = Epi::PERM ? ((R & ~31) + perm32(R & 31)) : R;
        voffA[i] = (unsigned)(R * lda + C) * 2u; voffB[i] = (unsigned)(Rb * ldb + C) * 2u; }
    const size_t kstep = (size_t)(BK * 2);
    const size_t hstepA = (size_t)HALF * lda * 2, hstepB = (size_t)HALF * ldb * 2;
    const unsigned ldsw = (unsigned)wid * 1024u;
    const int aoff = lds_byte(wr * 64 + fr, fq * 8), boff = lds_byte(wc * 32 + fr, fq * 8);
#define PG8_SA(b, h) (((b) * 2 + (h)) * HTB)
#define PG8_SB(b, h) ((4 + (b) * 2 + (h)) * HTB)
#define PG8_STAGE(bufoff, gbase, voff) do { _Pragma("unroll") for (int _i = 0; _i < 2; ++_i) \
        __builtin_amdgcn_global_load_lds((const GAS unsigned*)((const char*)(gbase) + (voff)[_i]), (LAS unsigned*)(lds + (bufoff) + ldsw + _i * 8192), 16, 0, 0); } while (0)
#define PG8_LDA(dst, b, h) do { _Pragma("unroll") for (int m = 0; m < 4; ++m) _Pragma("unroll") for (int k = 0; k < 2; ++k) dst[m][k] = *(const LAS bf16x8*)(lds + PG8_SA(b, h) + aoff + m * 2048 + k * 1024); } while (0)
#define PG8_LDB(dst, b, h) do { _Pragma("unroll") for (int n = 0; n < 2; ++n) _Pragma("unroll") for (int k = 0; k < 2; ++k) dst[n][k] = *(const LAS bf16x8*)(lds + PG8_SB(b, h) + boff + n * 2048 + k * 1024); } while (0)
#define PG8_MMA(ai, bj, At, Bt) do { __builtin_amdgcn_s_setprio(1); _Pragma("unroll") for (int m = 0; m < 4; ++m) _Pragma("unroll") for (int n = 0; n < 2; ++n) _Pragma("unroll") for (int k = 0; k < 2; ++k) \
        acc[ai][bj][m][n] = __builtin_amdgcn_mfma_f32_16x16x32_bf16(Bt[n][k], At[m][k], acc[ai][bj][m][n], 0, 0, 0); __builtin_amdgcn_s_setprio(0); } while (0)
#define PG8_WAIT_V(n) asm volatile("s_waitcnt vmcnt(" #n ")" ::: "memory")
#define PG8_WAIT_L(n) asm volatile("s_waitcnt lgkmcnt(" #n ")" ::: "memory")
#define PG8_BAR __builtin_amdgcn_s_barrier()
#define PG8_SCHED __builtin_amdgcn_sched_barrier(0)
    Unit cur, nxt; int ui = 0;
    if (!S.next(0, cur)) return;
    f32x4 acc[2][2][4][2];
#pragma unroll
    for (int a = 0; a < 2; ++a)
#pragma unroll
        for (int b = 0; b < 2; ++b)
#pragma unroll
            for (int m = 0; m < 4; ++m)
#pragma unroll
                for (int n = 0; n < 2; ++n) acc[a][b][m][n] = (f32x4){0.f, 0.f, 0.f, 0.f};
    bf16x8 At[4][2], B0[2][2], B1[2][2];
    const char* cA = S.a_ptr(cur); const char* cB = S.b_ptr(cur);
    PG8_STAGE(PG8_SB(0, 0), cB, voffB); PG8_STAGE(PG8_SA(0, 0), cA, voffA); PG8_STAGE(PG8_SB(0, 1), cB + hstepB, voffB); PG8_STAGE(PG8_SA(0, 1), cA + hstepA, voffA);
    if (wr == 1) PG8_BAR;
    PG8_WAIT_V(4); PG8_BAR;
    PG8_STAGE(PG8_SB(1, 0), cB + kstep, voffB); PG8_STAGE(PG8_SA(1, 0), cA + kstep, voffA); PG8_STAGE(PG8_SB(1, 1), cB + hstepB + kstep, voffB);
    PG8_WAIT_V(6); PG8_BAR;
    for (;;) {
        const bool has_next = S.next(ui + 1, nxt);
        const char* nA = has_next ? S.a_ptr(nxt) : cA; const char* nB = has_next ? S.b_ptr(nxt) : cB;
#pragma unroll 1
        for (int t = 0; t < nt; t += 2) {
            const bool last = (t == nt - 2);
            const char* a1 = cA + (size_t)(t + 1) * kstep;
            const char* a2 = last ? nA : cA + (size_t)(t + 2) * kstep; const char* b2 = last ? nB : cB + (size_t)(t + 2) * kstep;
            const char* a3 = a2 + kstep; const char* b3 = b2 + kstep;
            PG8_LDB(B0, 0, 0); PG8_SCHED; PG8_LDA(At, 0, 0); PG8_STAGE(PG8_SA(1, 1), a1 + hstepA, voffA);
            PG8_WAIT_L(8); PG8_BAR; PG8_WAIT_L(0); PG8_MMA(0, 0, At, B0); PG8_BAR; PG8_SCHED;
            PG8_LDB(B1, 0, 1); PG8_STAGE(PG8_SB(0, 0), b2, voffB);
            PG8_BAR; PG8_WAIT_L(0); PG8_MMA(0, 1, At, B1); PG8_BAR;
            PG8_LDA(At, 0, 1); PG8_STAGE(PG8_SA(0, 0), a2, voffA);
            PG8_BAR; PG8_WAIT_L(0); PG8_MMA(1, 0, At, B0); PG8_BAR; PG8_SCHED;
            PG8_STAGE(PG8_SB(0, 1), b2 + hstepB, voffB);
            PG8_WAIT_V(6); PG8_BAR; PG8_MMA(1, 1, At, B1); PG8_BAR;
            PG8_LDB(B0, 1, 0); PG8_SCHED; PG8_LDA(At, 1, 0); PG8_STAGE(PG8_SA(0, 1), a2 + hstepA, voffA);
            PG8_WAIT_L(8); PG8_BAR; PG8_WAIT_L(0); PG8_MMA(0, 0, At, B0); PG8_BAR; PG8_SCHED;
            PG8_LDB(B1, 1, 1); PG8_STAGE(PG8_SB(1, 0), b3, voffB);
            PG8_BAR; PG8_WAIT_L(0); PG8_MMA(0, 1, At, B1); PG8_BAR;
            PG8_LDA(At, 1, 1); PG8_STAGE(PG8_SA(1, 0), a3, voffA);
            PG8_BAR; PG8_WAIT_L(0); PG8_MMA(1, 0, At, B0); PG8_BAR; PG8_SCHED;
            PG8_STAGE(PG8_SB(1, 1), b3 + hstepB, voffB);
            PG8_WAIT_V(6); PG8_BAR; PG8_MMA(1, 1, At, B1); PG8_BAR;
        }
        E(acc, cur, wr, wc, fr, fq);
        if (!has_next) break;
#pragma unroll
        for (int a = 0; a < 2; ++a)
#pragma unroll
            for (int b = 0; b < 2; ++b)
#pragma unroll
                for (int m = 0; m < 4; ++m)
#pragma unroll
                    for (int n = 0; n < 2; ++n) acc[a][b][m][n] = (f32x4){0.f, 0.f, 0.f, 0.f};
        cur = nxt; cA = nA; cB = nB; ++ui;
    }
    PG8_WAIT_V(0);
    if (wr == 0) PG8_BAR;
    PG8_BAR;
#undef PG8_SA
#undef PG8_SB
#undef PG8_STAGE
#undef PG8_LDA
#undef PG8_LDB
#undef PG8_MMA
#undef PG8_WAIT_V
#undef PG8_WAIT_L
#undef PG8_BAR
#undef PG8_SCHED
}
}
using pg8::Unit;
constexpr size_t al256(size_t x) { return (x + 255) & ~(size_t)255; }
constexpr size_t SZ_ACT_BF = (size_t)MROWS * D * 2;
constexpr size_t SZ_ACT_F32 = (size_t)MROWS * D * 4;
constexpr size_t WS_CTL = 0, CTL_BYTES = 65536;
constexpr size_t WS_ZREG = WS_CTL + CTL_BYTES;
constexpr size_t Z_LDN = 0;
constexpr size_t Z_LUP = Z_LDN + (size_t)1024 * 1024 * 2;
constexpr size_t Z_SLOT = Z_LUP + (size_t)6144 * 256 * 2;
constexpr size_t Z_AW = 2 * Z_SLOT;
constexpr size_t ZREG_BYTES = al256(Z_AW + (size_t)4096 * 256 * 2);
constexpr size_t WS_MOD = WS_ZREG + ZREG_BYTES;
constexpr size_t WS_RSTD = WS_MOD + al256((size_t)DEPTH * 3 * 6 * D * 4);
constexpr size_t WS_RES = WS_RSTD + al256((size_t)MROWS * 4);
constexpr size_t WS_VFIRST = WS_RES + SZ_ACT_F32;
constexpr size_t WS_WREG = WS_VFIRST + SZ_ACT_BF;
constexpr size_t WREG_BYTES = (size_t)200 * 1024 * 1024;
constexpr size_t WS_ARENA = WS_WREG + WREG_BYTES;
constexpr size_t ARENA_BYTES = (size_t)1170 * 1000 * 1000;
constexpr size_t WS_END = WS_ARENA + ARENA_BYTES;

constexpr int CW_BAR = 0;
constexpr int CW_MOE = 4096;

constexpr int LDS_MAIN = 139264;
constexpr int LDS_MISC = LDS_MAIN;
constexpr int LDS_BYTES = LDS_MAIN + 256;

struct Args { const float* in[51]; float* out; unsigned char* ws; int ph_lo, ph_hi; };

enum InIdx { I_X = 0, I_C, I_CTX, I_CCTX, I_NORMG, I_ADAW, I_ADAB, I_FINALG, I_RW_MU, I_RW_WRKV, I_RW_WO, I_RW_W0, I_RW_W1, I_RW_W2, I_RW_A0, I_RW_A1, I_RW_A2,
             I_RW_V0, I_RW_V1, I_RW_V2, I_RW_G1, I_RW_G2, I_RW_KK, I_RW_KA, I_RW_RK, I_RW_LNW, I_RW_LNB, I_HY_WIN, I_HY_BIN, I_HY_CW, I_HY_CB, I_HY_FW1, I_HY_FB1,
             I_HY_FW2, I_HY_FB2, I_HY_FW3, I_HY_FB3, I_HY_FW4, I_HY_FREQ, I_HY_SKIP, I_HY_WO, I_HY_BO, I_HG_WIN, I_HG_LB, I_HG_GN, I_HG_WO, I_FFN_W13, I_FFN_W2,
             I_MOE_ROUTER, I_MOE_W13, I_MOE_W2, N_IN };

struct Ctx {
    LAS unsigned char* lds;
    int tid, lane, wave, G, bid;
};

__device__ __forceinline__ void ph_init_res(const Ctx& C, const float* x, const float* ctx, float* res) {
    const size_t nctx4 = (size_t)NCTX * D / 4, n4 = (size_t)MROWS * D / 4;
    const GAS f32x4* c4 = (const GAS f32x4*)ctx; const GAS f32x4* x4 = (const GAS f32x4*)x; GAS f32x4* r4 = (GAS f32x4*)res;
    for (size_t i = (size_t)C.bid * NTHR + C.tid; i < n4; i += (size_t)C.G * NTHR) r4[i] = i < nctx4 ? c4[i] : x4[i - nctx4];
}

__device__ __forceinline__ void ph_adaln(const Ctx& C, const float* c, const float* c_ctx, const float* ada_w, const float* ada_b, float* mod) {
    LAS float* sv = (LAS float*)C.lds;
    LAS float* red = sv + 3 * D;
    for (int i = C.tid; i < 3 * D; i += NTHR) { const int b = i / D, k = i % D; const float v = (b == 0) ? c_ctx[k] : c[(b - 1) * D + k]; sv[i] = siluf_(v); }
    __syncthreads();
    const int NITEM = DEPTH * (6 * D / 64);
    const int col = C.tid & 63, ks = C.tid >> 6;
    for (int it = C.bid; it < NITEM; it += C.G) {
        const int layer = it / (6 * D / 64), cb = it % (6 * D / 64);
        const GAS float* W = (const GAS float*)ada_w + (size_t)layer * D * 6 * D + cb * 64 + col;
        float a0 = 0.f, a1 = 0.f, a2 = 0.f;
#pragma unroll 8
        for (int k = ks * 128; k < ks * 128 + 128; ++k) { const float w = W[(size_t)k * 6 * D]; a0 += sv[k] * w; a1 += sv[D + k] * w; a2 += sv[2 * D + k] * w; }
        red[(ks * 3 + 0) * 64 + col] = a0; red[(ks * 3 + 1) * 64 + col] = a1; red[(ks * 3 + 2) * 64 + col] = a2;
        __syncthreads();
        if (C.tid < 192) { const int b = C.tid / 64, cc = C.tid % 64; float s = 0.f;
#pragma unroll
            for (int q = 0; q < 8; ++q) s += red[(q * 3 + b) * 64 + cc];
            const int n = cb * 64 + cc;
            mod[((size_t)(layer * 3 + b) * 6 * D) + n] = s + ada_b[(size_t)layer * 6 * D + n]; }
        __syncthreads();
    }
}

__device__ __forceinline__ void load_row(const float* row, int lane, f32x4 (&v)[4]) {
    const GAS f32x4* p = (const GAS f32x4*)row + lane;
#pragma unroll
    for (int j = 0; j < 4; ++j) v[j] = p[64 * j];
}
__device__ __forceinline__ float row_rstd(const f32x4 (&v)[4]) {
    float s = 0.f;
#pragma unroll
    for (int j = 0; j < 4; ++j) s += (v[j].x * v[j].x + v[j].y * v[j].y) + (v[j].z * v[j].z + v[j].w * v[j].w);
    return 1.0f / sqrtf(wave_sum(s) * (1.0f / D) + NORM_EPS);
}

__device__ __forceinline__ void ph_rstd(const Ctx& C, const float* res, float* rstd) {
    const int gw = C.bid * NWAVES + C.wave, NGW = C.G * NWAVES;
    for (int r = gw; r < MROWS; r += NGW) { f32x4 v[4]; load_row(res + (size_t)r * D, C.lane, v); const float s = row_rstd(v); if (C.lane == 0) rstd[r] = s; }
}

__device__ __forceinline__ void ph_norm_mod_bf16(const Ctx& C, const float* res, const float* g, const float* modl, int i_shift, int i_scale, bf16_t* hb) {
    const int gw = C.bid * NWAVES + C.wave, NGW = C.G * NWAVES;
    for (int r = gw; r < MROWS; r += NGW) {
        f32x4 v[4]; load_row(res + (size_t)r * D, C.lane, v); const float s = row_rstd(v);
        const int b = row_bidx(r);
        const GAS f32x4* g4 = (const GAS f32x4*)g + C.lane; const GAS f32x4* sh4 = (const GAS f32x4*)(modl + (size_t)(b * 6 + i_shift) * D) + C.lane; const GAS f32x4* sc4 = (const GAS f32x4*)(modl + (size_t)(b * 6 + i_scale) * D) + C.lane;
        GAS v2u* o = (GAS v2u*)(hb + (size_t)r * D) + C.lane;
#pragma unroll
        for (int j = 0; j < 4; ++j) { const f32x4 gg = g4[64 * j], sh = sh4[64 * j], sc = sc4[64 * j];
            const f32x4 h = v[j] * s * gg * (sc + 1.0f) + sh;
            v2u w; w.x = pk2(h.x, h.y); w.y = pk2(h.z, h.w); o[64 * j] = w; }
    }
}

__device__ __forceinline__ void ph_final(const Ctx& C, const float* res, const float* g, float* out) {
    const int gw = C.bid * NWAVES + C.wave, NGW = C.G * NWAVES;
    for (int r = gw; r < NLAT; r += NGW) {
        f32x4 v[4]; load_row(res + (size_t)(NCTX + r) * D, C.lane, v); const float s = row_rstd(v);
        const GAS f32x4* g4 = (const GAS f32x4*)g + C.lane; GAS f32x4* o = (GAS f32x4*)(out + (size_t)r * D) + C.lane;
#pragma unroll
        for (int j = 0; j < 4; ++j) o[64 * j] = v[j] * s * g4[64 * j];
    }
}

struct CvtJob { const float* src; bf16_t* dst; int K, N, sld, ldd, roff, coff, nseg, nstride; };
__device__ __forceinline__ int cvt_items(const CvtJob& j) { return ((j.K + 63) / 64) * ((j.N + 63) / 64); }
__device__ __forceinline__ void cvt_item(const Ctx& C, const CvtJob& j, int item) {
    LAS float* t = (LAS float*)C.lds;
    const int nb = (j.N + 63) / 64, k0 = (item / nb) * 64, n0 = (item % nb) * 64;
    {   const int nn = C.tid & 63, kk0 = C.tid >> 6;
#pragma unroll
        for (int q = 0; q < 8; ++q) { const int kk = kk0 + 8 * q, k = k0 + kk, n = n0 + nn; t[kk * 65 + nn] = (k < j.K && n < j.N) ? ((const GAS float*)j.src)[(size_t)k * j.sld + n] : 0.f; } }
    __syncthreads();
    {   const int kq = C.tid & 15, nn0 = C.tid >> 4;
#pragma unroll
        for (int q = 0; q < 2; ++q) { const int nn = nn0 + 32 * q, n = n0 + nn, k = k0 + 4 * kq;
            if (n < j.N && k < j.K) { const int r = j.roff + (n / j.nseg) * j.nstride + (n % j.nseg);
                v2u w; w.x = pk2(t[(4 * kq + 0) * 65 + nn], t[(4 * kq + 1) * 65 + nn]); w.y = pk2(t[(4 * kq + 2) * 65 + nn], t[(4 * kq + 3) * 65 + nn]);
                *(GAS v2u*)(j.dst + (size_t)r * j.ldd + j.coff + k) = w; } } }
    __syncthreads();
}
template <int NJ> __device__ __forceinline__ void cvt_run(const Ctx& C, const CvtJob (&jobs)[NJ]) {
    int base = 0;
#pragma unroll
    for (int q = 0; q < NJ; ++q) { const int ni = cvt_items(jobs[q]);
        int first = (C.bid - base % C.G + C.G) % C.G;
        for (int it = first; it < ni; it += C.G) cvt_item(C, jobs[q], it);
        base += ni; }
}
struct SchedPlain {
    const bf16_t* A; const bf16_t* Bt; int lda, ldb, nM, nN, G, c;
    __device__ __forceinline__ bool next(int i, Unit& u) const { const bool ok = pg8::static_unit(nM, nN, G, c, i, u.pm, u.pn); u.aux = u.pn; return ok; }
    __device__ __forceinline__ const char* a_ptr(const Unit& u) const { return (const char*)(A + (size_t)u.pm * 256 * lda); }
    __device__ __forceinline__ const char* b_ptr(const Unit& u) const { return (const char*)(Bt + (size_t)u.pn * 256 * ldb); }
};

typedef f32x4 AccT[2][2][4][2];

struct EpiF32RowBias {
    static constexpr bool PERM = false;
    float* Cp; int ldc; const float* rbias;
    __device__ __forceinline__ void operator()(const AccT& acc, const Unit& u, int wr, int wc, int fr, int fq) const {
        const int row0 = u.pm * 256 + wr * 64 + fr, col0 = u.aux * 256 + wc * 32 + 4 * fq;
#pragma unroll
        for (int ai = 0; ai < 2; ++ai)
#pragma unroll
            for (int m = 0; m < 4; ++m) { const int row = row0 + ai * 128 + m * 16; const float b = rbias ? rbias[row] : 0.f; GAS float* rowp = (GAS float*)Cp + (size_t)row * ldc + col0;
#pragma unroll
                for (int bj = 0; bj < 2; ++bj)
#pragma unroll
                    for (int n = 0; n < 2; ++n) *(GAS f32x4*)(rowp + bj * 128 + n * 16) = acc[ai][bj][m][n] + b; }
    }
};

struct EpiRes {
    static constexpr bool PERM = false;
    float* res; const float* modl; int gi; const float* bias;
    __device__ __forceinline__ void operator()(const AccT& acc, const Unit& u, int wr, int wc, int fr, int fq) const {
        const int row0 = u.pm * 256 + wr * 64 + fr, col0 = u.pn * 256 + wc * 32 + 4 * fq;
        const int b = u.pm < 2 ? 0 : (u.pm < 66 ? 1 : 2);
        const GAS float* gate = (const GAS float*)modl + (size_t)(b * 6 + gi) * D;
        f32x4 gv[2][2], bv[2][2];
#pragma unroll
        for (int bj = 0; bj < 2; ++bj)
#pragma unroll
            for (int n = 0; n < 2; ++n) { gv[bj][n] = *(const GAS f32x4*)(gate + col0 + bj * 128 + n * 16); bv[bj][n] = bias ? *(const GAS f32x4*)((const GAS float*)bias + col0 + bj * 128 + n * 16) : (f32x4){0.f, 0.f, 0.f, 0.f}; }
#pragma unroll
        for (int ai = 0; ai < 2; ++ai)
#pragma unroll
            for (int m = 0; m < 4; ++m) { GAS float* rowp = (GAS float*)res + (size_t)(row0 + ai * 128 + m * 16) * D + col0;
#pragma unroll
                for (int bj = 0; bj < 2; ++bj)
#pragma unroll
                    for (int n = 0; n < 2; ++n) { GAS f32x4* p = (GAS f32x4*)(rowp + bj * 128 + n * 16); *p = *p + gv[bj][n] * (acc[ai][bj][m][n] + bv[bj][n]); } }
    }
};

struct EpiSwiGLU {
    static constexpr bool PERM = true;
    bf16_t* O; int ldo;
    __device__ __forceinline__ void operator()(const AccT& acc, const Unit& u, int wr, int wc, int fr, int fq) const {
        const int row0 = u.pm * 256 + wr * 64 + fr, col0 = u.aux * 128 + wc * 32 + 8 * fq;
#pragma unroll
        for (int ai = 0; ai < 2; ++ai)
#pragma unroll
            for (int m = 0; m < 4; ++m) { GAS bf16_t* rowp = (GAS bf16_t*)O + (size_t)(row0 + ai * 128 + m * 16) * ldo + col0;
                float o[8];
#pragma unroll
                for (int n = 0; n < 2; ++n)
#pragma unroll
                    for (int j = 0; j < 4; ++j) { const float g = acc[ai][0][m][n][j], up = acc[ai][1][m][n][j]; o[n * 4 + j] = siluf_(g) * up; }
                v4u w; w.x = pk2(o[0], o[1]); w.y = pk2(o[2], o[3]); w.z = pk2(o[4], o[5]); w.w = pk2(o[6], o[7]);
                *(GAS v4u*)rowp = w; }
    }
};
constexpr int FN = 16384;
constexpr int HY_NPOS = SEQ + CTXL;
__device__ __forceinline__ int pidx(int p) { return p + ((p >> 6) << 2); }
__device__ __forceinline__ f32x2 cmul(f32x2 a, f32x2 b) { return (f32x2){a.x * b.x - a.y * b.y, a.x * b.y + a.y * b.x}; }
__device__ __forceinline__ f32x2 cmulc(f32x2 a, f32x2 b) { return (f32x2){a.x * b.x + a.y * b.y, a.y * b.x - a.x * b.y}; }

#define W16C_ {1.0f, 0.92387953251f, 0.70710678119f, 0.38268343237f, 0.0f, -0.38268343237f, -0.70710678119f, -0.92387953251f}
#define W16S_ {0.0f, -0.38268343237f, -0.70710678119f, -0.92387953251f, -1.0f, -0.92387953251f, -0.70710678119f, -0.38268343237f}

template <bool INV> __device__ __forceinline__ void fft_pass16(LAS f32x2* X, const int S, const int lgS, const int tid) {
    constexpr float wc[8] = W16C_, ws[8] = W16S_;
#pragma unroll 1
    for (int gi = 0; gi < 2; ++gi) {
        const int g = tid + gi * 512, blk = g >> lgS, q = g & (S - 1), base = blk * 16 * S + q;
        f32x2 e[16];
#pragma unroll
        for (int m = 0; m < 16; ++m) e[m] = X[pidx(base + m * S)];
        float sn, cs; sincospif(-(float)q / (8.0f * (float)S), &sn, &cs);
        const f32x2 w1 = (f32x2){cs, sn}, w2 = cmul(w1, w1), w4 = cmul(w2, w2), w8 = cmul(w4, w4);
        if (!INV) {
#pragma unroll
            for (int m = 0; m < 8; ++m) { const f32x2 a = e[m], b = e[m + 8]; e[m] = a + b; e[m + 8] = cmul(a - b, cmul(w1, (f32x2){wc[m], ws[m]})); }
#pragma unroll
            for (int h = 0; h < 16; h += 8)
#pragma unroll
                for (int m = 0; m < 4; ++m) { const f32x2 a = e[h + m], b = e[h + m + 4]; e[h + m] = a + b; e[h + m + 4] = cmul(a - b, cmul(w2, (f32x2){wc[2 * m], ws[2 * m]})); }
#pragma unroll
            for (int h = 0; h < 16; h += 4)
#pragma unroll
                for (int m = 0; m < 2; ++m) { const f32x2 a = e[h + m], b = e[h + m + 2]; e[h + m] = a + b; e[h + m + 2] = cmul(a - b, cmul(w4, (f32x2){wc[4 * m], ws[4 * m]})); }
#pragma unroll
            for (int h = 0; h < 16; h += 2) { const f32x2 a = e[h], b = e[h + 1]; e[h] = a + b; e[h + 1] = cmul(a - b, w8); }
        } else {
#pragma unroll
            for (int h = 0; h < 16; h += 2) { const f32x2 a = e[h], b = cmulc(e[h + 1], w8); e[h] = a + b; e[h + 1] = a - b; }
#pragma unroll
            for (int h = 0; h < 16; h += 4)
#pragma unroll
                for (int m = 0; m < 2; ++m) { const f32x2 a = e[h + m], b = cmulc(e[h + m + 2], cmul(w4, (f32x2){wc[4 * m], ws[4 * m]})); e[h + m] = a + b; e[h + m + 2] = a - b; }
#pragma unroll
            for (int h = 0; h < 16; h += 8)
#pragma unroll
                for (int m = 0; m < 4; ++m) { const f32x2 a = e[h + m], b = cmulc(e[h + m + 4], cmul(w2, (f32x2){wc[2 * m], ws[2 * m]})); e[h + m] = a + b; e[h + m + 4] = a - b; }
#pragma unroll
            for (int m = 0; m < 8; ++m) { const f32x2 a = e[m], b = cmulc(e[m + 8], cmul(w1, (f32x2){wc[m], ws[m]})); e[m] = a + b; e[m + 8] = a - b; }
        }
#pragma unroll
        for (int m = 0; m < 16; ++m) X[pidx(base + m * S)] = e[m];
    }
}
template <bool INV> __device__ __forceinline__ void fft_pass4(LAS f32x2* X, const int tid) {
#pragma unroll 2
    for (int gi = 0; gi < 8; ++gi) {
        const int base = pidx(4 * (tid + gi * 512));
        f32x2 e0 = X[base], e1 = X[base + 1], e2 = X[base + 2], e3 = X[base + 3];
        if (!INV) {
            f32x2 a = e0, b = e2; e0 = a + b; e2 = a - b;
            a = e1; b = e3; e1 = a + b; { const f32x2 d = a - b; e3 = (f32x2){d.y, -d.x}; }
            a = e0; b = e1; e0 = a + b; e1 = a - b;
            a = e2; b = e3; e2 = a + b; e3 = a - b;
        } else {
            f32x2 a = e0, b = e1; e0 = a + b; e1 = a - b;
            a = e2; b = e3; e2 = a + b; e3 = a - b;
            a = e0; b = e2; e0 = a + b; e2 = a - b;
            a = e1; b = (f32x2){-e3.y, e3.x}; e1 = a + b; e3 = a - b;
        }
        X[base] = e0; X[base + 1] = e1; X[base + 2] = e2; X[base + 3] = e3;
    }
}
__device__ __forceinline__ void fft_fwd(LAS f32x2* X, int tid) {
    fft_pass16<false>(X, 1024, 10, tid); __syncthreads(); fft_pass16<false>(X, 64, 6, tid); __syncthreads(); fft_pass16<false>(X, 4, 2, tid); __syncthreads(); fft_pass4<false>(X, tid); __syncthreads();
}
__device__ __forceinline__ void fft_inv(LAS f32x2* X, int tid) {
    fft_pass4<true>(X, tid); __syncthreads(); fft_pass16<true>(X, 4, 2, tid); __syncthreads(); fft_pass16<true>(X, 64, 6, tid); __syncthreads(); fft_pass16<true>(X, 1024, 10, tid); __syncthreads();
}

__device__ __forceinline__ float conv3(const GAS float* seq, int n, int L, float w0, float w1, float w2, float cb) {
    const float p0 = n > 0 ? seq[n - 1] : 0.f, p1 = seq[n], p2 = n < L - 1 ? seq[n + 1] : 0.f;
    return w0 * p0 + w1 * p1 + w2 * p2 + cb;
}

__device__ __forceinline__ void ph_hy_filter_mlp(const Ctx& C, const float* w1, const float* b1, const float* w2, const float* b2, const float* w3, const float* b3, const float* freq, bf16_t* HB) {
    const int gw = C.bid * NWAVES + C.wave, NGW = C.G * NWAVES, j = C.lane;
    const GAS float* W1 = (const GAS float*)w1; const GAS float* W2 = (const GAS float*)w2; const GAS float* W3 = (const GAS float*)w3;
    const float f0 = freq[j], f1 = freq[64 + j], f2 = freq[128 + j], bb1 = b1[j], bb2 = b2[j], bb3 = b3[j];
    for (int p = gw; p < HY_NPOS; p += NGW) {
        const int L = p < SEQ ? SEQ : CTXL; const int pos = p < SEQ ? p : p - SEQ;
        const float fpos = (float)pos, t = fpos / (float)(L - 1);
        const float a = (float)(6.283185307179586 / (double)L) * fpos;
        float z = 0.f;
        if (j == 0) z = t;
        else if (j <= 32) { const int bi = (j - 1) & 15; const float band = 1e-4f + (float)bi * ((15.0f - 1e-4f) / 15.0f); const float ang = a * band; z = (j <= 16) ? cosf(ang) : -sinf(ang); }
        float acc = bb1;
#pragma unroll
        for (int i = 0; i < 33; ++i) acc += __shfl(z, i) * W1[i * 64 + j];
        float h = sinf(f0 * acc);
        acc = bb2;
#pragma unroll 16
        for (int i = 0; i < 64; ++i) acc += __shfl(h, i) * W2[i * 64 + j];
        h = sinf(f1 * acc);
        acc = bb3;
#pragma unroll 16
        for (int i = 0; i < 64; ++i) acc += __shfl(h, i) * W3[i * 64 + j];
        h = sinf(f2 * acc);
        const unsigned hi = f2bf(h); const unsigned lo = f2bf(h - bf2f(hi));
        GAS bf16_t* o = (GAS bf16_t*)HB + (size_t)p * 256;
        o[j] = (bf16_t)hi; o[64 + j] = (bf16_t)lo; o[128 + j] = (bf16_t)hi; o[192 + j] = 0;
    }
}
__device__ __forceinline__ void ph_hy_w4split(const Ctx& C, const float* w4, bf16_t* AW) {
    for (int i = C.bid * NTHR + C.tid; i < 64 * 4096; i += C.G * NTHR) { const int k = i >> 12, n = i & 4095; const float w = w4[i];
        const unsigned hi = f2bf(w), lo = f2bf(w - bf2f(hi)); GAS bf16_t* o = (GAS bf16_t*)AW + (size_t)n * 256;
        o[k] = (bf16_t)hi; o[64 + k] = (bf16_t)hi; o[128 + k] = (bf16_t)lo; o[192 + k] = 0; }
}
struct EpiHyFilt {
    static constexpr bool PERM = false;
    float* F;
    __device__ __forceinline__ void operator()(const AccT& acc, const Unit& u, int wr, int wc, int fr, int fq) const {
        const int row0 = u.pm * 256 + wr * 64 + fr, col0 = u.pn * 256 + wc * 32 + 4 * fq;
        const float d0 = -15.350567286626973f, d1 = -3.0701134573253946f;
#pragma unroll
        for (int ai = 0; ai < 2; ++ai)
#pragma unroll
            for (int m = 0; m < 4; ++m) { const int row = row0 + ai * 128 + m * 16, ch = row & 1023;
                const float ad = fabsf(d0 + (d1 - d0) * ((float)ch / 1023.0f));
                GAS float* rowp = (GAS float*)F + (size_t)row * HY_NPOS + col0;
#pragma unroll
                for (int bj = 0; bj < 2; ++bj)
#pragma unroll
                    for (int n = 0; n < 2; ++n) { const int c0 = col0 + bj * 128 + n * 16; f32x4 o;
#pragma unroll
                        for (int jj = 0; jj < 4; ++jj) { const int p = c0 + jj; const float t = p < SEQ ? (float)p / (float)(SEQ - 1) : (float)(p - SEQ) / (float)(CTXL - 1); o[jj] = acc[ai][bj][m][n][jj] * __expf(-t * ad); }
                        *(GAS f32x4*)(rowp + bj * 128 + n * 16) = o; } }
    }
};

__device__ __forceinline__ void ph_hy_conv(const Ctx& C, const float* PROJT, const float* FILT, const float* cw, const float* cbias, const float* skip, float* YT, f32x2* SCR) {
    LAS f32x2* X = (LAS f32x2*)C.lds;
    GAS f32x2* U = (GAS f32x2*)SCR + (size_t)C.bid * 3 * FN; GAS f32x2* R1 = U + FN; GAS f32x2* KS = U + 2 * FN;
    const int tid = C.tid;
    for (int ch = C.bid; ch < D; ch += C.G) {
        const GAS float* px1 = (const GAS float*)PROJT + (size_t)ch * MROWS; const GAS float* px2 = (const GAS float*)PROJT + (size_t)(D + ch) * MROWS; const GAS float* pv = (const GAS float*)PROJT + (size_t)(2 * D + ch) * MROWS;
        const float a0 = cw[ch], a1 = cw[3 * D + ch], a2 = cw[6 * D + ch], ab = cbias[ch];
        const float b0 = cw[D + ch], b1 = cw[3 * D + D + ch], b2 = cw[6 * D + D + ch], bb = cbias[D + ch];
        const float v0 = cw[2 * D + ch], v1 = cw[3 * D + 2 * D + ch], v2 = cw[6 * D + 2 * D + ch], vb = cbias[2 * D + ch];
        {   LAS float* gf = (LAS float*)C.lds;
            LAS float* us = gf + 1024;
            LAS float* zs = us + 512;
            for (int i = tid; i < 1024; i += NTHR) gf[i] = ((const GAS float*)FILT)[(size_t)((i >> 8) * D + ch) * HY_NPOS + SEQ + (i & 255)];
            const int b = tid >> 8, t = tid & 255;
            us[tid] = conv3(pv + b * CTXL, t, CTXL, v0, v1, v2, vb);
            __syncthreads();
            float y = skip[ch] * us[tid];
            for (int s = 0; s < CTXL; ++s) { const float g = s <= t ? gf[t - s] : gf[256 + s - t]; y += g * us[b * 256 + s]; }
            zs[tid] = y * conv3(px1 + b * CTXL, t, CTXL, a0, a1, a2, ab);
            __syncthreads();
            float y2 = skip[D + ch] * zs[tid];
            for (int s = 0; s < CTXL; ++s) { const float g = s <= t ? gf[512 + t - s] : gf[768 + s - t]; y2 += g * zs[b * 256 + s]; }
            ((GAS float*)YT)[(size_t)ch * MROWS + b * CTXL + t] = y2 * conv3(px2 + b * CTXL, t, CTXL, b0, b1, b2, bb);
            __syncthreads();
        }
        const GAS float* lv0 = pv + NCTX; const GAS float* lv1 = pv + NCTX + SEQ;
        for (int n = tid; n < FN; n += NTHR) U[n] = (f32x2){conv3(lv0, n, SEQ, v0, v1, v2, vb), conv3(lv1, n, SEQ, v0, v1, v2, vb)};
        for (int o = 0; o < 2; ++o) {
            const GAS float* hf = (const GAS float*)FILT + (size_t)((o * 2 + 0) * D + ch) * HY_NPOS; const GAS float* hb = (const GAS float*)FILT + (size_t)((o * 2 + 1) * D + ch) * HY_NPOS;
            const float sk = skip[o * D + ch];
            for (int n = tid; n < FN; n += NTHR) { const float f = hf[n], r = n ? hb[FN - n] : 0.f; X[pidx(n)] = (f32x2){f + r, 0.f}; }
            __syncthreads(); fft_fwd(X, tid);
            for (int n = tid; n < FN; n += NTHR) KS[n] = X[pidx(n)];
            VM_WAIT(); __syncthreads();
            for (int n = tid; n < FN; n += NTHR) X[pidx(n)] = U[n];
            __syncthreads(); fft_fwd(X, tid);
            for (int n = tid; n < FN; n += NTHR) { const int p = pidx(n); X[p] = cmul(X[p], KS[n]); }
            __syncthreads(); fft_inv(X, tid);
            for (int n = tid; n < FN; n += NTHR) R1[n] = X[pidx(n)];
            __syncthreads();
            for (int n = tid; n < FN; n += NTHR) { const float f = hf[n], r = n ? hb[FN - n] : 0.f; float sn, cs; sincospif(-(float)n * (1.0f / (float)FN), &sn, &cs); const float d = f - r; X[pidx(n)] = (f32x2){d * cs, d * sn}; }
            __syncthreads(); fft_fwd(X, tid);
            for (int n = tid; n < FN; n += NTHR) KS[n] = X[pidx(n)];
            VM_WAIT(); __syncthreads();
            for (int n = tid; n < FN; n += NTHR) { float sn, cs; sincospif(-(float)n * (1.0f / (float)FN), &sn, &cs); X[pidx(n)] = cmul(U[n], (f32x2){cs, sn}); }
            __syncthreads(); fft_fwd(X, tid);
            for (int n = tid; n < FN; n += NTHR) { const int p = pidx(n); X[p] = cmul(X[p], KS[n]); }
            __syncthreads(); fft_inv(X, tid);
            VM_WAIT(); __syncthreads();
            for (int n = tid; n < FN; n += NTHR) {
                float sn, cs; sincospif(-(float)n * (1.0f / (float)FN), &sn, &cs);
                const f32x2 r2 = cmulc(X[pidx(n)], (f32x2){cs, sn}); const f32x2 u = U[n]; const f32x2 r1 = R1[n];
                const f32x2 y = (r1 + r2) * (0.5f / (float)FN) + u * sk;
                if (o == 0) U[n] = (f32x2){y.x * conv3(px1 + NCTX, n, SEQ, a0, a1, a2, ab), y.y * conv3(px1 + NCTX + SEQ, n, SEQ, a0, a1, a2, ab)};
                else { ((GAS float*)YT)[(size_t)ch * MROWS + NCTX + n] = y.x * conv3(px2 + NCTX, n, SEQ, b0, b1, b2, bb); ((GAS float*)YT)[(size_t)ch * MROWS + NCTX + SEQ + n] = y.y * conv3(px2 + NCTX + SEQ, n, SEQ, b0, b1, b2, bb); }
            }
            VM_WAIT(); __syncthreads();
        }
    }
}

__device__ __forceinline__ void ph_hy_transpose(const Ctx& C, const float* YT, bf16_t* YB) {
    LAS float* t = (LAS float*)C.lds;
    const int NIT = (D / 64) * (MROWS / 64);
    for (int it = C.bid; it < NIT; it += C.G) {
        const int c0 = (it % (D / 64)) * 64, t0 = (it / (D / 64)) * 64;
        {   const int tt = C.tid & 63, cc0 = C.tid >> 6;
#pragma unroll
            for (int q = 0; q < 8; ++q) { const int cc = cc0 + 8 * q; t[cc * 65 + tt] = ((const GAS float*)YT)[(size_t)(c0 + cc) * MROWS + t0 + tt]; } }
        __syncthreads();
        {   const int cq = C.tid & 15, tt0 = C.tid >> 4;
#pragma unroll
            for (int q = 0; q < 2; ++q) { const int tt = tt0 + 32 * q; v2u w; w.x = pk2(t[(4 * cq + 0) * 65 + tt], t[(4 * cq + 1) * 65 + tt]); w.y = pk2(t[(4 * cq + 2) * 65 + tt], t[(4 * cq + 3) * 65 + tt]);
                *(GAS v2u*)((GAS bf16_t*)YB + (size_t)(t0 + tt) * D + c0 + 4 * cq) = w; } }
        __syncthreads();
    }
}
constexpr int RW_H = 16, RW_N = 64;
constexpr int NSTEP = CTXL + SEQ;

__device__ __forceinline__ void ph_rw_mix(const Ctx& C, const float* res, const float* rstd, const float* g, const float* modl, const float* mu, bf16_t* X6) {
    const int gw = C.bid * NWAVES + C.wave, NGW = C.G * NWAVES, lane = C.lane;
    for (int r = gw; r < MROWS; r += NGW) {
        int nb[4]; bool ok[4];
        if (r < NCTX) { const int t = r & 255; nb[0] = nb[1] = r - 1; ok[0] = ok[1] = t > 0; nb[2] = nb[3] = r + 1; ok[2] = ok[3] = t < 255; }
        else { const int l = (r - NCTX) & (SEQ - 1), gy = l >> 6, gx = l & 63; nb[0] = r - 1; ok[0] = gx > 0; nb[1] = r + 1; ok[1] = gx < 63; nb[2] = r - 64; ok[2] = gy > 0; nb[3] = r + 64; ok[3] = gy < 255; }
        const int b = row_bidx(r);
        const float so = rstd[r];
        const GAS f32x4* own = (const GAS f32x4*)(res + (size_t)r * D) + lane;
        const GAS f32x4* g4 = (const GAS f32x4*)g + lane; const GAS f32x4* sh4 = (const GAS f32x4*)(modl + (size_t)(b * 6 + 0) * D) + lane; const GAS f32x4* sc4 = (const GAS f32x4*)(modl + (size_t)(b * 6 + 1) * D) + lane;
#pragma unroll
        for (int j = 0; j < 4; ++j) {
            const f32x4 gg = g4[64 * j] * (sc4[64 * j] + 1.0f), sh = sh4[64 * j];
            const f32x4 ho = own[64 * j] * so * gg + sh;
            f32x4 hn = (f32x4){0.f, 0.f, 0.f, 0.f};
            if (ok[j]) { const float sn = rstd[nb[j]]; hn = ((const GAS f32x4*)(res + (size_t)nb[j] * D) + lane)[64 * j] * sn * gg + sh; }
            const f32x4 xx = hn - ho;
#pragma unroll
            for (int m = 0; m < 6; ++m) { const f32x4 mm = ((const GAS f32x4*)(mu + (size_t)m * D) + lane)[64 * j]; const f32x4 x = ho + xx * mm;
                v2u w; w.x = pk2(x.x, x.y); w.y = pk2(x.z, x.w); ((GAS v2u*)(X6 + ((size_t)m * MROWS + r) * D) + lane)[64 * j] = w; }
        }
    }
}

struct SchedRw1 {
    const bf16_t* X6; const bf16_t* Wrkv; const bf16_t* Ldn; int nN, G, c;
    __device__ __forceinline__ bool next(int i, Unit& u) const { const bool ok = pg8::static_unit(PMT, nN, G, c, i, u.pm, u.pn); u.aux = 0; return ok; }
    __device__ __forceinline__ const char* a_ptr(const Unit& u) const { const int am = u.pn < 4 ? 0 : u.pn < 8 ? 2 : u.pn < 12 ? 3 : u.pn == 12 ? 1 : u.pn == 13 ? 4 : u.pn == 14 ? 5 : 3;
        return (const char*)(X6 + ((size_t)am * MROWS + (size_t)u.pm * 256) * D); }
    __device__ __forceinline__ const char* b_ptr(const Unit& u) const { return u.pn < 12 ? (const char*)(Wrkv + (size_t)u.pn * 256 * D) : (const char*)(Ldn + (size_t)(u.pn - 12) * 256 * D); }
};
__device__ __forceinline__ float act_sel(float x, int act) { const float e = __expf(act == 1 ? 2.0f * x : -x); const float t = 1.0f - 2.0f / (e + 1.0f), s = 1.0f / (1.0f + e); return act == 1 ? t : (act == 2 ? s : x); }
struct EpiRw1 {
    static constexpr bool PERM = true;
    bf16_t* Rb; bf16_t* Kb; bf16_t* Vb; bf16_t* LD;
    __device__ __forceinline__ void operator()(const AccT& acc, const Unit& u, int wr, int wc, int fr, int fq) const {
        const int row0 = u.pm * 256 + wr * 64 + fr;
        const int grp = u.pn >> 2;
        const size_t doff = (size_t)(grp == 0) * (size_t)Rb + (size_t)(grp == 1) * (size_t)Kb + (size_t)(grp == 2) * (size_t)Vb + (size_t)(grp == 3) * (size_t)LD;
        bf16_t* dst = (bf16_t*)doff;
        const int colt = (u.pn & 3) * 256; const int act = (u.pn == 12) ? 1 : ((u.pn == 14) ? 2 : 0);
        const int col0 = colt + wc * 32 + 8 * fq;
        if (act == 0) {
#pragma unroll
            for (int ai = 0; ai < 2; ++ai)
#pragma unroll
                for (int m = 0; m < 4; ++m) { GAS bf16_t* rowp = (GAS bf16_t*)dst + (size_t)(row0 + ai * 128 + m * 16) * D + col0;
#pragma unroll
                    for (int bj = 0; bj < 2; ++bj) { const f32x4 p = acc[ai][bj][m][0], q = acc[ai][bj][m][1];
                        v4u w; w.x = pk2(p[0], p[1]); w.y = pk2(p[2], p[3]); w.z = pk2(q[0], q[1]); w.w = pk2(q[2], q[3]);
                        *(GAS v4u*)(rowp + bj * 128) = w; } }
        } else {
#pragma unroll
            for (int ai = 0; ai < 2; ++ai)
#pragma unroll
                for (int m = 0; m < 4; ++m) { GAS bf16_t* rowp = (GAS bf16_t*)dst + (size_t)(row0 + ai * 128 + m * 16) * D + col0;
#pragma unroll
                    for (int bj = 0; bj < 2; ++bj) { const f32x4 p = acc[ai][bj][m][0], q = acc[ai][bj][m][1];
                        v4u w; w.x = pk2(act_sel(p[0], act), act_sel(p[1], act)); w.y = pk2(act_sel(p[2], act), act_sel(p[3], act)); w.z = pk2(act_sel(q[0], act), act_sel(q[1], act)); w.w = pk2(act_sel(q[2], act), act_sel(q[3], act));
                        *(GAS v4u*)(rowp + bj * 128) = w; } }
        }
    }
};

struct SchedRw2 {
    const bf16_t* LD; const bf16_t* Lup; int nN, G, c;
    __device__ __forceinline__ bool next(int i, Unit& u) const { const bool ok = pg8::static_unit(PMT, nN, G, c, i, u.pm, u.pn); u.aux = 0; return ok; }
    __device__ __forceinline__ const char* a_ptr(const Unit& u) const { const int grp = u.pn < 8 ? 0 : u.pn < 16 ? 1 : u.pn < 20 ? 2 : 3; return (const char*)(LD + (size_t)u.pm * 256 * D + grp * 256); }
    __device__ __forceinline__ const char* b_ptr(const Unit& u) const { return (const char*)(Lup + (size_t)u.pn * 256 * 256); }
};
struct EpiRw2 {
    static constexpr bool PERM = false;
    float* DEC; bf16_t* ASIG; bf16_t* Gb; bf16_t* Vb; const bf16_t* VF; const float* w0; const float* a0; const float* v0;
    __device__ __forceinline__ void operator()(const AccT& acc, const Unit& u, int wr, int wc, int fr, int fq) const {
        const int row0 = u.pm * 256 + wr * 64 + fr;
        const int pn = u.pn, colt = (pn & 3) * 256 + wc * 32 + 4 * fq;
        const GAS float* cbp = pn < 8 ? (const GAS float*)w0 + (pn >> 2) * D : (pn < 16 ? (const GAS float*)a0 + ((pn - 8) >> 2) * D : (const GAS float*)v0);
        const float cbs = (pn >= 16 && pn < 20) ? 0.f : 1.f;
        const int mode = pn < 8 ? 0 : (pn < 16 ? 1 : (pn < 20 ? 2 : 3));
        const size_t dsel = (size_t)((pn < 8 ? pn : pn - 8) >> 2) * MROWS;
#pragma unroll
        for (int ai = 0; ai < 2; ++ai)
#pragma unroll
            for (int m = 0; m < 4; ++m) { const size_t row = (size_t)(row0 + ai * 128 + m * 16);
#pragma unroll
                for (int bj = 0; bj < 2; ++bj)
#pragma unroll
                    for (int n = 0; n < 2; ++n) { const int col = colt + bj * 128 + n * 16;
                        const f32x4 x = acc[ai][bj][m][n] + *(const GAS f32x4*)(cbp + col) * cbs;
                        if (mode == 0) { f32x4 o;
#pragma unroll
                            for (int j = 0; j < 4; ++j) { const float z = -x[j]; const float sp = z > 20.f ? z : __logf(1.0f + __expf(z)); o[j] = -__expf(-sp - 0.5f); }
                            *(GAS f32x4*)((GAS float*)DEC + (dsel + row) * D + col) = o; }
                        else if (mode == 1) { v2u w; w.x = pk2(sigmoidf_(x[0]), sigmoidf_(x[1])); w.y = pk2(sigmoidf_(x[2]), sigmoidf_(x[3]));
                            *(GAS v2u*)((GAS bf16_t*)ASIG + (dsel + row) * D + col) = w; }
                        else if (mode == 2) { v2u w; w.x = pk2(x[0], x[1]); w.y = pk2(x[2], x[3]); *(GAS v2u*)((GAS bf16_t*)Gb + row * D + col) = w; }
                        else { GAS v2u* vp = (GAS v2u*)((GAS bf16_t*)Vb + row * D + col); const v2u vv = *vp; const v2u ff = *(const GAS v2u*)((const GAS bf16_t*)VF + row * D + col);
                            const float o0 = bflo(vv.x) + (bflo(ff.x) - bflo(vv.x)) * sigmoidf_(x[0]), o1 = bfhi(vv.x) + (bfhi(ff.x) - bfhi(vv.x)) * sigmoidf_(x[1]);
                            const float o2 = bflo(vv.y) + (bflo(ff.y) - bflo(vv.y)) * sigmoidf_(x[2]), o3 = bfhi(vv.y) + (bfhi(ff.y) - bfhi(vv.y)) * sigmoidf_(x[3]);
                            v2u w; w.x = pk2(o0, o1); w.y = pk2(o2, o3); *vp = w; } }
                asm volatile("" ::: "memory"); }
    }
};

__device__ __forceinline__ int rw_step_row(int d, int b, int s) {
    if (s < CTXL) return b * CTXL + (d == 0 ? s : CTXL - 1 - s);
    const int l = s - CTXL; return NCTX + b * SEQ + (d == 0 ? l : SEQ - 1 - l);
}
__device__ __forceinline__ float dpp_xor1(float v) { return __builtin_bit_cast(float, __builtin_amdgcn_update_dpp(0, __builtin_bit_cast(int, v), 0xB1, 0xf, 0xf, false)); }
__device__ __forceinline__ float dpp_xor2(float v) { return __builtin_bit_cast(float, __builtin_amdgcn_update_dpp(0, __builtin_bit_cast(int, v), 0x4E, 0xf, 0xf, false)); }
__device__ __forceinline__ float dpp_hmirror(float v) { return __builtin_bit_cast(float, __builtin_amdgcn_update_dpp(0, __builtin_bit_cast(int, v), 0x141, 0xf, 0xf, false)); }
__device__ __forceinline__ float sum8(float v) { v += dpp_xor1(v); v += dpp_xor2(v); v += dpp_hmirror(v); return v; }

__device__ __forceinline__ void ph_rw_scan_seq(const Ctx& C, const bf16_t* Rb, const bf16_t* Kb, const bf16_t* Vb, const float* DEC, const bf16_t* ASIG, const float* k_k, const float* k_a, const float* r_k, float* Y, float* BON) {
    constexpr int T = 32;
    LAS float* sw = (LAS float*)C.lds;
    LAS float* sa = sw + T * 64; LAS float* sb = sa + T * 64; LAS float* sk = sb + T * 64; LAS float* sr = sk + T * 64; LAS float* sv = sr + T * 64; LAS float* sy = sv + T * 64;
    for (int chain = C.bid; chain < 64; chain += C.G) {
        const int d = chain >> 5, b = (chain >> 4) & 1, h = chain & 15;
        const int v = C.tid >> 3, seg = C.tid & 7;
        float S[8];
#pragma unroll
        for (int j = 0; j < 8; ++j) S[j] = 0.f;
        const int hc = h * 64 + C.lane;
        const float kkw = k_k[hc], kaw = k_a[hc], rkw = r_k[hc];
        for (int s0 = 0; s0 < NSTEP; s0 += T) {
            for (int tt = C.wave; tt < T; tt += NWAVES) {
                const int row = rw_step_row(d, b, s0 + tt); const size_t o = (size_t)row * D + hc;
                const float kx = bf2f(((const GAS bf16_t*)Kb)[o]), rx = bf2f(((const GAS bf16_t*)Rb)[o]), vx = bf2f(((const GAS bf16_t*)Vb)[o]);
                const float lw = ((const GAS float*)DEC)[(size_t)d * MROWS * D + o], as = bf2f(((const GAS bf16_t*)ASIG)[(size_t)d * MROWS * D + o]);
                const float kk = kx * kkw; const float nrm = sqrtf(wave_sum(kk * kk)); const float kkn = kk / fmaxf(nrm, 1e-12f);
                const float kd = kx * (1.0f + (as - 1.0f) * kaw);
                const float bon = wave_sum(rx * kd * rkw);
                if (C.lane == 0) BON[((size_t)d * MROWS + row) * RW_H + h] = bon;
                const int li = tt * 64 + C.lane;
                sw[li] = __expf(lw); sa[li] = -kkn; sb[li] = kkn * as; sk[li] = kd; sr[li] = rx; sv[li] = vx;
            }
            __syncthreads();
#pragma unroll 2
            for (int tt = 0; tt < T; ++tt) {
                const LAS f32x4* pw = (const LAS f32x4*)(sw + tt * 64 + seg * 8); const LAS f32x4* pa = (const LAS f32x4*)(sa + tt * 64 + seg * 8); const LAS f32x4* pb = (const LAS f32x4*)(sb + tt * 64 + seg * 8);
                const LAS f32x4* pk = (const LAS f32x4*)(sk + tt * 64 + seg * 8); const LAS f32x4* pr = (const LAS f32x4*)(sr + tt * 64 + seg * 8);
                const f32x4 a0 = pa[0], a1 = pa[1], w0 = pw[0], w1 = pw[1], b0 = pb[0], b1 = pb[1], k0 = pk[0], k1 = pk[1], r0 = pr[0], r1 = pr[1];
                const float vv = sv[tt * 64 + v];
                float dot = (S[0] * a0.x + S[1] * a0.y) + (S[2] * a0.z + S[3] * a0.w) + (S[4] * a1.x + S[5] * a1.y) + (S[6] * a1.z + S[7] * a1.w);
                dot = sum8(dot);
                S[0] = S[0] * w0.x + dot * b0.x + vv * k0.x; S[1] = S[1] * w0.y + dot * b0.y + vv * k0.y; S[2] = S[2] * w0.z + dot * b0.z + vv * k0.z; S[3] = S[3] * w0.w + dot * b0.w + vv * k0.w;
                S[4] = S[4] * w1.x + dot * b1.x + vv * k1.x; S[5] = S[5] * w1.y + dot * b1.y + vv * k1.y; S[6] = S[6] * w1.z + dot * b1.z + vv * k1.z; S[7] = S[7] * w1.w + dot * b1.w + vv * k1.w;
                float y = (S[0] * r0.x + S[1] * r0.y) + (S[2] * r0.z + S[3] * r0.w) + (S[4] * r1.x + S[5] * r1.y) + (S[6] * r1.z + S[7] * r1.w);
                y = sum8(y);
                if (seg == 0) sy[tt * 64 + v] = y;
            }
            __syncthreads();
            for (int i = C.tid; i < T * 64; i += NTHR) { const int tt = i >> 6, c = i & 63; const int row = rw_step_row(d, b, s0 + tt); ((GAS float*)Y)[((size_t)d * MROWS + row) * D + h * 64 + c] = sy[i]; }
            __syncthreads();
        }
    }
}

__device__ __forceinline__ float dpp_rmirror(float v) { return __builtin_bit_cast(float, __builtin_amdgcn_update_dpp(0, __builtin_bit_cast(int, v), 0x140, 0xf, 0xf, false)); }
__device__ __forceinline__ float sum16(float v) { v += dpp_xor1(v); v += dpp_xor2(v); v += dpp_hmirror(v); v += dpp_rmirror(v); return v; }
__device__ __forceinline__ void ph_rw_scan_v2(const Ctx& C, const bf16_t* Rb, const bf16_t* Kb, const bf16_t* Vb, const float* DEC, const bf16_t* ASIG, const float* k_k, const float* k_a, const float* r_k, float* Y, float* BON) {
    constexpr int T = 32, NCH = NSTEP / T, BUF = 5 * T * 64 + T * 16;
    LAS float* base = (LAS float*)C.lds;
    LAS float* syb = base + 2 * BUF;
    for (int item = C.bid; item < 256; item += C.G) {
        const int chain = item >> 2, rq = item & 3, d = chain >> 5, b = (chain >> 4) & 1, h = chain & 15;
        const bool producer = C.wave >= 4;
        const int hc = h * 64 + C.lane;
        const float kkw = k_k[hc], kaw = k_a[hc], rkw = r_k[hc];
        const int vl = (C.tid & 255) >> 4, seg = C.tid & 15;
        float S0 = 0.f, S1 = 0.f, S2 = 0.f, S3 = 0.f;
        auto stage = [&](int cc) {
            LAS float* bw = base + (cc & 1) * BUF; LAS float* ba = bw + T * 64; LAS float* bb = ba + T * 64; LAS float* bk = bb + T * 64; LAS float* br = bk + T * 64; LAS float* bv = br + T * 64;
            const int pw = C.wave - 4;
            float kx[8], rx[8], lw[8], as[8], vx[8]; int rows[8];
#pragma unroll
            for (int q = 0; q < 8; ++q) { const int tt = pw * 8 + q; rows[q] = rw_step_row(d, b, cc * T + tt); const size_t o = (size_t)rows[q] * D + hc;
                kx[q] = bf2f(((const GAS bf16_t*)Kb)[o]); rx[q] = bf2f(((const GAS bf16_t*)Rb)[o]); lw[q] = ((const GAS float*)DEC)[(size_t)d * MROWS * D + o]; as[q] = bf2f(((const GAS bf16_t*)ASIG)[(size_t)d * MROWS * D + o]);
                vx[q] = C.lane < 16 ? bf2f(((const GAS bf16_t*)Vb)[(size_t)rows[q] * D + h * 64 + rq * 16 + C.lane]) : 0.f; }
#pragma unroll
            for (int q = 0; q < 8; ++q) { const int tt = pw * 8 + q;
                const float kk = kx[q] * kkw; const float nrm = sqrtf(wave_sum(kk * kk)); const float kkn = kk / fmaxf(nrm, 1e-12f);
                const float kd = kx[q] * (1.0f + (as[q] - 1.0f) * kaw);
                if (rq == 0) { const float bon = wave_sum(rx[q] * kd * rkw); if (C.lane == 0) BON[((size_t)d * MROWS + rows[q]) * RW_H + h] = bon; }
                const int li = tt * 64 + C.lane;
                bw[li] = __expf(lw[q]); ba[li] = -kkn; bb[li] = kkn * as[q]; bk[li] = kd; br[li] = rx[q];
                if (C.lane < 16) bv[tt * 16 + C.lane] = vx[q]; }
        };
        auto flush = [&](int cc) {
            const LAS float* sy = syb + (cc & 1) * T * 16; const int i0 = C.tid - 256;
#pragma unroll
            for (int q = 0; q < 2; ++q) { const int i = i0 + 256 * q, tt = i >> 4, c = i & 15; const int row = rw_step_row(d, b, cc * T + tt); ((GAS float*)Y)[((size_t)d * MROWS + row) * D + h * 64 + rq * 16 + c] = sy[i]; }
        };
        if (producer) stage(0);
        __syncthreads();
        for (int cc = 0; cc < NCH; ++cc) {
            if (producer) { if (cc + 1 < NCH) stage(cc + 1); if (cc >= 1) flush(cc - 1); }
            else {
                const LAS float* bw = base + (cc & 1) * BUF; const LAS float* ba = bw + T * 64; const LAS float* bb = ba + T * 64; const LAS float* bk = bb + T * 64; const LAS float* br = bk + T * 64; const LAS float* bv = br + T * 64;
                LAS float* sy = syb + (cc & 1) * T * 16;
#pragma unroll 4
                for (int tt = 0; tt < T; ++tt) {
                    const f32x4 a4 = *(const LAS f32x4*)(ba + tt * 64 + seg * 4), w4 = *(const LAS f32x4*)(bw + tt * 64 + seg * 4), b4 = *(const LAS f32x4*)(bb + tt * 64 + seg * 4), k4 = *(const LAS f32x4*)(bk + tt * 64 + seg * 4), r4 = *(const LAS f32x4*)(br + tt * 64 + seg * 4);
                    const float vv = bv[tt * 16 + vl];
                    float dot = (S0 * a4.x + S1 * a4.y) + (S2 * a4.z + S3 * a4.w);
                    dot = sum16(dot);
                    S0 = S0 * w4.x + (dot * b4.x + vv * k4.x); S1 = S1 * w4.y + (dot * b4.y + vv * k4.y); S2 = S2 * w4.z + (dot * b4.z + vv * k4.z); S3 = S3 * w4.w + (dot * b4.w + vv * k4.w);
                    float y = (S0 * r4.x + S1 * r4.y) + (S2 * r4.z + S3 * r4.w);
                    y = sum16(y);
                    if (seg == 0) sy[tt * 16 + vl] = y;
                }
            }
            __syncthreads();
        }
        if (producer) flush(NCH - 1);
        __syncthreads();
    }
}

__device__ __forceinline__ void ph_rw_post(const Ctx& C, const float* Y, const float* BON, const bf16_t* Vb, const bf16_t* Gb, const float* lnw, const float* lnb, bf16_t* YB) {
    const int gw = C.bid * NWAVES + C.wave, NGW = C.G * NWAVES, lane = C.lane;
    for (int r = gw; r < MROWS; r += NGW) {
        const GAS f32x4* y0 = (const GAS f32x4*)(Y + (size_t)r * D) + lane; const GAS f32x4* y1 = (const GAS f32x4*)(Y + ((size_t)MROWS + r) * D) + lane;
#pragma unroll
        for (int j = 0; j < 4; ++j) {
            const f32x4 y = y0[64 * j] + y1[64 * j];
            float s = (y.x + y.y) + (y.z + y.w);
            s += __shfl_xor(s, 1); s += __shfl_xor(s, 2); s += __shfl_xor(s, 4); s += __shfl_xor(s, 8);
            const float mean = s * (1.0f / 64.0f); const f32x4 dd = y - mean;
            float q = (dd.x * dd.x + dd.y * dd.y) + (dd.z * dd.z + dd.w * dd.w);
            q += __shfl_xor(q, 1); q += __shfl_xor(q, 2); q += __shfl_xor(q, 4); q += __shfl_xor(q, 8);
            const float rs = 1.0f / sqrtf(q * (1.0f / 64.0f) + 64e-5f);
            const int hd = 4 * j + (lane >> 4);
            const float bon = BON[(size_t)r * RW_H + hd] + BON[((size_t)MROWS + r) * RW_H + hd];
            const f32x4 lw = ((const GAS f32x4*)lnw + lane)[64 * j], lb = ((const GAS f32x4*)lnb + lane)[64 * j];
            const v2u vv = ((const GAS v2u*)(Vb + (size_t)r * D) + lane)[64 * j], gg = ((const GAS v2u*)(Gb + (size_t)r * D) + lane)[64 * j];
            const f32x4 vf = (f32x4){bflo(vv.x), bfhi(vv.x), bflo(vv.y), bfhi(vv.y)}, gf = (f32x4){bflo(gg.x), bfhi(gg.x), bflo(gg.y), bfhi(gg.y)};
            const f32x4 o = (dd * rs * lw + lb + vf * bon) * gf;
            v2u w; w.x = pk2(o.x, o.y); w.y = pk2(o.z, o.w); ((GAS v2u*)(YB + (size_t)r * D) + lane)[64 * j] = w;
        }
    }
}
constexpr int HG_H = 8, HG_DK = 128;
__device__ __forceinline__ void ph_hg_lb(const Ctx& C, const float* hg_lb, int layer, float* LB) {
    for (int i = C.bid * NTHR + C.tid; i < 2 * D; i += C.G * NTHR) {
        float x[DEPTH], mx = -3.0e38f;
#pragma unroll
        for (int l = 0; l < DEPTH; ++l) { x[l] = hg_lb[(size_t)l * 2 * D + i]; mx = fmaxf(mx, x[l]); }
        float den = 0.f, num = 0.f;
#pragma unroll
        for (int l = 0; l < DEPTH; ++l) { const float e = __expf(x[l] - mx); den += e; if (l >= 1 && l <= layer) num += e; }
        LB[i] = num / den;
    }
}
struct EpiHg {
    static constexpr bool PERM = false;
    bf16_t* QVG; float* FG; const float* LB;
    __device__ __forceinline__ void operator()(const AccT& acc, const Unit& u, int wr, int wc, int fr, int fq) const {
        const int row0 = u.pm * 256 + wr * 64 + fr, grp = u.pn >> 2, colt = (u.pn & 3) * 256 + wc * 32 + 4 * fq;
        const int isf = (grp == 1 || grp == 2) ? 1 : 0, d = grp == 2 ? 1 : 0, bsel = grp == 0 ? 0 : (grp == 3 ? 1 : 2), act = grp != 3;
#pragma unroll
        for (int ai = 0; ai < 2; ++ai)
#pragma unroll
            for (int m = 0; m < 4; ++m) { const size_t row = (size_t)(row0 + ai * 128 + m * 16);
#pragma unroll
                for (int bj = 0; bj < 2; ++bj)
#pragma unroll
                    for (int n = 0; n < 2; ++n) { const int col = colt + bj * 128 + n * 16; const f32x4 x = acc[ai][bj][m][n];
                        if (isf) { const f32x4 lb = *(const GAS f32x4*)((const GAS float*)LB + d * D + col); f32x4 o;
#pragma unroll
                            for (int j = 0; j < 4; ++j) o[j] = lb[j] + (1.0f - lb[j]) * sigmoidf_(x[j]);
                            *(GAS f32x4*)((GAS float*)FG + ((size_t)d * MROWS + row) * D + col) = o; }
                        else { v2u w; if (act) { w.x = pk2(siluf_(x[0]), siluf_(x[1])); w.y = pk2(siluf_(x[2]), siluf_(x[3])); } else { w.x = pk2(x[0], x[1]); w.y = pk2(x[2], x[3]); }
                            *(GAS v2u*)((GAS bf16_t*)QVG + ((size_t)bsel * MROWS + row) * D + col) = w; } }
                asm volatile("" ::: "memory"); }
    }
};
__device__ __forceinline__ void ph_hg_scan_seq(const Ctx& C, const bf16_t* QVG, const float* FG, float* O) {
    constexpr int T = 32;
    LAS float* sf = (LAS float*)C.lds;
    LAS float* sk = sf + T * 128; LAS float* sq = sk + T * 128; LAS float* sv = sq + T * 128; LAS float* so = sv + T * 64;
    const bf16_t* Qb = QVG; const bf16_t* Vb = QVG + (size_t)MROWS * D;
    for (int item = C.bid; item < 64; item += C.G) {
        const int chain = item >> 1, vh = item & 1, d = chain >> 4, b = (chain >> 3) & 1, h = chain & 7;
        const int v = C.tid >> 3, seg = C.tid & 7;
        float S[16];
#pragma unroll
        for (int j = 0; j < 16; ++j) S[j] = 0.f;
        for (int s0 = 0; s0 < NSTEP; s0 += T) {
            for (int i = C.tid; i < T * 128; i += NTHR) { const int tt = i >> 7, c = i & 127; const int row = rw_step_row(d, b, s0 + tt); const size_t o = (size_t)row * D + h * 128 + c;
                const float f = ((const GAS float*)FG)[(size_t)d * MROWS * D + o]; sf[i] = f; sk[i] = 1.0f - f; sq[i] = bf2f(((const GAS bf16_t*)Qb)[o]);
                if ((c >> 6) == vh) sv[tt * 64 + (c & 63)] = bf2f(((const GAS bf16_t*)Vb)[o]); }
            __syncthreads();
#pragma unroll 2
            for (int tt = 0; tt < T; ++tt) {
                const LAS f32x4* pf = (const LAS f32x4*)(sf + tt * 128 + seg * 16); const LAS f32x4* pk = (const LAS f32x4*)(sk + tt * 128 + seg * 16); const LAS f32x4* pq = (const LAS f32x4*)(sq + tt * 128 + seg * 16);
                const float vv = sv[tt * 64 + v]; float y = 0.f;
#pragma unroll
                for (int jj = 0; jj < 4; ++jj) { const f32x4 f = pf[jj], k = pk[jj], q = pq[jj];
#pragma unroll
                    for (int i = 0; i < 4; ++i) { S[4 * jj + i] = S[4 * jj + i] * f[i] + k[i] * vv; y += S[4 * jj + i] * q[i]; } }
                y = sum8(y);
                if (seg == 0) so[tt * 64 + v] = y;
            }
            __syncthreads();
            for (int i = C.tid; i < T * 64; i += NTHR) { const int tt = i >> 6, c = i & 63; const int row = rw_step_row(d, b, s0 + tt); ((GAS float*)O)[((size_t)d * MROWS + row) * D + h * 128 + vh * 64 + c] = so[i]; }
            __syncthreads();
        }
    }
}
__device__ __forceinline__ void ph_hg_scan_v2(const Ctx& C, const bf16_t* QVG, const float* FG, float* O) {
    constexpr int T = 32, NCH = NSTEP / T, BUF = 2 * T * 128 + T * 16;
    LAS float* base = (LAS float*)C.lds;
    LAS float* syb = base + 2 * BUF;
    const bf16_t* Qb = QVG; const bf16_t* Vb = QVG + (size_t)MROWS * D;
    for (int item = C.bid; item < 256; item += C.G) {
        const int chain = item >> 3, ve = item & 7, d = chain >> 4, b = (chain >> 3) & 1, h = chain & 7;
        const bool producer = C.wave >= 4;
        const int vl = (C.tid & 255) >> 4, seg = C.tid & 15;
        float S[8];
#pragma unroll
        for (int j = 0; j < 8; ++j) S[j] = 0.f;
        auto stage = [&](int cc) {
            LAS float* bf = base + (cc & 1) * BUF; LAS float* bq = bf + T * 128; LAS float* bv = bq + T * 128;
            const int pw = C.wave - 4;
            float f0[8], f1[8], q0[8], q1[8], vx[8];
#pragma unroll
            for (int q = 0; q < 8; ++q) { const int tt = pw * 8 + q; const int row = rw_step_row(d, b, cc * T + tt); const size_t o = (size_t)row * D + h * 128 + C.lane;
                f0[q] = ((const GAS float*)FG)[(size_t)d * MROWS * D + o]; f1[q] = ((const GAS float*)FG)[(size_t)d * MROWS * D + o + 64];
                q0[q] = bf2f(((const GAS bf16_t*)Qb)[o]); q1[q] = bf2f(((const GAS bf16_t*)Qb)[o + 64]);
                vx[q] = C.lane < 16 ? bf2f(((const GAS bf16_t*)Vb)[(size_t)row * D + h * 128 + ve * 16 + C.lane]) : 0.f; }
#pragma unroll
            for (int q = 0; q < 8; ++q) { const int tt = pw * 8 + q; bf[tt * 128 + C.lane] = f0[q]; bf[tt * 128 + 64 + C.lane] = f1[q]; bq[tt * 128 + C.lane] = q0[q]; bq[tt * 128 + 64 + C.lane] = q1[q]; if (C.lane < 16) bv[tt * 16 + C.lane] = vx[q]; }
        };
        auto flush = [&](int cc) {
            const LAS float* sy = syb + (cc & 1) * T * 16; const int i0 = C.tid - 256;
#pragma unroll
            for (int q = 0; q < 2; ++q) { const int i = i0 + 256 * q, tt = i >> 4, c = i & 15; const int row = rw_step_row(d, b, cc * T + tt); ((GAS float*)O)[((size_t)d * MROWS + row) * D + h * 128 + ve * 16 + c] = sy[i]; }
        };
        if (producer) stage(0);
        __syncthreads();
        for (int cc = 0; cc < NCH; ++cc) {
            if (producer) { if (cc + 1 < NCH) stage(cc + 1); if (cc >= 1) flush(cc - 1); }
            else {
                const LAS float* bf = base + (cc & 1) * BUF; const LAS float* bq = bf + T * 128; const LAS float* bv = bq + T * 128;
                LAS float* sy = syb + (cc & 1) * T * 16;
#pragma unroll 4
                for (int tt = 0; tt < T; ++tt) {
                    const f32x4 fa = *(const LAS f32x4*)(bf + tt * 128 + seg * 8), fb = *(const LAS f32x4*)(bf + tt * 128 + seg * 8 + 4), qa = *(const LAS f32x4*)(bq + tt * 128 + seg * 8), qb = *(const LAS f32x4*)(bq + tt * 128 + seg * 8 + 4);
                    const float vv = bv[tt * 16 + vl];
#pragma unroll
                    for (int i = 0; i < 4; ++i) { S[i] = S[i] * fa[i] + (1.0f - fa[i]) * vv; S[4 + i] = S[4 + i] * fb[i] + (1.0f - fb[i]) * vv; }
                    float y = ((S[0] * qa.x + S[1] * qa.y) + (S[2] * qa.z + S[3] * qa.w)) + ((S[4] * qb.x + S[5] * qb.y) + (S[6] * qb.z + S[7] * qb.w));
                    y = sum16(y);
                    if (seg == 0) sy[tt * 16 + vl] = y;
                }
            }
            __syncthreads();
        }
        if (producer) flush(NCH - 1);
        __syncthreads();
    }
}
__device__ __forceinline__ void ph_hg_post(const Ctx& C, const float* O, const bf16_t* GS, const float* gn, bf16_t* YB) {
    const int gw = C.bid * NWAVES + C.wave, NGW = C.G * NWAVES, lane = C.lane;
    for (int r = gw; r < MROWS; r += NGW) {
        const GAS f32x4* o0 = (const GAS f32x4*)(O + (size_t)r * D) + lane; const GAS f32x4* o1 = (const GAS f32x4*)(O + ((size_t)MROWS + r) * D) + lane;
#pragma unroll
        for (int j = 0; j < 4; ++j) {
            const f32x4 y = o0[64 * j] + o1[64 * j];
            float q = (y.x * y.x + y.y * y.y) + (y.z * y.z + y.w * y.w);
            q += __shfl_xor(q, 1); q += __shfl_xor(q, 2); q += __shfl_xor(q, 4); q += __shfl_xor(q, 8); q += __shfl_xor(q, 16);
            const float rs = 1.0f / sqrtf(q * (1.0f / 128.0f) + NORM_EPS);
            const f32x4 gw4 = ((const GAS f32x4*)gn)[(lane & 31)];
            const v2u gg = ((const GAS v2u*)(GS + (size_t)r * D) + lane)[64 * j];
            const f32x4 gf = (f32x4){bflo(gg.x), bfhi(gg.x), bflo(gg.y), bfhi(gg.y)};
            const f32x4 o = y * rs * gw4 * gf;
            v2u w; w.x = pk2(o.x, o.y); w.y = pk2(o.z, o.w); ((GAS v2u*)(YB + (size_t)r * D) + lane)[64 * j] = w;
        }
    }
}
constexpr int MOE_MAXROWS = 68608;
constexpr int MOE_MAXT = MOE_MAXROWS / 256;

__device__ __forceinline__ void ph_moe_route(const Ctx& C, const float* res, const float* g, const float* modl, const float* router, bf16_t* H2, int* TOKE, float* TOKG, int* BCNT) {
    LAS float* rt = (LAS float*)C.lds;
    LAS int* cnt = (LAS int*)(rt + D * NEXP);
    for (int i = C.tid; i < D * NEXP; i += NTHR) rt[i] = router[i];
    if (C.tid < NEXP) cnt[C.tid] = 0;
    __syncthreads();
    const int gw = C.bid * NWAVES + C.wave, NGW = C.G * NWAVES, lane = C.lane;
    for (int r = gw; r < MROWS; r += NGW) {
        f32x4 v[4]; load_row(res + (size_t)r * D, lane, v); const float s = row_rstd(v);
        const int b = row_bidx(r);
        const GAS f32x4* g4 = (const GAS f32x4*)g + lane; const GAS f32x4* sh4 = (const GAS f32x4*)(modl + (size_t)(b * 6 + 3) * D) + lane; const GAS f32x4* sc4 = (const GAS f32x4*)(modl + (size_t)(b * 6 + 4) * D) + lane;
        GAS v2u* o = (GAS v2u*)(H2 + (size_t)r * D) + lane;
        float lg[NEXP];
#pragma unroll
        for (int e = 0; e < NEXP; ++e) lg[e] = 0.f;
#pragma unroll
        for (int j = 0; j < 4; ++j) { const f32x4 h = v[j] * s * g4[64 * j] * (sc4[64 * j] + 1.0f) + sh4[64 * j];
            v2u w; w.x = pk2(h.x, h.y); w.y = pk2(h.z, h.w); o[64 * j] = w;
#pragma unroll
            for (int i = 0; i < 4; ++i) { const LAS f32x4* rr = (const LAS f32x4*)(rt + (size_t)(256 * j + 4 * lane + i) * NEXP); const f32x4 r0 = rr[0], r1 = rr[1]; const float hv = h[i];
                lg[0] += hv * r0.x; lg[1] += hv * r0.y; lg[2] += hv * r0.z; lg[3] += hv * r0.w; lg[4] += hv * r1.x; lg[5] += hv * r1.y; lg[6] += hv * r1.z; lg[7] += hv * r1.w; } }
#pragma unroll
        for (int e = 0; e < NEXP; ++e) lg[e] = wave_sum(lg[e]);
        int i0 = 0; float l0 = lg[0];
#pragma unroll
        for (int e = 1; e < NEXP; ++e) if (lg[e] > l0) { l0 = lg[e]; i0 = e; }
        int i1 = -1; float l1 = -3.0e38f;
#pragma unroll
        for (int e = 0; e < NEXP; ++e) if (e != i0 && lg[e] > l1) { l1 = lg[e]; i1 = e; }
        const float g0 = 1.0f / (1.0f + __expf(l1 - l0));
        if (lane == 0) { TOKE[2 * r] = i0; TOKE[2 * r + 1] = i1; TOKG[2 * r] = g0; TOKG[2 * r + 1] = 1.0f - g0; __hip_atomic_fetch_add(&cnt[i0], 1, __ATOMIC_RELAXED, __HIP_MEMORY_SCOPE_WORKGROUP); __hip_atomic_fetch_add(&cnt[i1], 1, __ATOMIC_RELAXED, __HIP_MEMORY_SCOPE_WORKGROUP); }
    }
    __syncthreads();
    if (C.tid < NEXP) BCNT[C.bid * NEXP + C.tid] = cnt[C.tid];
    __syncthreads();
}
__device__ __forceinline__ void ph_moe_scatter(const Ctx& C, const bf16_t* H2, const int* TOKE, const int* BCNT, int* DEST, int* TILE, bf16_t* ABUF) {
    LAS int* cur = (LAS int*)C.lds;
    if (C.tid < NEXP) { int tot = 0, mine = 0; for (int b = 0; b < C.G; ++b) { const int c = BCNT[b * NEXP + C.tid]; tot += c; mine += (b < C.bid) ? c : 0; } cur[16 + C.tid] = tot; cur[24 + C.tid] = mine; }
    __syncthreads();
    if (C.tid == 0) { int st = 0; for (int e = 0; e < NEXP; ++e) { const int nt = (cur[16 + e] + 255) >> 8; cur[8 + e] = st; cur[e] = st * 256 + cur[24 + e]; if (C.bid == 0) for (int q = 0; q < nt; ++q) TILE[st + q] = e; st += nt; } if (C.bid == 0) TILE[MOE_MAXT] = st; }
    __syncthreads();
    const int gw = C.bid * NWAVES + C.wave, NGW = C.G * NWAVES, lane = C.lane;
    for (int r = gw; r < MROWS; r += NGW) {
        int p0 = 0, p1 = 0;
        if (lane == 0) { p0 = __hip_atomic_fetch_add(&cur[TOKE[2 * r]], 1, __ATOMIC_RELAXED, __HIP_MEMORY_SCOPE_WORKGROUP); p1 = __hip_atomic_fetch_add(&cur[TOKE[2 * r + 1]], 1, __ATOMIC_RELAXED, __HIP_MEMORY_SCOPE_WORKGROUP); DEST[2 * r] = p0; DEST[2 * r + 1] = p1; }
        p0 = __shfl(p0, 0); p1 = __shfl(p1, 0);
        const GAS v4u* src = (const GAS v4u*)(H2 + (size_t)r * D) + lane; const v4u a = src[0], b = src[64];
        GAS v4u* d0 = (GAS v4u*)(ABUF + (size_t)p0 * D) + lane; GAS v4u* d1 = (GAS v4u*)(ABUF + (size_t)p1 * D) + lane;
        d0[0] = a; d0[64] = b; d1[0] = a; d1[64] = b;
    }
}
struct SchedMoe {
    const bf16_t* A; const bf16_t* Bt; const int* TILE; int lda, ldb, npl  , G, c;
    __device__ __forceinline__ bool next(int i, Unit& u) const { const int nt = TILE[MOE_MAXT]; const long L = (long)i * G + c; if (L >= (long)nt * npl) return false;
        u.pm = (int)(L / npl); u.aux = (int)(L % npl); u.pn = TILE[u.pm] * npl + u.aux; return true; }
    __device__ __forceinline__ const char* a_ptr(const Unit& u) const { return (const char*)(A + (size_t)u.pm * 256 * lda); }
    __device__ __forceinline__ const char* b_ptr(const Unit& u) const { return (const char*)(Bt + (size_t)u.pn * 256 * ldb); }
};
__device__ __forceinline__ void ph_moe_combine(const Ctx& C, float* res, const float* modl, const float* OUT, const int* DEST, const float* TOKG) {
    const int gw = C.bid * NWAVES + C.wave, NGW = C.G * NWAVES, lane = C.lane;
    for (int r = gw; r < MROWS; r += NGW) {
        const int d0 = DEST[2 * r], d1 = DEST[2 * r + 1]; const float g0 = TOKG[2 * r], g1 = TOKG[2 * r + 1]; const int b = row_bidx(r);
        const GAS f32x4* o0 = (const GAS f32x4*)(OUT + (size_t)d0 * D) + lane; const GAS f32x4* o1 = (const GAS f32x4*)(OUT + (size_t)d1 * D) + lane;
        const GAS f32x4* gt = (const GAS f32x4*)(modl + (size_t)(b * 6 + 5) * D) + lane; GAS f32x4* rp = (GAS f32x4*)(res + (size_t)r * D) + lane;
#pragma unroll
        for (int j = 0; j < 4; ++j) rp[64 * j] = rp[64 * j] + gt[64 * j] * (o0[64 * j] * g0 + o1[64 * j] * g1);
    }
}
constexpr size_t HY_H = 0;
constexpr size_t HY_PROJT = al256(HY_H + SZ_ACT_BF);
constexpr size_t HY_HB = al256(HY_PROJT + (size_t)3 * D * MROWS * 4);
constexpr size_t HY_FILT = al256(HY_HB + (size_t)HY_NPOS * 256 * 2);
constexpr size_t HY_YT = al256(HY_FILT + (size_t)4096 * HY_NPOS * 4);
constexpr size_t HY_YB = al256(HY_YT + (size_t)D * MROWS * 4);
constexpr size_t HY_SCR = al256(HY_YB + SZ_ACT_BF);
constexpr size_t HY_END = HY_SCR + (size_t)256 * 3 * FN * 8;
static_assert(HY_END <= ARENA_BYTES, "hyena arena");
constexpr size_t HYW_WIN = 0, HYW_WO = (size_t)3 * D * D * 2;

__device__ __forceinline__ void hy_phase_a(const Ctx& C, const Args& args, unsigned char* ws, int layer) {
    bf16_t* WinT = (bf16_t*)(ws + WS_WREG + HYW_WIN); bf16_t* WoT = (bf16_t*)(ws + WS_WREG + HYW_WO);
    const CvtJob jobs[2] = { {args.in[I_HY_WIN], WinT, D, 3 * D, 3 * D, D, 0, 0, 3 * D, 0}, {args.in[I_HY_WO], WoT, D, D, D, D, 0, 0, D, 0} };
    cvt_run(C, jobs);
    ph_hy_w4split(C, args.in[I_HY_FW4], (bf16_t*)(ws + WS_ZREG + Z_AW));
    ph_hy_filter_mlp(C, args.in[I_HY_FW1], args.in[I_HY_FB1], args.in[I_HY_FW2], args.in[I_HY_FB2], args.in[I_HY_FW3], args.in[I_HY_FB3], args.in[I_HY_FREQ], (bf16_t*)(ws + WS_ARENA + HY_HB));
    ph_norm_mod_bf16(C, (const float*)(ws + WS_RES), args.in[I_NORMG] + (size_t)(layer * 2 + 0) * D, (const float*)(ws + WS_MOD) + (size_t)layer * 18 * D, 0, 1, (bf16_t*)(ws + WS_ARENA + HY_H));
}
__device__ __forceinline__ void hy_phase_b(const Ctx& C, const Args& args, unsigned char* ws) {
    {   SchedPlain S{(const bf16_t*)(ws + WS_WREG + HYW_WIN), (const bf16_t*)(ws + WS_ARENA + HY_H), D, D, 3 * D / 256, PMT, C.G, C.bid};
        EpiF32RowBias E{(float*)(ws + WS_ARENA + HY_PROJT), MROWS, args.in[I_HY_BIN]};
        pg8::gemm_phase(C.lds, D, D, D, S, E); }
    {   SchedPlain S{(const bf16_t*)(ws + WS_ZREG + Z_AW), (const bf16_t*)(ws + WS_ARENA + HY_HB), 256, 256, 4096 / 256, HY_NPOS / 256, C.G, C.bid};
        EpiHyFilt E{(float*)(ws + WS_ARENA + HY_FILT)};
        pg8::gemm_phase(C.lds, 256, 256, 256, S, E); }
}
__device__ __forceinline__ void hy_phase_wo(const Ctx& C, const Args& args, unsigned char* ws, int layer) {
    SchedPlain S{(const bf16_t*)(ws + WS_ARENA + HY_YB), (const bf16_t*)(ws + WS_WREG + HYW_WO), D, D, PMT, D / 256, C.G, C.bid};
    EpiRes E{(float*)(ws + WS_RES), (const float*)(ws + WS_MOD) + (size_t)layer * 18 * D, 2, args.in[I_HY_BO]};
    pg8::gemm_phase(C.lds, D, D, D, S, E);
}

constexpr size_t RW_X6 = 0;
constexpr size_t RW_Y = 0;
constexpr size_t RW_YB = al256(RW_Y + 2 * SZ_ACT_F32);
constexpr size_t RW_RKV = al256(RW_X6 + 6 * SZ_ACT_BF);
constexpr size_t RW_LD = al256(RW_RKV + 3 * SZ_ACT_BF);
constexpr size_t RW_DEC = al256(RW_LD + SZ_ACT_BF);
constexpr size_t RW_ASIG = al256(RW_DEC + 2 * SZ_ACT_F32);
constexpr size_t RW_G = al256(RW_ASIG + 2 * SZ_ACT_BF);
constexpr size_t RW_BON = al256(RW_G + SZ_ACT_BF);
constexpr size_t RW_END = RW_BON + (size_t)2 * MROWS * RW_H * 4;
static_assert(RW_YB + SZ_ACT_BF <= RW_RKV && RW_END <= ARENA_BYTES, "rwkv arena");
constexpr size_t RWW_RKV = 0, RWW_WO = (size_t)3 * D * D * 2;

struct RwP { int layer, slot; };
__device__ __forceinline__ bf16_t* rw_vbuf(unsigned char* ws, int slot) { return slot == 0 ? (bf16_t*)(ws + WS_VFIRST) : (bf16_t*)(ws + WS_ARENA + RW_RKV + 2 * SZ_ACT_BF); }

__device__ __forceinline__ void rw_phase_a(const Ctx& C, const Args& args, unsigned char* ws, int layer, int slot) {
    bf16_t* Wrkv = (bf16_t*)(ws + WS_WREG + RWW_RKV); bf16_t* WoT = (bf16_t*)(ws + WS_WREG + RWW_WO);
    bf16_t* Ldn = (bf16_t*)(ws + WS_ZREG + slot * Z_SLOT + Z_LDN); bf16_t* Lup = (bf16_t*)(ws + WS_ZREG + slot * Z_SLOT + Z_LUP);
    const float* wrkv = args.in[I_RW_WRKV] + (size_t)slot * 3 * D * D;
    const float* w1 = args.in[I_RW_W1] + (size_t)slot * 2 * D * 64; const float* a1 = args.in[I_RW_A1] + (size_t)slot * 2 * D * 64;
    const float* w2 = args.in[I_RW_W2] + (size_t)slot * 2 * 64 * D; const float* a2 = args.in[I_RW_A2] + (size_t)slot * 2 * 64 * D;
    const CvtJob jobs[14] = {
        {wrkv, Wrkv, D, D, D, D, 0, 0, D, 0}, {wrkv + (size_t)D * D, Wrkv, D, D, D, D, D, 0, D, 0}, {wrkv + (size_t)2 * D * D, Wrkv, D, D, D, D, 2 * D, 0, D, 0},
        {args.in[I_RW_WO] + (size_t)slot * D * D, WoT, D, D, D, D, 0, 0, D, 0},
        {w1, Ldn, D, 64, 64, D, 0, 0, 64, 0}, {w1 + (size_t)D * 64, Ldn, D, 64, 64, D, 64, 0, 64, 0},
        {a1, Ldn, D, 64, 64, D, 256, 0, 64, 0}, {a1 + (size_t)D * 64, Ldn, D, 64, 64, D, 256 + 64, 0, 64, 0},
        {args.in[I_RW_G1] + (size_t)slot * D * 160, Ldn, D, 160, 160, D, 512, 0, 160, 0},
        {w2, Lup, 64, D, D, 256, 0, 0, D, 0}, {w2 + (size_t)64 * D, Lup, 64, D, D, 256, D, 64, D, 0},
        {a2, Lup, 64, D, D, 256, 2 * D, 0, D, 0}, {a2 + (size_t)64 * D, Lup, 64, D, D, 256, 3 * D, 64, D, 0},
        {args.in[I_RW_G2] + (size_t)slot * 160 * D, Lup, 160, D, D, 256, 4 * D, 0, D, 0} };
    cvt_run(C, jobs);
    if (slot > 0) { const CvtJob jv[2] = { {args.in[I_RW_V1] + (size_t)(slot - 1) * D * 32, Ldn, D, 32, 32, D, 768, 0, 32, 0}, {args.in[I_RW_V2] + (size_t)(slot - 1) * 32 * D, Lup, 32, D, D, 256, 5 * D, 0, D, 0} }; cvt_run(C, jv); }
    ph_rstd(C, (const float*)(ws + WS_RES), (float*)(ws + WS_RSTD));
}
__device__ __forceinline__ void rw_phase_mix(const Ctx& C, const Args& args, unsigned char* ws, int layer, int slot) {
    ph_rw_mix(C, (const float*)(ws + WS_RES), (const float*)(ws + WS_RSTD), args.in[I_NORMG] + (size_t)(layer * 2) * D, (const float*)(ws + WS_MOD) + (size_t)layer * 18 * D, args.in[I_RW_MU] + (size_t)slot * 6 * D, (bf16_t*)(ws + WS_ARENA + RW_X6));
}
__device__ __forceinline__ void rw_phase_g1(const Ctx& C, const Args& args, unsigned char* ws, int layer, int slot) {
    SchedRw1 S{(const bf16_t*)(ws + WS_ARENA + RW_X6), (const bf16_t*)(ws + WS_WREG + RWW_RKV), (const bf16_t*)(ws + WS_ZREG + slot * Z_SLOT + Z_LDN), slot > 0 ? 16 : 15, C.G, C.bid};
    EpiRw1 E{(bf16_t*)(ws + WS_ARENA + RW_RKV), (bf16_t*)(ws + WS_ARENA + RW_RKV + SZ_ACT_BF), rw_vbuf(ws, slot), (bf16_t*)(ws + WS_ARENA + RW_LD)};
    pg8::gemm_phase(C.lds, D, D, D, S, E);
}
__device__ __forceinline__ void rw_phase_g2(const Ctx& C, const Args& args, unsigned char* ws, int layer, int slot) {
    SchedRw2 S{(const bf16_t*)(ws + WS_ARENA + RW_LD), (const bf16_t*)(ws + WS_ZREG + slot * Z_SLOT + Z_LUP), slot > 0 ? 24 : 20, C.G, C.bid};
    EpiRw2 E{(float*)(ws + WS_ARENA + RW_DEC), (bf16_t*)(ws + WS_ARENA + RW_ASIG), (bf16_t*)(ws + WS_ARENA + RW_G), rw_vbuf(ws, slot), (const bf16_t*)(ws + WS_VFIRST),
             args.in[I_RW_W0] + (size_t)slot * 2 * D, args.in[I_RW_A0] + (size_t)slot * 2 * D, args.in[I_RW_V0] + (size_t)(slot > 0 ? slot - 1 : 0) * D};
    pg8::gemm_phase(C.lds, 256, D, 256, S, E);
}
__device__ __forceinline__ void rw_phase_scan(const Ctx& C, const Args& args, unsigned char* ws, int layer, int slot) {
    ph_rw_scan_v2(C, (const bf16_t*)(ws + WS_ARENA + RW_RKV), (const bf16_t*)(ws + WS_ARENA + RW_RKV + SZ_ACT_BF), rw_vbuf(ws, slot), (const float*)(ws + WS_ARENA + RW_DEC), (const bf16_t*)(ws + WS_ARENA + RW_ASIG),
                   args.in[I_RW_KK] + (size_t)slot * D, args.in[I_RW_KA] + (size_t)slot * D, args.in[I_RW_RK] + (size_t)slot * D, (float*)(ws + WS_ARENA + RW_Y), (float*)(ws + WS_ARENA + RW_BON));
}
__device__ __forceinline__ void rw_phase_post(const Ctx& C, const Args& args, unsigned char* ws, int layer, int slot) {
    ph_rw_post(C, (const float*)(ws + WS_ARENA + RW_Y), (const float*)(ws + WS_ARENA + RW_BON), rw_vbuf(ws, slot), (const bf16_t*)(ws + WS_ARENA + RW_G), args.in[I_RW_LNW] + (size_t)slot * D, args.in[I_RW_LNB] + (size_t)slot * D, (bf16_t*)(ws + WS_ARENA + RW_YB));
}
__device__ __forceinline__ void rw_phase_wo(const Ctx& C, const Args& args, unsigned char* ws, int layer, int slot) {
    SchedPlain S{(const bf16_t*)(ws + WS_ARENA + RW_YB), (const bf16_t*)(ws + WS_WREG + RWW_WO), D, D, PMT, D / 256, C.G, C.bid};
    EpiRes E{(float*)(ws + WS_RES), (const float*)(ws + WS_MOD) + (size_t)layer * 18 * D, 2, nullptr};
    pg8::gemm_phase(C.lds, D, D, D, S, E);
}

constexpr size_t FF_H2 = 0, FF_ACT = al256(SZ_ACT_BF);
constexpr size_t FFW_13 = 0, FFW_2 = (size_t)2 * FFN * D * 2;
__device__ __forceinline__ void ff_phase_a(const Ctx& C, const Args& args, unsigned char* ws, int layer) {
    const float* w13 = args.in[I_FFN_W13] + (size_t)(layer / 2) * D * 2 * FFN; const float* w2 = args.in[I_FFN_W2] + (size_t)(layer / 2) * FFN * D;
    bf16_t* W13T = (bf16_t*)(ws + WS_WREG + FFW_13); bf16_t* W2T = (bf16_t*)(ws + WS_WREG + FFW_2);
    const CvtJob jobs[3] = { {w13, W13T, D, FFN, 2 * FFN, D, 0, 0, 128, 256}, {w13 + FFN, W13T, D, FFN, 2 * FFN, D, 128, 0, 128, 256}, {w2, W2T, FFN, D, D, FFN, 0, 0, D, 0} };
    cvt_run(C, jobs);
    ph_norm_mod_bf16(C, (const float*)(ws + WS_RES), args.in[I_NORMG] + (size_t)(layer * 2 + 1) * D, (const float*)(ws + WS_MOD) + (size_t)layer * 18 * D, 3, 4, (bf16_t*)(ws + WS_ARENA + FF_H2));
}
__device__ __forceinline__ void ff_phase_g1(const Ctx& C, unsigned char* ws) {
    SchedPlain S{(const bf16_t*)(ws + WS_ARENA + FF_H2), (const bf16_t*)(ws + WS_WREG + FFW_13), D, D, PMT, 2 * FFN / 256, C.G, C.bid};
    EpiSwiGLU E{(bf16_t*)(ws + WS_ARENA + FF_ACT), FFN};
    pg8::gemm_phase(C.lds, D, D, D, S, E);
}
__device__ __forceinline__ void ff_phase_g2(const Ctx& C, unsigned char* ws, int layer) {
    SchedPlain S{(const bf16_t*)(ws + WS_ARENA + FF_ACT), (const bf16_t*)(ws + WS_WREG + FFW_2), FFN, FFN, PMT, D / 256, C.G, C.bid};
    EpiRes E{(float*)(ws + WS_RES), (const float*)(ws + WS_MOD) + (size_t)layer * 18 * D, 5, nullptr};
    pg8::gemm_phase(C.lds, FFN, FFN, FFN, S, E);
}
constexpr size_t MO_H2 = 0;
constexpr size_t MO_ABUF = al256(MO_H2 + SZ_ACT_BF);
constexpr size_t MO_ACT = al256(MO_ABUF + (size_t)MOE_MAXROWS * D * 2);
constexpr size_t MO_OUT = al256(MO_ACT + (size_t)MOE_MAXROWS * EDIM * 2);
constexpr size_t MO_TOKE = al256(MO_OUT + (size_t)MOE_MAXROWS * D * 4);
constexpr size_t MO_TOKG = al256(MO_TOKE + (size_t)MROWS * 8);
constexpr size_t MO_DEST = al256(MO_TOKG + (size_t)MROWS * 8);
constexpr size_t MO_BCNT = al256(MO_DEST + (size_t)MROWS * 8);
constexpr size_t MO_TILE = al256(MO_BCNT + (size_t)1024 * NEXP * 4);
constexpr size_t MO_END = MO_TILE + 4096;
static_assert(MO_END <= ARENA_BYTES, "moe arena");
constexpr size_t MOW_13 = 0, MOW_2 = (size_t)NEXP * 2 * EDIM * D * 2;
static_assert(MOW_2 + (size_t)NEXP * D * EDIM * 2 <= WREG_BYTES, "moe weights");
__device__ __forceinline__ void mo_phase_a(const Ctx& C, const Args& args, unsigned char* ws, int layer) {
    const float* w13 = args.in[I_MOE_W13] + (size_t)(layer / 2) * NEXP * D * 2 * EDIM; const float* w2 = args.in[I_MOE_W2] + (size_t)(layer / 2) * NEXP * EDIM * D;
    bf16_t* W13T = (bf16_t*)(ws + WS_WREG + MOW_13); bf16_t* W2T = (bf16_t*)(ws + WS_WREG + MOW_2);
#pragma unroll 1
    for (int e = 0; e < NEXP; ++e) {
        const CvtJob jobs[3] = { {w13 + (size_t)e * D * 2 * EDIM, W13T + (size_t)e * 2 * EDIM * D, D, EDIM, 2 * EDIM, D, 0, 0, 128, 256}, {w13 + (size_t)e * D * 2 * EDIM + EDIM, W13T + (size_t)e * 2 * EDIM * D, D, EDIM, 2 * EDIM, D, 128, 0, 128, 256},
                                 {w2 + (size_t)e * EDIM * D, W2T + (size_t)e * D * EDIM, EDIM, D, D, EDIM, 0, 0, D, 0} };
        cvt_run(C, jobs); }
    ph_moe_route(C, (const float*)(ws + WS_RES), args.in[I_NORMG] + (size_t)(layer * 2 + 1) * D, (const float*)(ws + WS_MOD) + (size_t)layer * 18 * D, args.in[I_MOE_ROUTER] + (size_t)(layer / 2) * D * NEXP,
                 (bf16_t*)(ws + WS_ARENA + MO_H2), (int*)(ws + WS_ARENA + MO_TOKE), (float*)(ws + WS_ARENA + MO_TOKG), (int*)(ws + WS_ARENA + MO_BCNT));
}
__device__ __forceinline__ void mo_phase_b(const Ctx& C, unsigned char* ws) {
    ph_moe_scatter(C, (const bf16_t*)(ws + WS_ARENA + MO_H2), (const int*)(ws + WS_ARENA + MO_TOKE), (const int*)(ws + WS_ARENA + MO_BCNT), (int*)(ws + WS_ARENA + MO_DEST), (int*)(ws + WS_ARENA + MO_TILE), (bf16_t*)(ws + WS_ARENA + MO_ABUF));
}
__device__ __forceinline__ void mo_phase_g1(const Ctx& C, unsigned char* ws) {
    SchedMoe S{(const bf16_t*)(ws + WS_ARENA + MO_ABUF), (const bf16_t*)(ws + WS_WREG + MOW_13), (const int*)(ws + WS_ARENA + MO_TILE), D, D, 2 * EDIM / 256, C.G, C.bid};
    EpiSwiGLU E{(bf16_t*)(ws + WS_ARENA + MO_ACT), EDIM};
    pg8::gemm_phase(C.lds, D, D, D, S, E);
}
__device__ __forceinline__ void mo_phase_g2(const Ctx& C, unsigned char* ws) {
    SchedMoe S{(const bf16_t*)(ws + WS_ARENA + MO_ACT), (const bf16_t*)(ws + WS_WREG + MOW_2), (const int*)(ws + WS_ARENA + MO_TILE), EDIM, EDIM, D / 256, C.G, C.bid};
    EpiF32RowBias E{(float*)(ws + WS_ARENA + MO_OUT), D, nullptr};
    pg8::gemm_phase(C.lds, EDIM, EDIM, EDIM, S, E);
}
__device__ __forceinline__ void mo_phase_c(const Ctx& C, unsigned char* ws, int layer) {
    ph_moe_combine(C, (float*)(ws + WS_RES), (const float*)(ws + WS_MOD) + (size_t)layer * 18 * D, (const float*)(ws + WS_ARENA + MO_OUT), (const int*)(ws + WS_ARENA + MO_DEST), (const float*)(ws + WS_ARENA + MO_TOKG));
}

constexpr size_t HG_HB = 0;
constexpr size_t HG_QVG = al256(HG_HB + SZ_ACT_BF);
constexpr size_t HG_FG = al256(HG_QVG + 3 * SZ_ACT_BF);
constexpr size_t HG_O = al256(HG_FG + 2 * SZ_ACT_F32);
constexpr size_t HG_YB = al256(HG_O + 2 * SZ_ACT_F32);
constexpr size_t HG_LB = al256(HG_YB + SZ_ACT_BF);
constexpr size_t HG_END = HG_LB + 2 * D * 4;
static_assert(HG_END <= ARENA_BYTES, "hgrn arena");
constexpr size_t HGW_WIN = 0, HGW_WO = (size_t)5 * D * D * 2;
__device__ __forceinline__ void hg_phase_a(const Ctx& C, const Args& args, unsigned char* ws, int layer, int slot) {
    const CvtJob jobs[2] = { {args.in[I_HG_WIN] + (size_t)slot * D * 5 * D, (bf16_t*)(ws + WS_WREG + HGW_WIN), D, 5 * D, 5 * D, D, 0, 0, 5 * D, 0}, {args.in[I_HG_WO] + (size_t)slot * D * D, (bf16_t*)(ws + WS_WREG + HGW_WO), D, D, D, D, 0, 0, D, 0} };
    cvt_run(C, jobs);
    ph_hg_lb(C, args.in[I_HG_LB], layer, (float*)(ws + WS_ARENA + HG_LB));
    ph_norm_mod_bf16(C, (const float*)(ws + WS_RES), args.in[I_NORMG] + (size_t)(layer * 2) * D, (const float*)(ws + WS_MOD) + (size_t)layer * 18 * D, 0, 1, (bf16_t*)(ws + WS_ARENA + HG_HB));
}
__device__ __forceinline__ void hg_phase_g1(const Ctx& C, unsigned char* ws) {
    SchedPlain S{(const bf16_t*)(ws + WS_ARENA + HG_HB), (const bf16_t*)(ws + WS_WREG + HGW_WIN), D, D, PMT, 5 * D / 256, C.G, C.bid};
    EpiHg E{(bf16_t*)(ws + WS_ARENA + HG_QVG), (float*)(ws + WS_ARENA + HG_FG), (const float*)(ws + WS_ARENA + HG_LB)};
    pg8::gemm_phase(C.lds, D, D, D, S, E);
}
__device__ __forceinline__ void hg_phase_scan(const Ctx& C, unsigned char* ws) { ph_hg_scan_v2(C, (const bf16_t*)(ws + WS_ARENA + HG_QVG), (const float*)(ws + WS_ARENA + HG_FG), (float*)(ws + WS_ARENA + HG_O)); }
__device__ __forceinline__ void hg_phase_post(const Ctx& C, const Args& args, unsigned char* ws, int slot) {
    ph_hg_post(C, (const float*)(ws + WS_ARENA + HG_O), (const bf16_t*)(ws + WS_ARENA + HG_QVG + 2 * SZ_ACT_BF), args.in[I_HG_GN] + (size_t)slot * 128, (bf16_t*)(ws + WS_ARENA + HG_YB));
}
__device__ __forceinline__ void hg_phase_wo(const Ctx& C, unsigned char* ws, int layer) {
    SchedPlain S{(const bf16_t*)(ws + WS_ARENA + HG_YB), (const bf16_t*)(ws + WS_WREG + HGW_WO), D, D, PMT, D / 256, C.G, C.bid};
    EpiRes E{(float*)(ws + WS_RES), (const float*)(ws + WS_MOD) + (size_t)layer * 18 * D, 2, nullptr};
    pg8::gemm_phase(C.lds, D, D, D, S, E);
}
enum PhaseId { PH_INIT = 0, PH_RW0_A, PH_RW0_MIX, PH_RW0_G1, PH_RW0_G2, PH_RW0_SCAN, PH_RW0_POST, PH_RW0_WO, PH_FF0_A, PH_FF0_G1, PH_FF0_G2,
               PH_HY_A, PH_HY_B, PH_HY_CONV, PH_HY_TR, PH_HY_WO, PH_MO1_A, PH_MO1_B, PH_MO1_G1, PH_MO1_G2, PH_MO1_C,
               PH_HG_A, PH_HG_G1, PH_HG_SCAN, PH_HG_POST, PH_HG_WO, PH_FF2_A, PH_FF2_G1, PH_FF2_G2,
               PH_RW3_A, PH_RW3_MIX, PH_RW3_G1, PH_RW3_G2, PH_RW3_SCAN, PH_RW3_POST, PH_RW3_WO, PH_MO3_A, PH_MO3_B, PH_MO3_G1, PH_MO3_G2, PH_MO3_C, PH_FINAL, N_PHASES };
#define RW_PROGRAM(P, layer, slot) \
    if (IN(P##_A)) { rw_phase_a(C, args, ws, layer, slot); SEAM(P##_A); } \
    if (IN(P##_MIX)) { rw_phase_mix(C, args, ws, layer, slot); SEAM(P##_MIX); } \
    if (IN(P##_G1)) { rw_phase_g1(C, args, ws, layer, slot); SEAM(P##_G1); } \
    if (IN(P##_G2)) { rw_phase_g2(C, args, ws, layer, slot); SEAM(P##_G2); } \
    if (IN(P##_SCAN)) { rw_phase_scan(C, args, ws, layer, slot); SEAM(P##_SCAN); } \
    if (IN(P##_POST)) { rw_phase_post(C, args, ws, layer, slot); SEAM(P##_POST); } \
    if (IN(P##_WO)) { rw_phase_wo(C, args, ws, layer, slot); SEAM(P##_WO); }
#define HY_PROGRAM \
    if (IN(PH_HY_A)) { hy_phase_a(C, args, ws, 1); SEAM(PH_HY_A); } \
    if (IN(PH_HY_B)) { hy_phase_b(C, args, ws); SEAM(PH_HY_B); } \
    if (IN(PH_HY_CONV)) { ph_hy_conv(C, (const float*)(ws + WS_ARENA + HY_PROJT), (const float*)(ws + WS_ARENA + HY_FILT), args.in[I_HY_CW], args.in[I_HY_CB], args.in[I_HY_SKIP], (float*)(ws + WS_ARENA + HY_YT), (f32x2*)(ws + WS_ARENA + HY_SCR)); SEAM(PH_HY_CONV); } \
    if (IN(PH_HY_TR)) { ph_hy_transpose(C, (const float*)(ws + WS_ARENA + HY_YT), (bf16_t*)(ws + WS_ARENA + HY_YB)); SEAM(PH_HY_TR); } \
    if (IN(PH_HY_WO)) { hy_phase_wo(C, args, ws, 1); SEAM(PH_HY_WO); }
#define FF_PROGRAM(P, layer) \
    if (IN(P##_A)) { ff_phase_a(C, args, ws, layer); SEAM(P##_A); } \
    if (IN(P##_G1)) { ff_phase_g1(C, ws); SEAM(P##_G1); } \
    if (IN(P##_G2)) { ff_phase_g2(C, ws, layer); SEAM(P##_G2); }
#define MO_PROGRAM(P, layer) \
    if (IN(P##_A)) { mo_phase_a(C, args, ws, layer); SEAM(P##_A); } \
    if (IN(P##_B)) { mo_phase_b(C, ws); SEAM(P##_B); } \
    if (IN(P##_G1)) { mo_phase_g1(C, ws); SEAM(P##_G1); } \
    if (IN(P##_G2)) { mo_phase_g2(C, ws); SEAM(P##_G2); } \
    if (IN(P##_C)) { mo_phase_c(C, ws, layer); SEAM(P##_C); }
#define HG_PROGRAM \
    if (IN(PH_HG_A)) { hg_phase_a(C, args, ws, 2, 0); SEAM(PH_HG_A); } \
    if (IN(PH_HG_G1)) { hg_phase_g1(C, ws); SEAM(PH_HG_G1); } \
    if (IN(PH_HG_SCAN)) { hg_phase_scan(C, ws); SEAM(PH_HG_SCAN); } \
    if (IN(PH_HG_POST)) { hg_phase_post(C, args, ws, 0); SEAM(PH_HG_POST); } \
    if (IN(PH_HG_WO)) { hg_phase_wo(C, ws, 2); SEAM(PH_HG_WO); }
#define PHASE_PROGRAM RW_PROGRAM(PH_RW0, 0, 0) FF_PROGRAM(PH_FF0, 0) HY_PROGRAM MO_PROGRAM(PH_MO1, 1) HG_PROGRAM FF_PROGRAM(PH_FF2, 2) RW_PROGRAM(PH_RW3, 3, 1) MO_PROGRAM(PH_MO3, 3)
#ifndef MK_ONE_LAUNCH
#define MK_ONE_LAUNCH 1
#endif

__global__ void __launch_bounds__(NTHR, 2) mega_fwd(Args args) {
    extern __shared__ __attribute__((aligned(16))) unsigned char lds_raw[];
    Ctx C;
    C.lds = (LAS unsigned char*)lds_raw;
    C.tid = threadIdx.x; C.lane = C.tid & 63; C.wave = __builtin_amdgcn_readfirstlane(C.tid >> 6); C.G = gridDim.x; C.bid = blockIdx.x;
    volatile LAS unsigned* MISC = (volatile LAS unsigned*)(C.lds + LDS_MISC);
    if (C.tid < 64) MISC[C.tid] = 0u;
    __syncthreads();
    unsigned char* ws = args.ws;
    unsigned* ctl = (unsigned*)(ws + WS_CTL);
    XcdBarrier bar; bar.bar = ctl + CW_BAR; bar.x = 0; bar.st = nullptr;
    if (MK_ONE_LAUNCH) bar = xcd_barrier_post(ctl + CW_BAR, MISC + 8);
    const int lo = args.ph_lo, hi = args.ph_hi;
#define IN(k) (lo <= (k) && (k) < hi)
#define SEAM(k) do { if (MK_ONE_LAUNCH && IN((k) + 1)) xcd_barrier(bar); else __syncthreads(); } while (0)
    float* RES = (float*)(ws + WS_RES);
    float* MOD = (float*)(ws + WS_MOD);

    if (IN(PH_INIT)) { ph_init_res(C, args.in[I_X], args.in[I_CTX], RES); ph_adaln(C, args.in[I_C], args.in[I_CCTX], args.in[I_ADAW], args.in[I_ADAB], MOD); SEAM(PH_INIT); }

    PHASE_PROGRAM

    if (IN(PH_FINAL)) { ph_final(C, RES, args.in[I_FINALG], args.out); }
#undef IN
#undef SEAM
}

extern "C" void kernel_launch(void* const* d_in, const int* in_sizes, int n_in, void* d_out, int out_size, void* d_ws, size_t ws_size, hipStream_t stream) {
    static int grid = 0;
    if (grid == 0) {
        if (n_in != N_IN || out_size != NLAT * D || ws_size < WS_END) { fprintf(stderr, "kernel_launch: unexpected shapes (n_in %d out %d ws %zu need %zu)\n", n_in, out_size, ws_size, (size_t)WS_END); grid = -1; return; }
        int dev = 0, cus = 0, per_cu = 0;
        if (hipGetDevice(&dev) != hipSuccess || hipDeviceGetAttribute(&cus, hipDeviceAttributeMultiprocessorCount, dev) != hipSuccess) { grid = -1; return; }
        if (hipFuncSetAttribute((const void*)mega_fwd, hipFuncAttributeMaxDynamicSharedMemorySize, LDS_BYTES) != hipSuccess) { fprintf(stderr, "kernel_launch: hipFuncSetAttribute failed\n"); grid = -1; return; }
        if (hipOccupancyMaxActiveBlocksPerMultiprocessor(&per_cu, (const void*)mega_fwd, NTHR, LDS_BYTES) != hipSuccess || per_cu < 1) { fprintf(stderr, "kernel_launch: occupancy query says %d\n", per_cu); }
        (void)hipGetLastError();
        grid = cus;
    }
    if (grid < 0) return;
    (void)hipMemsetAsync((char*)d_ws + WS_CTL, 0, CTL_BYTES + ZREG_BYTES, stream);
    Args a{};
    for (int i = 0; i < N_IN; ++i) a.in[i] = (const float*)d_in[i];
    a.out = (float*)d_out; a.ws = (unsigned char*)d_ws;
#if MK_ONE_LAUNCH
    a.ph_lo = 0; a.ph_hi = N_PHASES;
    hipLaunchKernelGGL(mega_fwd, dim3(grid), dim3(NTHR), LDS_BYTES, stream, a);
#else
    for (int p = 0; p < N_PHASES; ++p) { a.ph_lo = p; a.ph_hi = p + 1; hipLaunchKernelGGL(mega_fwd, dim3(grid), dim3(NTHR), LDS_BYTES, stream, a); }
#endif
}
```

```cpp
#include <hip/hip_runtime.h>
#include <cstdio>
#include <cstdint>

#define GAS __attribute__((address_space(1)))
#define LAS __attribute__((address_space(3)))
typedef unsigned short bf16_t;
typedef unsigned v4u __attribute__((ext_vector_type(4)));
typedef unsigned v2u __attribute__((ext_vector_type(2)));
typedef float f32x4 __attribute__((ext_vector_type(4)));
typedef float f32x2 __attribute__((ext_vector_type(2)));
typedef short bf16x8 __attribute__((ext_vector_type(8)));
typedef GAS unsigned gu32;
#define RLX_AGENT __ATOMIC_RELAXED, __HIP_MEMORY_SCOPE_AGENT
#define LDS_WAIT() asm volatile("s_waitcnt lgkmcnt(0)" ::: "memory")
#define VM_WAIT() asm volatile("s_waitcnt vmcnt(0)" ::: "memory")

constexpr int D = 1024, NB = 2, SEQ = 16384, CTXL = 256, GRIDW = 64;
constexpr int NCTX = NB * CTXL;
constexpr int NLAT = NB * SEQ;
constexpr int MROWS = NCTX + NLAT;
constexpr int PMT = MROWS / 256;
constexpr int DEPTH = 4;
constexpr int FFN = 2816, NEXP = 8, EDIM = 3584;
constexpr int NWAVES = 8, NTHR = 512;
constexpr float NORM_EPS = 1e-6f;

__device__ __forceinline__ unsigned f2bf(float f) { unsigned u = __builtin_bit_cast(unsigned, f); return (u + 0x7fffu + ((u >> 16) & 1u)) >> 16; }
typedef __bf16 bf16x2_t __attribute__((ext_vector_type(2)));
__device__ __forceinline__ unsigned pk2(float lo, float hi) { const bf16x2_t v = __builtin_convertvector((f32x2){lo, hi}, bf16x2_t); return __builtin_bit_cast(unsigned, v); }
__device__ __forceinline__ float bf2f(unsigned b) { return __builtin_bit_cast(float, b << 16); }
__device__ __forceinline__ float bflo(unsigned w) { return __builtin_bit_cast(float, w << 16); }
__device__ __forceinline__ float bfhi(unsigned w) { return __builtin_bit_cast(float, w & 0xffff0000u); }
__device__ __forceinline__ float sigmoidf_(float x) { return 1.0f / (1.0f + __expf(-x)); }
__device__ __forceinline__ float siluf_(float x) { return x / (1.0f + __expf(-x)); }
__device__ __forceinline__ float wave_sum(float v) {
#pragma unroll
    for (int o = 1; o < 64; o <<= 1) v += __shfl_xor(v, o);
    return v;
}
__device__ __forceinline__ int row_bidx(int r) { return r < NCTX ? 0 : 1 + ((r - NCTX) >> 14); }

#define XB_TMO      128
#define XB_XCNT(j)  (256  + 64 * (j))
#define XB_XSUB(j)  (1280 + 64 * (j))
#define XB_XGEN(j)  (2304 + 64 * (j))
#define XB_TOP      3328
#define XB_TOPGEN   3392
#define XCD_BAR_WORDS 3456
#define XB_SPIN_CAP (1u << 20)

__device__ __forceinline__ unsigned xb_ld(unsigned* p)              { return __hip_atomic_load(p, __ATOMIC_RELAXED, __HIP_MEMORY_SCOPE_AGENT); }
__device__ __forceinline__ unsigned xb_add(unsigned* p, unsigned v) { return __hip_atomic_fetch_add(p, v, __ATOMIC_RELAXED, __HIP_MEMORY_SCOPE_AGENT); }
__device__ __forceinline__ unsigned xb_xcc_id() { return (unsigned)__builtin_amdgcn_s_getreg((3 << 11) | 20) & 0xFu; }
#define XB_SPIN(cond, bar) do { unsigned _sp = 0; while (cond) { __builtin_amdgcn_s_sleep(1); \
    if ((++_sp & 255u) == 0u) { if (xb_ld(&(bar)[XB_TMO])) break; if (_sp > XB_SPIN_CAP) { atomicAdd(&(bar)[XB_TMO], 1u); break; } } } } while (0)

struct XcdBarrier { unsigned* bar; unsigned x; volatile LAS unsigned* st; };

__device__ __forceinline__ XcdBarrier xcd_barrier_post(unsigned* bar, volatile LAS unsigned* st) {
    XcdBarrier b; b.bar = bar; b.x = xb_xcc_id(); b.st = st;
    if (threadIdx.x == 0) (void)xb_add(&bar[XB_XCNT(b.x)], 1u);
    return b;
}
__device__ __forceinline__ void xcd_barrier_complete(unsigned* bar, unsigned x, unsigned& nloc, unsigned& nx) {
    const unsigned G = gridDim.x * gridDim.y * gridDim.z;
    unsigned sum, cnt, mine, sp = 0u;
    for (;;) {
        sum = 0u; cnt = 0u; mine = 0u;
#pragma unroll
        for (unsigned j = 0; j < 16; ++j) { const unsigned c = xb_ld(&bar[XB_XCNT(j)]); sum += c; cnt += (c > 0u) ? 1u : 0u; mine = (j == x) ? c : mine; }
        if (sum == G) break;
        __builtin_amdgcn_s_sleep(1);
        if ((++sp & 255u) == 0u) { if (xb_ld(&bar[XB_TMO])) break; if (sp > XB_SPIN_CAP) { atomicAdd(&bar[XB_TMO], 1u); break; } }
    }
    nloc = mine > 0u ? mine : 1u; nx = cnt > 0u ? cnt : 1u;
}
__device__ __forceinline__ void xcd_barrier(const XcdBarrier& b) {
    asm volatile("s_waitcnt vmcnt(0)" ::: "memory");
    __syncthreads();
    if (threadIdx.x == 0) {
        unsigned* bar = b.bar;
        __builtin_amdgcn_s_waitcnt(0);
        unsigned nloc = b.st[0], nx = b.st[1];
        if (nloc == 0u) { xcd_barrier_complete(bar, b.x, nloc, nx); b.st[0] = nloc; b.st[1] = nx; }
        const unsigned old = xb_add(&bar[XB_XSUB(b.x)], 1u);
        const unsigned gen = old / nloc;
        if (old + 1u == (gen + 1u) * nloc) {
            __builtin_amdgcn_fence(__ATOMIC_RELEASE, "agent");
            asm volatile("s_waitcnt vmcnt(0)" ::: "memory");
            const unsigned og = xb_add(&bar[XB_TOP], 1u);
            const unsigned tg = og / nx;
            if (og + 1u == (tg + 1u) * nx) xb_add(&bar[XB_TOPGEN], 1u);
            else XB_SPIN(xb_ld(&bar[XB_TOPGEN]) == tg, bar);
            __builtin_amdgcn_fence(__ATOMIC_ACQUIRE, "agent");
            xb_add(&bar[XB_XGEN(b.x)], 1u);
            asm volatile("s_waitcnt vmcnt(0)" ::: "memory");
        } else {
            XB_SPIN(xb_ld(&bar[XB_XGEN(b.x)]) == gen, bar);
            __builtin_amdgcn_fence(__ATOMIC_ACQUIRE, "agent");
            asm volatile("s_waitcnt vmcnt(0)" ::: "memory");
        }
    }
    __syncthreads();
}
namespace pg8 {
constexpr int BM = 256, BK = 64, HALF = 128, HTB = HALF * BK * 2, STAGE_BYTES = 8 * HTB, NXCD = 8, WGM = 8;
__host__ __device__ __forceinline__ int lds_byte(int r, int c) { const int st = (r >> 4) * 2 + (c >> 5), rr = r & 15, cc = c & 31, ob = rr * 64 + cc * 2; return st * 1024 + (ob ^ (((ob >> 9) & 1) << 5)); }
__host__ __device__ __forceinline__ void stage_rc(int b, int& R, int& C) { const int st = b / 1024, sb = b % 1024, swz = sb ^ (((sb >> 9) & 1) << 5); R = (st >> 1) * 16 + swz / 64; C = (st & 1) * 32 + (swz % 64) / 2; }
__host__ __device__ __forceinline__ int perm32(int rho) { const int n = rho >> 4, i = rho & 15; return 8 * (i >> 2) + 4 * n + (i & 3); }

struct Unit { int pm, pn, aux; };

__device__ __forceinline__ bool static_unit(int nM, int nN, int G, int c, int i, int& pm, int& pn) {
    const int nwg = nM * nN; const long L = (long)i * G + c; if (L >= nwg) return false;
    int wgid = (int)L; { const int q = nwg / NXCD, r = nwg % NXCD, xcd = wgid % NXCD, off = wgid / NXCD; wgid = (xcd < r ? xcd * (q + 1) : r * (q + 1) + (xcd - r) * q) + off; }
    const int nig = WGM * nN, gid = wgid / nig, fm = gid * WGM, gsz = (nM - fm) < WGM ? (nM - fm) : WGM;
    pm = fm + ((wgid % nig) % gsz); pn = (wgid % nig) / gsz; return true;
}

__device__ __forceinline__ unsigned cvt_pk_bf16(float lo, float hi) { unsigned r; asm volatile("v_cvt_pk_bf16_f32 %0, %1, %2" : "=v"(r) : "v"(lo), "v"(hi)); return r; }

template <class Epi, class Sched>
__device__ __forceinline__ void gemm_phase(LAS unsigned char* lds, const int K_, const int lda, const int ldb, const Sched& S, const Epi& E) {
    int K = K_; asm volatile("" : "+s"(K));
    const int tid = threadIdx.x, wid = __builtin_amdgcn_readfirstlane(tid >> 6), lane = tid & 63, wr = wid >> 2, wc = wid & 3, fr = lane & 15, fq = lane >> 4;
    const int nt = K / BK;
    unsigned voffA[2], voffB[2];
#pragma unroll
    for (int i = 0; i < 2; ++i) { int R, C; stage_rc(tid * 16 + i * 8192, R, C); const int Rb = Epi::PERM ? ((R & ~31) + perm32(R & 31)) : R;
        voffA[i] = (unsigned)(R * lda + C) * 2u; voffB[i] = (unsigned)(Rb * ldb + C) * 2u; }
    const size_t kstep = (size_t)(BK * 2);
    const size_t hstepA = (size_t)HALF * lda * 2, hstepB = (size_t)HALF * ldb * 2;
    const unsigned ldsw = (unsigned)wid * 1024u;
    const int aoff = lds_byte(wr * 64 + fr, fq * 8), boff = lds_byte(wc * 32 + fr, fq * 8);
#define PG8_SA(b, h) (((b) * 2 + (h)) * HTB)
#define PG8_SB(b, h) ((4 + (b) * 2 + (h)) * HTB)
#define PG8_STAGE(bufoff, gbase, voff) do { _Pragma("unroll") for (int _i = 0; _i < 2; ++_i) \
        __builtin_amdgcn_global_load_lds((const GAS unsigned*)((const char*)(gbase) + (voff)[_i]), (LAS unsigned*)(lds + (bufoff) + ldsw + _i * 8192), 16, 0, 0); } while (0)
#define PG8_LDA(dst, b, h) do { _Pragma("unroll") for (int m = 0; m < 4; ++m) _Pragma("unroll") for (int k = 0; k < 2; ++k) dst[m][k] = *(const LAS bf16x8*)(lds + PG8_SA(b, h) + aoff + m * 2048 + k * 1024); } while (0)
#define PG8_LDB(dst, b, h) do { _Pragma("unroll") for (int n = 0; n < 2; ++n) _Pragma("unroll") for (int k = 0; k < 2; ++k) dst[n][k] = *(const LAS bf16x8*)(lds + PG8_SB(b, h) + boff + n * 2048 + k * 1024); } while (0)
#define PG8_MMA(ai, bj, At, Bt) do { __builtin_amdgcn_s_setprio(1); _Pragma("unroll") for (int m = 0; m < 4; ++m) _Pragma("unroll") for (int n = 0; n < 2; ++n) _Pragma("unroll") for (int k = 0; k < 2; ++k) \
        acc[ai][bj][m][n] = __builtin_amdgcn_mfma_f32_16x16x32_bf16(Bt[n][k], At[m][k], acc[ai][bj][m][n], 0, 0, 0); __builtin_amdgcn_s_setprio(0); } while (0)
#define PG8_WAIT_V(n) asm volatile("s_waitcnt vmcnt(" #n ")" ::: "memory")
#define PG8_WAIT_L(n) asm volatile("s_waitcnt lgkmcnt(" #n ")" ::: "memory")
#define PG8_BAR __builtin_amdgcn_s_barrier()
#define PG8_SCHED __builtin_amdgcn_sched_barrier(0)
    Unit cur, nxt; int ui = 0;
    if (!S.next(0, cur)) return;
    f32x4 acc[2][2][4][2];
#pragma unroll
    for (int a = 0; a < 2; ++a)
#pragma unroll
        for (int b = 0; b < 2; ++b)
#pragma unroll
            for (int m = 0; m < 4; ++m)
#pragma unroll
                for (int n = 0; n < 2; ++n) acc[a][b][m][n] = (f32x4){0.f, 0.f, 0.f, 0.f};
    bf16x8 At[4][2], B0[2][2], B1[2][2];
    const char* cA = S.a_ptr(cur); const char* cB = S.b_ptr(cur);
    PG8_STAGE(PG8_SB(0, 0), cB, voffB); PG8_STAGE(PG8_SA(0, 0), cA, voffA); PG8_STAGE(PG8_SB(0, 1), cB + hstepB, voffB); PG8_STAGE(PG8_SA(0, 1), cA + hstepA, voffA);
    if (wr == 1) PG8_BAR;
    PG8_WAIT_V(4); PG8_BAR;
    PG8_STAGE(PG8_SB(1, 0), cB + kstep, voffB); PG8_STAGE(PG8_SA(1, 0), cA + kstep, voffA); PG8_STAGE(PG8_SB(1, 1), cB + hstepB + kstep, voffB);
    PG8_WAIT_V(6); PG8_BAR;
    for (;;) {
        const bool has_next = S.next(ui + 1, nxt);
        const char* nA = has_next ? S.a_ptr(nxt) : cA; const char* nB = has_next ? S.b_ptr(nxt) : cB;
#pragma unroll 1
        for (int t = 0; t < nt; t += 2) {
            const bool last = (t == nt - 2);
            const char* a1 = cA + (size_t)(t + 1) * kstep;
            const char* a2 = last ? nA : cA + (size_t)(t + 2) * kstep; const char* b2 = last ? nB : cB + (size_t)(t + 2) * kstep;
            const char* a3 = a2 + kstep; const char* b3 = b2 + kstep;
            PG8_LDB(B0, 0, 0); PG8_SCHED; PG8_LDA(At, 0, 0); PG8_STAGE(PG8_SA(1, 1), a1 + hstepA, voffA);
            PG8_WAIT_L(8); PG8_BAR; PG8_WAIT_L(0); PG8_MMA(0, 0, At, B0); PG8_BAR; PG8_SCHED;
            PG8_LDB(B1, 0, 1); PG8_STAGE(PG8_SB(0, 0), b2, voffB);
            PG8_BAR; PG8_WAIT_L(0); PG8_MMA(0, 1, At, B1); PG8_BAR;
            PG8_LDA(At, 0, 1); PG8_STAGE(PG8_SA(0, 0), a2, voffA);
            PG8_BAR; PG8_WAIT_L(0); PG8_MMA(1, 0, At, B0); PG8_BAR; PG8_SCHED;
            PG8_STAGE(PG8_SB(0, 1), b2 + hstepB, voffB);
            PG8_WAIT_V(6); PG8_BAR; PG8_MMA(1, 1, At, B1); PG8_BAR;
            PG8_LDB(B0, 1, 0); PG8_SCHED; PG8_LDA(At, 1, 0); PG8_STAGE(PG8_SA(0, 1), a2 + hstepA, voffA);
            PG8_WAIT_L(8); PG8_BAR; PG8_WAIT_L(0); PG8_MMA(0, 0, At, B0); PG8_BAR; PG8_SCHED;
            PG8_LDB(B1, 1, 1); PG8_STAGE(PG8_SB(1, 0), b3, voffB);
            PG8_BAR; PG8_WAIT_L(0); PG8_MMA(0, 1, At, B1); PG8_BAR;
            PG8_LDA(At, 1, 1); PG8_STAGE(PG8_SA(1, 0), a3, voffA);
            PG8_BAR; PG8_WAIT_L(0); PG8_MMA(1, 0, At, B0); PG8_BAR; PG8_SCHED;
            PG8_STAGE(PG8_SB(1, 1), b3 + hstepB, voffB);
            PG8_WAIT_V(6); PG8_BAR; PG8_MMA(1, 1, At, B1); PG8_BAR;
        }
        E(acc, cur, wr, wc, fr, fq);
        if (!has_next) break;
#pragma unroll
        for (int a = 0; a < 2; ++a)
#pragma unroll
            for (int b = 0; b < 2; ++b)
#pragma unroll
                for (int m = 0; m < 4; ++m)
#pragma unroll
                    for (int n = 0; n < 2; ++n) acc[a][b][m][n] = (f32x4){0.f, 0.f, 0.f, 0.f};
        cur = nxt; cA = nA; cB = nB; ++ui;
    }
    PG8_WAIT_V(0);
    if (wr == 0) PG8_BAR;
    PG8_BAR;
#undef PG8_SA
#undef PG8_SB
#undef PG8_STAGE
#undef PG8_LDA
#undef PG8_LDB
#undef PG8_MMA
#undef PG8_WAIT_V
#undef PG8_WAIT_L
#undef PG8_BAR
#undef PG8_SCHED
}
}
using pg8::Unit;
constexpr size_t al256(size_t x) { return (x + 255) & ~(size_t)255; }
constexpr size_t SZ_ACT_BF = (size_t)MROWS * D * 2;
constexpr size_t SZ_ACT_F32 = (size_t)MROWS * D * 4;
constexpr size_t WS_CTL = 0, CTL_BYTES = 65536;
constexpr size_t WS_ZREG = WS_CTL + CTL_BYTES;
constexpr size_t Z_LDN = 0;
constexpr size_t Z_LUP = Z_LDN + (size_t)1024 * 1024 * 2;
constexpr size_t Z_SLOT = Z_LUP + (size_t)6144 * 256 * 2;
constexpr size_t Z_AW = 2 * Z_SLOT;
constexpr size_t ZREG_BYTES = al256(Z_AW + (size_t)4096 * 256 * 2);
constexpr size_t WS_MOD = WS_ZREG + ZREG_BYTES;
constexpr size_t WS_RSTD = WS_MOD + al256((size_t)DEPTH * 3 * 6 * D * 4);
constexpr size_t WS_RES = WS_RSTD + al256((size_t)MROWS * 4);
constexpr size_t WS_VFIRST = WS_RES + SZ_ACT_F32;
constexpr size_t WS_WREG = WS_VFIRST + SZ_ACT_BF;
constexpr size_t WREG_BYTES = (size_t)216 * 1024 * 1024;
constexpr size_t WS_ARENA = WS_WREG + WREG_BYTES;
constexpr size_t ARENA_BYTES = (size_t)1400 * 1000 * 1000;
constexpr size_t WS_END = WS_ARENA + ARENA_BYTES;

constexpr int CW_BAR = 0;
constexpr int CW_MOE = 4096;
constexpr int CW_TC = 14336;
constexpr int TAILB = 8;

constexpr int LDS_MAIN = 139264;
constexpr int LDS_MISC = LDS_MAIN;
constexpr int LDS_BYTES = LDS_MAIN + 256;

struct Args { const float* in[51]; float* out; unsigned char* ws; int ph_lo, ph_hi; };

enum InIdx { I_X = 0, I_C, I_CTX, I_CCTX, I_NORMG, I_ADAW, I_ADAB, I_FINALG, I_RW_MU, I_RW_WRKV, I_RW_WO, I_RW_W0, I_RW_W1, I_RW_W2, I_RW_A0, I_RW_A1, I_RW_A2,
             I_RW_V0, I_RW_V1, I_RW_V2, I_RW_G1, I_RW_G2, I_RW_KK, I_RW_KA, I_RW_RK, I_RW_LNW, I_RW_LNB, I_HY_WIN, I_HY_BIN, I_HY_CW, I_HY_CB, I_HY_FW1, I_HY_FB1,
             I_HY_FW2, I_HY_FB2, I_HY_FW3, I_HY_FB3, I_HY_FW4, I_HY_FREQ, I_HY_SKIP, I_HY_WO, I_HY_BO, I_HG_WIN, I_HG_LB, I_HG_GN, I_HG_WO, I_FFN_W13, I_FFN_W2,
             I_MOE_ROUTER, I_MOE_W13, I_MOE_W2, N_IN };

struct Ctx {
    LAS unsigned char* lds;
    int tid, lane, wave, G, bid;
};

__device__ __forceinline__ void ph_init_res(const Ctx& C, const float* x, const float* ctx, float* res) {
    const size_t nctx4 = (size_t)NCTX * D / 4, n4 = (size_t)MROWS * D / 4;
    const GAS f32x4* c4 = (const GAS f32x4*)ctx; const GAS f32x4* x4 = (const GAS f32x4*)x; GAS f32x4* r4 = (GAS f32x4*)res;
    for (size_t i = (size_t)C.bid * NTHR + C.tid; i < n4; i += (size_t)C.G * NTHR) r4[i] = i < nctx4 ? c4[i] : x4[i - nctx4];
}

struct ResSrc { const float* res; const float* x; const float* ctx; };
__device__ __forceinline__ const float* res_row(const ResSrc& s, int r) { return s.x == nullptr ? s.res + (size_t)r * D : (r < NCTX ? s.ctx + (size_t)r * D : s.x + (size_t)(r - NCTX) * D); }

__device__ __forceinline__ void ph_adaln(const Ctx& C, const float* c, const float* c_ctx, const float* ada_w, const float* ada_b, float* mod) {
    LAS float* sv = (LAS float*)C.lds;
    LAS float* red = sv + 3 * D;
    for (int i = C.tid; i < 3 * D; i += NTHR) { const int b = i / D, k = i % D; const float v = (b == 0) ? c_ctx[k] : c[(b - 1) * D + k]; sv[i] = siluf_(v); }
    __syncthreads();
    const int NITEM = DEPTH * (6 * D / 32);
    const int col = C.tid & 31, ks = C.tid >> 5;
    for (int it = C.bid; it < NITEM; it += C.G) {
        const int layer = it / (6 * D / 32), cb = it % (6 * D / 32);
        const GAS float* W = (const GAS float*)ada_w + (size_t)layer * D * 6 * D + cb * 32 + col;
        float a0 = 0.f, a1 = 0.f, a2 = 0.f;
#pragma unroll 16
        for (int k = ks * 64; k < ks * 64 + 64; ++k) { const float w = W[(size_t)k * 6 * D]; a0 += sv[k] * w; a1 += sv[D + k] * w; a2 += sv[2 * D + k] * w; }
        red[(ks * 3 + 0) * 32 + col] = a0; red[(ks * 3 + 1) * 32 + col] = a1; red[(ks * 3 + 2) * 32 + col] = a2;
        __syncthreads();
        if (C.tid < 96) { const int b = C.tid / 32, cc = C.tid % 32; float s = 0.f;
#pragma unroll
            for (int q = 0; q < 16; ++q) s += red[(q * 3 + b) * 32 + cc];
            const int n = cb * 32 + cc;
            mod[((size_t)(layer * 3 + b) * 6 * D) + n] = s + ada_b[(size_t)layer * 6 * D + n]; }
        __syncthreads();
    }
}

__device__ __forceinline__ void load_row(const float* row, int lane, f32x4 (&v)[4]) {
    const GAS f32x4* p = (const GAS f32x4*)row + lane;
#pragma unroll
    for (int j = 0; j < 4; ++j) v[j] = p[64 * j];
}
__device__ __forceinline__ float row_rstd(const f32x4 (&v)[4]) {
    float s = 0.f;
#pragma unroll
    for (int j = 0; j < 4; ++j) s += (v[j].x * v[j].x + v[j].y * v[j].y) + (v[j].z * v[j].z + v[j].w * v[j].w);
    return 1.0f / sqrtf(wave_sum(s) * (1.0f / D) + NORM_EPS);
}

struct RowIt { int r0, r1, step; };
__device__ __forceinline__ bool tail_split(const Ctx& C) { return C.G >= 64; }
__device__ __forceinline__ RowIt row_part(const Ctx& C, bool split) {
    RowIt it;
    if (!split) { it.r0 = C.bid * NWAVES + C.wave; it.r1 = MROWS; it.step = C.G * NWAVES; }
    else if (C.bid < TAILB) { it.r0 = C.bid * NWAVES + C.wave; it.r1 = NCTX; it.step = TAILB * NWAVES; }
    else { it.r0 = NCTX + (C.bid - TAILB) * NWAVES + C.wave; it.r1 = MROWS; it.step = (C.G - TAILB) * NWAVES; }
    return it;
}
__device__ __forceinline__ void tile_signal(const Ctx& C, unsigned* tc) {
    asm volatile("s_waitcnt vmcnt(0)" ::: "memory");
    __syncthreads();
    if (C.tid == 0) { __builtin_amdgcn_fence(__ATOMIC_RELEASE, "agent"); asm volatile("s_waitcnt vmcnt(0)" ::: "memory"); (void)__hip_atomic_fetch_add(tc, 1u, __ATOMIC_RELAXED, __HIP_MEMORY_SCOPE_AGENT); }
    __syncthreads();
}
__device__ __forceinline__ void tile_wait(unsigned* tc, unsigned need) {
    unsigned sp = 0;
    while (__hip_atomic_load(tc, __ATOMIC_RELAXED, __HIP_MEMORY_SCOPE_AGENT) < need) { __builtin_amdgcn_s_sleep(2); if (++sp > (1u << 22)) break; }
    __builtin_amdgcn_fence(__ATOMIC_ACQUIRE, "agent");
}

__device__ __forceinline__ void tile_wait_block(const Ctx& C, unsigned* tc, int ntile, unsigned need) {
    __syncthreads();
    if (C.tid == 0) { for (int t = 0; t < ntile; ++t) { unsigned sp = 0; while (__hip_atomic_load(tc + t, __ATOMIC_RELAXED, __HIP_MEMORY_SCOPE_AGENT) < need) { __builtin_amdgcn_s_sleep(2); if (++sp > (1u << 22)) break; } }
        __builtin_amdgcn_fence(__ATOMIC_ACQUIRE, "agent"); asm volatile("s_waitcnt vmcnt(0)" ::: "memory"); }
    __syncthreads();
}

__device__ __forceinline__ void ph_rstd(const Ctx& C, const ResSrc& src, float* rstd, unsigned* tc = nullptr) {
    const bool split = tc != nullptr; const RowIt it = row_part(C, split);
    for (int r = it.r0; r < it.r1; r += it.step) { f32x4 v[4]; load_row(res_row(src, r), C.lane, v); const float s = row_rstd(v); if (C.lane == 0) rstd[r] = s; }
}

__device__ __forceinline__ void ph_norm_mod_bf16(const Ctx& C, const float* res, const float* g, const float* modl, int i_shift, int i_scale, bf16_t* hb, unsigned* tc = nullptr) {
    const bool split = tc != nullptr; const RowIt it = row_part(C, split);
    for (int r = it.r0; r < it.r1; r += it.step) {
        f32x4 v[4]; load_row(res + (size_t)r * D, C.lane, v); const float s = row_rstd(v);
        const int b = row_bidx(r);
        const GAS f32x4* g4 = (const GAS f32x4*)g + C.lane; const GAS f32x4* sh4 = (const GAS f32x4*)(modl + (size_t)(b * 6 + i_shift) * D) + C.lane; const GAS f32x4* sc4 = (const GAS f32x4*)(modl + (size_t)(b * 6 + i_scale) * D) + C.lane;
        GAS v2u* o = (GAS v2u*)(hb + (size_t)r * D) + C.lane;
#pragma unroll
        for (int j = 0; j < 4; ++j) { const f32x4 gg = g4[64 * j], sh = sh4[64 * j], sc = sc4[64 * j];
            const f32x4 h = v[j] * s * gg * (sc + 1.0f) + sh;
            v2u w; w.x = pk2(h.x, h.y); w.y = pk2(h.z, h.w); o[64 * j] = w; }
    }
}

__device__ __forceinline__ void ph_final(const Ctx& C, const float* res, const float* g, float* out) {
    const int gw = C.bid * NWAVES + C.wave, NGW = C.G * NWAVES;
    for (int r = gw; r < NLAT; r += NGW) {
        f32x4 v[4]; load_row(res + (size_t)(NCTX + r) * D, C.lane, v); const float s = row_rstd(v);
        const GAS f32x4* g4 = (const GAS f32x4*)g + C.lane; GAS f32x4* o = (GAS f32x4*)(out + (size_t)r * D) + C.lane;
#pragma unroll
        for (int j = 0; j < 4; ++j) o[64 * j] = v[j] * s * g4[64 * j];
    }
}

struct CvtJob { const float* src; bf16_t* dst; int K, N, sld, ldd, roff, coff, nseg, nstride; };
__device__ __forceinline__ void cvt_wave_load(const CvtJob& j, int item, int lane, float (&v)[32]) {
    const int nb = (j.N + 31) / 32, k0 = (item / nb) * 64, n0 = (item % nb) * 32, nn = lane & 31, kh = lane >> 5;
#pragma unroll
    for (int q = 0; q < 32; ++q) { const int k = k0 + 2 * q + kh, n = n0 + nn; v[q] = (k < j.K && n < j.N) ? ((const GAS float*)j.src)[(size_t)k * j.sld + n] : 0.f; }
}
__device__ __forceinline__ void cvt_wave_emit(LAS float* t, const CvtJob& j, int item, int lane, const float (&v)[32]) {
    const int nb = (j.N + 31) / 32, k0 = (item / nb) * 64, n0 = (item % nb) * 32, nn = lane & 31, kh = lane >> 5;
#pragma unroll
    for (int q = 0; q < 32; ++q) t[(2 * q + kh) * 33 + nn] = v[q];
    asm volatile("s_waitcnt lgkmcnt(0)" ::: "memory");
    const int c = lane & 7;
#pragma unroll
    for (int q = 0; q < 4; ++q) { const int n_ = (lane >> 3) + 8 * q, n = n0 + n_, k = k0 + 8 * c; const LAS float* s_ = t + (8 * c) * 33 + n_;
        if (n < j.N && k < j.K) { const int r = j.roff + (n / j.nseg) * j.nstride + (n % j.nseg);
            v4u o; o.x = pk2(s_[0], s_[33]); o.y = pk2(s_[66], s_[99]); o.z = pk2(s_[132], s_[165]); o.w = pk2(s_[198], s_[231]);
            *(GAS v4u*)(j.dst + (size_t)r * j.ldd + j.coff + k) = o; } }
    asm volatile("s_waitcnt lgkmcnt(0)" ::: "memory");
}
__device__ __forceinline__ int cvt_items(const CvtJob& j) { return ((j.K + 63) / 64) * ((j.N + 31) / 32); }
template <int NJ> __device__ __forceinline__ void cvt_run(const Ctx& C, const CvtJob (&jobs)[NJ]) {
    LAS float* t = (LAS float*)C.lds + C.wave * (64 * 33);
    const int gw = C.bid * NWAVES + C.wave, NGW = C.G * NWAVES;
    int base = 0;
#pragma unroll
    for (int q = 0; q < NJ; ++q) { const int ni = cvt_items(jobs[q]);
        const int first = (gw - base % NGW + NGW) % NGW;
        for (int it = first; it < ni; it += NGW) { float v[32]; cvt_wave_load(jobs[q], it, C.lane, v); cvt_wave_emit(t, jobs[q], it, C.lane, v); }
        base += ni; }
}
struct SchedPlain {
    const bf16_t* A; const bf16_t* Bt; int lda, ldb, nM, nN, G, c; int pm0 = 0;
    __device__ __forceinline__ bool next(int i, Unit& u) const { const bool ok = pg8::static_unit(nM, nN, G, c, i, u.pm, u.pn); u.pm += pm0; u.aux = u.pn; return ok; }
    __device__ __forceinline__ const char* a_ptr(const Unit& u) const { return (const char*)(A + (size_t)u.pm * 256 * lda); }
    __device__ __forceinline__ const char* b_ptr(const Unit& u) const { return (const char*)(Bt + (size_t)u.pn * 256 * ldb); }
};

typedef f32x4 AccT[2][2][4][2];

struct EpiF32RowBias {
    static constexpr bool PERM = false;
    float* Cp; int ldc; const float* rbias;
    __device__ __forceinline__ void operator()(const AccT& acc, const Unit& u, int wr, int wc, int fr, int fq) const {
        const int row0 = u.pm * 256 + wr * 64 + fr, col0 = u.aux * 256 + wc * 32 + 4 * fq;
#pragma unroll
        for (int ai = 0; ai < 2; ++ai)
#pragma unroll
            for (int m = 0; m < 4; ++m) { const int row = row0 + ai * 128 + m * 16; const float b = rbias ? rbias[row] : 0.f; GAS float* rowp = (GAS float*)Cp + (size_t)row * ldc + col0;
#pragma unroll
                for (int bj = 0; bj < 2; ++bj)
#pragma unroll
                    for (int n = 0; n < 2; ++n) *(GAS f32x4*)(rowp + bj * 128 + n * 16) = acc[ai][bj][m][n] + b; }
    }
};

struct EpiRes {
    static constexpr bool PERM = false;
    float* res; const float* modl; int gi; const float* bias; const float* in_x = nullptr; const float* in_ctx = nullptr;
    __device__ __forceinline__ void operator()(const AccT& acc, const Unit& u, int wr, int wc, int fr, int fq) const {
        const int row0 = u.pm * 256 + wr * 64 + fr, col0 = u.pn * 256 + wc * 32 + 4 * fq;
        const int b = u.pm < 2 ? 0 : (u.pm < 66 ? 1 : 2);
        const GAS float* gate = (const GAS float*)modl + (size_t)(b * 6 + gi) * D;
        f32x4 gv[2][2], bv[2][2];
#pragma unroll
        for (int bj = 0; bj < 2; ++bj)
#pragma unroll
            for (int n = 0; n < 2; ++n) { gv[bj][n] = *(const GAS f32x4*)(gate + col0 + bj * 128 + n * 16); bv[bj][n] = bias ? *(const GAS f32x4*)((const GAS float*)bias + col0 + bj * 128 + n * 16) : (f32x4){0.f, 0.f, 0.f, 0.f}; }
#pragma unroll
        for (int ai = 0; ai < 2; ++ai)
#pragma unroll
            for (int m = 0; m < 4; ++m) { const int row = row0 + ai * 128 + m * 16; GAS float* rowp = (GAS float*)res + (size_t)row * D + col0;
                const GAS float* inp = in_x == nullptr ? (const GAS float*)rowp : (u.pm < 2 ? (const GAS float*)in_ctx + (size_t)row * D + col0 : (const GAS float*)in_x + (size_t)(row - NCTX) * D + col0);
#pragma unroll
                for (int bj = 0; bj < 2; ++bj)
#pragma unroll
                    for (int n = 0; n < 2; ++n) { GAS f32x4* p = (GAS f32x4*)(rowp + bj * 128 + n * 16); *p = *(const GAS f32x4*)(inp + bj * 128 + n * 16) + gv[bj][n] * (acc[ai][bj][m][n] + bv[bj][n]); } }
    }
};

struct EpiSwiGLU {
    static constexpr bool PERM = true;
    bf16_t* O; int ldo;
    __device__ __forceinline__ void operator()(const AccT& acc, const Unit& u, int wr, int wc, int fr, int fq) const {
        const int row0 = u.pm * 256 + wr * 64 + fr, col0 = u.aux * 128 + wc * 32 + 8 * fq;
#pragma unroll
        for (int ai = 0; ai < 2; ++ai)
#pragma unroll
            for (int m = 0; m < 4; ++m) { GAS bf16_t* rowp = (GAS bf16_t*)O + (size_t)(row0 + ai * 128 + m * 16) * ldo + col0;
                float o[8];
#pragma unroll
                for (int n = 0; n < 2; ++n)
#pragma unroll
                    for (int j = 0; j < 4; ++j) { const float g = acc[ai][0][m][n][j], up = acc[ai][1][m][n][j]; o[n * 4 + j] = siluf_(g) * up; }
                v4u w; w.x = pk2(o[0], o[1]); w.y = pk2(o[2], o[3]); w.z = pk2(o[4], o[5]); w.w = pk2(o[6], o[7]);
                *(GAS v4u*)rowp = w; }
    }
};
constexpr int FN = 16384;
constexpr int HY_NPOS = SEQ + CTXL;
__device__ __forceinline__ int pidx(int p) { return p + ((p >> 6) << 2); }
__device__ __forceinline__ f32x2 cmul(f32x2 a, f32x2 b) { return (f32x2){a.x * b.x - a.y * b.y, a.x * b.y + a.y * b.x}; }
__device__ __forceinline__ f32x2 cmulc(f32x2 a, f32x2 b) { return (f32x2){a.x * b.x + a.y * b.y, a.y * b.x - a.x * b.y}; }

#define W16C_ {1.0f, 0.92387953251f, 0.70710678119f, 0.38268343237f, 0.0f, -0.38268343237f, -0.70710678119f, -0.92387953251f}
#define W16S_ {0.0f, -0.38268343237f, -0.70710678119f, -0.92387953251f, -1.0f, -0.92387953251f, -0.70710678119f, -0.38268343237f}

template <bool INV> __device__ __forceinline__ void fft_pass16(LAS f32x2* X, const int S, const int lgS, const int tid_) {
    constexpr float wc[8] = W16C_, ws[8] = W16S_;
    int tid = tid_; asm volatile("" : "+v"(tid));
#pragma unroll 1
    for (int gi = 0; gi < 2; ++gi) {
        const int g = tid + gi * 512, blk = g >> lgS, q = g & (S - 1), base = blk * 16 * S + q;
        f32x2 e[16];
#pragma unroll
        for (int m = 0; m < 16; ++m) e[m] = X[pidx(base + m * S)];
        const float rev = -(float)q / (16.0f * (float)S); const float sn = __builtin_amdgcn_sinf(rev), cs = __builtin_amdgcn_cosf(rev);
        const f32x2 w1 = (f32x2){cs, sn}, w2 = cmul(w1, w1), w4 = cmul(w2, w2), w8 = cmul(w4, w4);
        if (!INV) {
#pragma unroll
            for (int m = 0; m < 8; ++m) { const f32x2 a = e[m], b = e[m + 8]; e[m] = a + b; e[m + 8] = cmul(a - b, cmul(w1, (f32x2){wc[m], ws[m]})); }
#pragma unroll
            for (int h = 0; h < 16; h += 8)
#pragma unroll
                for (int m = 0; m < 4; ++m) { const f32x2 a = e[h + m], b = e[h + m + 4]; e[h + m] = a + b; e[h + m + 4] = cmul(a - b, cmul(w2, (f32x2){wc[2 * m], ws[2 * m]})); }
#pragma unroll
            for (int h = 0; h < 16; h += 4)
#pragma unroll
                for (int m = 0; m < 2; ++m) { const f32x2 a = e[h + m], b = e[h + m + 2]; e[h + m] = a + b; e[h + m + 2] = cmul(a - b, cmul(w4, (f32x2){wc[4 * m], ws[4 * m]})); }
#pragma unroll
            for (int h = 0; h < 16; h += 2) { const f32x2 a = e[h], b = e[h + 1]; e[h] = a + b; e[h + 1] = cmul(a - b, w8); }
        } else {
#pragma unroll
            for (int h = 0; h < 16; h += 2) { const f32x2 a = e[h], b = cmulc(e[h + 1], w8); e[h] = a + b; e[h + 1] = a - b; }
#pragma unroll
            for (int h = 0; h < 16; h += 4)
#pragma unroll
                for (int m = 0; m < 2; ++m) { const f32x2 a = e[h + m], b = cmulc(e[h + m + 2], cmul(w4, (f32x2){wc[4 * m], ws[4 * m]})); e[h + m] = a + b; e[h + m + 2] = a - b; }
#pragma unroll
            for (int h = 0; h < 16; h += 8)
#pragma unroll
                for (int m = 0; m < 4; ++m) { const f32x2 a = e[h + m], b = cmulc(e[h + m + 4], cmul(w2, (f32x2){wc[2 * m], ws[2 * m]})); e[h + m] = a + b; e[h + m + 4] = a - b; }
#pragma unroll
            for (int m = 0; m < 8; ++m) { const f32x2 a = e[m], b = cmulc(e[m + 8], cmul(w1, (f32x2){wc[m], ws[m]})); e[m] = a + b; e[m + 8] = a - b; }
        }
#pragma unroll
        for (int m = 0; m < 16; ++m) X[pidx(base + m * S)] = e[m];
    }
}
template <bool INV> __device__ __forceinline__ void fft_pass4(LAS f32x2* X, const int tid_) {
    int tid = tid_; asm volatile("" : "+v"(tid));
#pragma unroll 2
    for (int gi = 0; gi < 8; ++gi) {
        const int base = pidx(4 * (tid + gi * 512));
        f32x2 e0 = X[base], e1 = X[base + 1], e2 = X[base + 2], e3 = X[base + 3];
        if (!INV) {
            f32x2 a = e0, b = e2; e0 = a + b; e2 = a - b;
            a = e1; b = e3; e1 = a + b; { const f32x2 d = a - b; e3 = (f32x2){d.y, -d.x}; }
            a = e0; b = e1; e0 = a + b; e1 = a - b;
            a = e2; b = e3; e2 = a + b; e3 = a - b;
        } else {
            f32x2 a = e0, b = e1; e0 = a + b; e1 = a - b;
            a = e2; b = e3; e2 = a + b; e3 = a - b;
            a = e0; b = e2; e0 = a + b; e2 = a - b;
            a = e1; b = (f32x2){-e3.y, e3.x}; e1 = a + b; e3 = a - b;
        }
        X[base] = e0; X[base + 1] = e1; X[base + 2] = e2; X[base + 3] = e3;
    }
}
__device__ __forceinline__ void fft_fwd(LAS f32x2* X, int tid) {
    fft_pass16<false>(X, 1024, 10, tid); __syncthreads(); fft_pass16<false>(X, 64, 6, tid); __syncthreads(); fft_pass16<false>(X, 4, 2, tid); __syncthreads(); fft_pass4<false>(X, tid); __syncthreads();
}
__device__ __forceinline__ void fft_inv(LAS f32x2* X, int tid) {
    fft_pass4<true>(X, tid); __syncthreads(); fft_pass16<true>(X, 4, 2, tid); __syncthreads(); fft_pass16<true>(X, 64, 6, tid); __syncthreads(); fft_pass16<true>(X, 1024, 10, tid); __syncthreads();
}

__device__ __forceinline__ float conv3(const GAS float* seq, int n, int L, float w0, float w1, float w2, float cb) {
    const float p0 = n > 0 ? seq[n - 1] : 0.f, p1 = seq[n], p2 = n < L - 1 ? seq[n + 1] : 0.f;
    return w0 * p0 + w1 * p1 + w2 * p2 + cb;
}

__device__ __forceinline__ float conv3u(const GAS float* seq, unsigned n, float w0, float w1, float w2, float cb) {
    const float p0 = n > 0u ? seq[n - 1u] : 0.f, p1 = seq[n], p2 = n < (unsigned)(SEQ - 1) ? seq[n + 1u] : 0.f;
    return w0 * p0 + w1 * p1 + w2 * p2 + cb;
}

struct Tap4 { f32x4 q; float l, r; };
__device__ __forceinline__ Tap4 tap4_load(const GAS float* seq, unsigned nb) {
    Tap4 t; t.q = *(const GAS f32x4*)(seq + nb); t.l = nb ? seq[nb - 1u] : 0.f; t.r = nb + 4u < (unsigned)SEQ ? seq[nb + 4u] : 0.f; return t;
}
__device__ __forceinline__ f32x4 conv3q(const Tap4& t, float w0, float w1, float w2, float cb) {
    return (f32x4){w0 * t.l + w1 * t.q.x + w2 * t.q.y + cb, w0 * t.q.x + w1 * t.q.y + w2 * t.q.z + cb, w0 * t.q.y + w1 * t.q.z + w2 * t.q.w + cb, w0 * t.q.z + w1 * t.q.w + w2 * t.r + cb};
}

__device__ __forceinline__ void ph_hy_filter_mlp(const Ctx& C, const float* w1, const float* b1, const float* w2, const float* b2, const float* w3, const float* b3, const float* freq, bf16_t* HB) {
    const int gw = C.bid * NWAVES + C.wave, NGW = C.G * NWAVES, j = C.lane;
    const GAS float* W1 = (const GAS float*)w1; const GAS float* W2 = (const GAS float*)w2; const GAS float* W3 = (const GAS float*)w3;
    const float f0 = freq[j], f1 = freq[64 + j], f2 = freq[128 + j], bb1 = b1[j], bb2 = b2[j], bb3 = b3[j];
    for (int p = gw; p < HY_NPOS; p += NGW) {
        const int L = p < SEQ ? SEQ : CTXL; const int pos = p < SEQ ? p : p - SEQ;
        const float fpos = (float)pos, t = fpos / (float)(L - 1);
        const float a = (float)(6.283185307179586 / (double)L) * fpos;
        float z = 0.f;
        if (j == 0) z = t;
        else if (j <= 32) { const int bi = (j - 1) & 15; const float band = 1e-4f + (float)bi * ((15.0f - 1e-4f) / 15.0f); const float ang = a * band; z = (j <= 16) ? cosf(ang) : -sinf(ang); }
        float acc = bb1;
#pragma unroll
        for (int i = 0; i < 33; ++i) acc += __shfl(z, i) * W1[i * 64 + j];
        float h = sinf(f0 * acc);
        acc = bb2;
#pragma unroll 16
        for (int i = 0; i < 64; ++i) acc += __shfl(h, i) * W2[i * 64 + j];
        h = sinf(f1 * acc);
        acc = bb3;
#pragma unroll 16
        for (int i = 0; i < 64; ++i) acc += __shfl(h, i) * W3[i * 64 + j];
        h = sinf(f2 * acc);
        const unsigned hi = f2bf(h); const unsigned lo = f2bf(h - bf2f(hi));
        GAS bf16_t* o = (GAS bf16_t*)HB + (size_t)p * 256;
        o[j] = (bf16_t)hi; o[64 + j] = (bf16_t)lo; o[128 + j] = (bf16_t)hi; o[192 + j] = 0;
    }
}
__device__ __forceinline__ void ph_hy_w4split(const Ctx& C, const float* w4, bf16_t* AW) {
    for (int i = C.bid * NTHR + C.tid; i < 64 * 4096; i += C.G * NTHR) { const int k = i >> 12, n = i & 4095; const float w = w4[i];
        const unsigned hi = f2bf(w), lo = f2bf(w - bf2f(hi)); GAS bf16_t* o = (GAS bf16_t*)AW + (size_t)n * 256;
        o[k] = (bf16_t)hi; o[64 + k] = (bf16_t)hi; o[128 + k] = (bf16_t)lo; o[192 + k] = 0; }
}
struct EpiHyFilt {
    static constexpr bool PERM = false;
    float* F;
    __device__ __forceinline__ void operator()(const AccT& acc, const Unit& u, int wr, int wc, int fr, int fq) const {
        const int row0 = u.pm * 256 + wr * 64 + fr, col0 = u.pn * 256 + wc * 32 + 4 * fq;
        const float d0 = -15.350567286626973f, d1 = -3.0701134573253946f;
#pragma unroll
        for (int ai = 0; ai < 2; ++ai)
#pragma unroll
            for (int m = 0; m < 4; ++m) { const int row = row0 + ai * 128 + m * 16, ch = row & 1023;
                const float ad = fabsf(d0 + (d1 - d0) * ((float)ch / 1023.0f));
                GAS float* rowp = (GAS float*)F + (size_t)row * HY_NPOS + col0;
#pragma unroll
                for (int bj = 0; bj < 2; ++bj)
#pragma unroll
                    for (int n = 0; n < 2; ++n) { const int c0 = col0 + bj * 128 + n * 16; f32x4 o;
#pragma unroll
                        for (int jj = 0; jj < 4; ++jj) { const int p = c0 + jj; const float t = p < SEQ ? (float)p / (float)(SEQ - 1) : (float)(p - SEQ) / (float)(CTXL - 1); o[jj] = acc[ai][bj][m][n][jj] * __expf(-t * ad); }
                        *(GAS f32x4*)(rowp + bj * 128 + n * 16) = o; } }
    }
};

#ifndef HY_STAGGER
#define HY_STAGGER 3000
#endif
#ifdef HY_STAMP
#define HSTAMP(k) do { __syncthreads(); const unsigned long long t1_ = __builtin_amdgcn_s_memrealtime(); hacc[k] += t1_ - hprev; hprev = t1_; } while (0)
#else
#define HSTAMP(k) do { } while (0)
#endif
__device__ __forceinline__ void ph_hy_conv(const Ctx& C, const float* PROJT, const float* FILT, const float* cw, const float* cbias, const float* skip, float* YT, f32x2* SCR, void* SCR_TS = nullptr) {
    LAS f32x2* X = (LAS f32x2*)C.lds;
    GAS f32x2* R1 = (GAS f32x2*)SCR + (size_t)C.bid * 3 * FN;
    const int tid = C.tid;
#ifdef HY_STAMP
    unsigned long long hacc[6] = {0, 0, 0, 0, 0, 0}; unsigned long long hprev = __builtin_amdgcn_s_memrealtime();
#endif
    for (int ch = C.bid; ch < D; ch += C.G) {
        const GAS float* px1 = (const GAS float*)PROJT + (size_t)ch * MROWS; const GAS float* px2 = (const GAS float*)PROJT + (size_t)(D + ch) * MROWS; const GAS float* pv = (const GAS float*)PROJT + (size_t)(2 * D + ch) * MROWS;
        const float a0 = cw[ch], a1 = cw[3 * D + ch], a2 = cw[6 * D + ch], ab = cbias[ch];
        const float b0 = cw[D + ch], b1 = cw[3 * D + D + ch], b2 = cw[6 * D + D + ch], bb = cbias[D + ch];
        const float v0 = cw[2 * D + ch], v1 = cw[3 * D + 2 * D + ch], v2 = cw[6 * D + 2 * D + ch], vb = cbias[2 * D + ch];
        {   LAS float* gf = (LAS float*)C.lds;
            LAS float* us = gf + 1024;
            LAS float* zs = us + 512;
            int tc = tid; asm volatile("" : "+v"(tc));
            for (int i = tc; i < 1024; i += NTHR) gf[i] = ((const GAS float*)FILT)[(size_t)((i >> 8) * D + ch) * HY_NPOS + SEQ + (i & 255)];
            const int b = tc >> 8, t = tc & 255;
            us[tc] = conv3(pv + b * CTXL, t, CTXL, v0, v1, v2, vb);
            __syncthreads();
            float y = skip[ch] * us[tc];
#pragma unroll 16
            for (int s = 0; s < CTXL; ++s) { const int k = t - s; const float g = gf[k >= 0 ? k : 256 - k]; y += g * us[b * 256 + s]; }
            zs[tc] = y * conv3(px1 + b * CTXL, t, CTXL, a0, a1, a2, ab);
            __syncthreads();
            float y2 = skip[D + ch] * zs[tc];
#pragma unroll 16
            for (int s = 0; s < CTXL; ++s) { const int k = t - s; const float g = gf[512 + (k >= 0 ? k : 256 - k)]; y2 += g * zs[b * 256 + s]; }
            ((GAS float*)YT)[(size_t)ch * MROWS + b * CTXL + t] = y2 * conv3(px2 + b * CTXL, t, CTXL, b0, b1, b2, bb);
            __syncthreads();
        }
        HSTAMP(0);
        const GAS float* lv0 = pv + NCTX; const GAS float* lv1 = pv + NCTX + SEQ;
        const GAS float* lx10 = px1 + NCTX; const GAS float* lx20 = px2 + NCTX;
        GAS float* yt0 = (GAS float*)YT + (size_t)ch * MROWS + NCTX; GAS float* yt1 = yt0 + SEQ;
        f32x2 ur[32], ks[32];
        unsigned tq = (unsigned)tid; asm volatile("" : "+v"(tq));
        float cv0 = v0, cv1 = v1, cv2 = v2, cvb = vb; asm volatile("" : "+v"(cv0), "+v"(cv1), "+v"(cv2), "+v"(cvb));
#pragma unroll
        for (int c_ = 0; c_ < 8; c_ += 8) {
#pragma unroll
            for (int j_ = 0; j_ < 8; ++j_) { const int g = c_ + j_; const unsigned nb = 4u * tq + 2048u * g; LAS f32x4* xq = (LAS f32x4*)(X + 4u * (tq + (tq >> 4)) + 2176u * g); (void)nb; (void)xq;
                const Tap4 ta = tap4_load(lv0, nb), tb = tap4_load(lv1, nb); const f32x4 ca = conv3q(ta, cv0, cv1, cv2, cvb), cb_ = conv3q(tb, cv0, cv1, cv2, cvb);
                ur[4 * g] = (f32x2){ca.x, cb_.x}; ur[4 * g + 1] = (f32x2){ca.y, cb_.y}; ur[4 * g + 2] = (f32x2){ca.z, cb_.z}; ur[4 * g + 3] = (f32x2){ca.w, cb_.w}; }
            __builtin_amdgcn_sched_barrier(0); }
        HSTAMP(1);
#pragma unroll 1
        for (int o = 0; o < 2; ++o) {
            const GAS float* hf = (const GAS float*)FILT + (size_t)((o * 2 + 0) * D + ch) * HY_NPOS; const GAS float* hb = (const GAS float*)FILT + (size_t)((o * 2 + 1) * D + ch) * HY_NPOS;
            const float sk = skip[o * D + ch];
            asm volatile("" : "+v"(tq));
#pragma unroll
            for (int c_ = 0; c_ < 8; c_ += 8) {
#pragma unroll
                for (int j_ = 0; j_ < 8; ++j_) { const int g = c_ + j_; const unsigned nb = 4u * tq + 2048u * g; LAS f32x4* xq = (LAS f32x4*)(X + 4u * (tq + (tq >> 4)) + 2176u * g); (void)nb; (void)xq;
                    const f32x4 f = *(const GAS f32x4*)(hf + nb), rq = *(const GAS f32x4*)(hb + ((unsigned)FN - 4u - nb)); const float r0 = nb ? hb[(unsigned)FN - nb] : 0.f;
                xq[0] = (f32x4){f.x + r0, 0.f, f.y + rq.w, 0.f}; xq[1] = (f32x4){f.z + rq.z, 0.f, f.w + rq.y, 0.f}; }
                __builtin_amdgcn_sched_barrier(0); }
            __syncthreads(); HSTAMP(2); fft_fwd(X, tid); HSTAMP(3);
            asm volatile("" : "+v"(tq));
#pragma unroll
            for (int c_ = 0; c_ < 8; c_ += 8) {
#pragma unroll
                for (int j_ = 0; j_ < 8; ++j_) { const int g = c_ + j_; const unsigned nb = 4u * tq + 2048u * g; LAS f32x4* xq = (LAS f32x4*)(X + 4u * (tq + (tq >> 4)) + 2176u * g); (void)nb; (void)xq;
                    const f32x4 a = xq[0], b = xq[1]; ks[4 * g] = (f32x2){a.x, a.y}; ks[4 * g + 1] = (f32x2){a.z, a.w}; ks[4 * g + 2] = (f32x2){b.x, b.y}; ks[4 * g + 3] = (f32x2){b.z, b.w};
                xq[0] = (f32x4){ur[4 * g].x, ur[4 * g].y, ur[4 * g + 1].x, ur[4 * g + 1].y}; xq[1] = (f32x4){ur[4 * g + 2].x, ur[4 * g + 2].y, ur[4 * g + 3].x, ur[4 * g + 3].y}; }
                __builtin_amdgcn_sched_barrier(0); }
            __syncthreads();
            HSTAMP(4); fft_fwd(X, tid); HSTAMP(3);
            asm volatile("" : "+v"(tq));
#pragma unroll
            for (int c_ = 0; c_ < 8; c_ += 8) {
#pragma unroll
                for (int j_ = 0; j_ < 8; ++j_) { const int g = c_ + j_; const unsigned nb = 4u * tq + 2048u * g; LAS f32x4* xq = (LAS f32x4*)(X + 4u * (tq + (tq >> 4)) + 2176u * g); (void)nb; (void)xq;
                    const f32x4 a = xq[0], b = xq[1]; const f32x2 m0 = cmul((f32x2){a.x, a.y}, ks[4 * g]), m1 = cmul((f32x2){a.z, a.w}, ks[4 * g + 1]), m2 = cmul((f32x2){b.x, b.y}, ks[4 * g + 2]), m3 = cmul((f32x2){b.z, b.w}, ks[4 * g + 3]);
                xq[0] = (f32x4){m0.x, m0.y, m1.x, m1.y}; xq[1] = (f32x4){m2.x, m2.y, m3.x, m3.y}; }
                __builtin_amdgcn_sched_barrier(0); }
            __syncthreads(); HSTAMP(4); fft_inv(X, tid); HSTAMP(3);
            asm volatile("" : "+v"(tq));
#pragma unroll
            for (int c_ = 0; c_ < 8; c_ += 8) {
#pragma unroll
                for (int j_ = 0; j_ < 8; ++j_) { const int g = c_ + j_; const unsigned nb = 4u * tq + 2048u * g; LAS f32x4* xq = (LAS f32x4*)(X + 4u * (tq + (tq >> 4)) + 2176u * g); (void)nb; (void)xq;
                    GAS f32x4* rq_ = (GAS f32x4*)(R1 + nb); rq_[0] = xq[0]; rq_[1] = xq[1]; }
                __builtin_amdgcn_sched_barrier(0); }
#pragma unroll
            for (int c_ = 0; c_ < 8; c_ += 8) {
#pragma unroll
                for (int j_ = 0; j_ < 8; ++j_) { const int g = c_ + j_; const unsigned nb = 4u * tq + 2048u * g; LAS f32x4* xq = (LAS f32x4*)(X + 4u * (tq + (tq >> 4)) + 2176u * g); (void)nb; (void)xq;
                    const f32x4 f = *(const GAS f32x4*)(hf + nb), rq = *(const GAS f32x4*)(hb + ((unsigned)FN - 4u - nb)); const float r0 = nb ? hb[(unsigned)FN - nb] : 0.f;
                const float d0 = f.x - r0, d1 = f.y - rq.w, d2 = f.z - rq.z, d3 = f.w - rq.y;
                const float v0_ = -(float)nb * (0.5f / (float)FN), v1_ = -(float)(nb + 1u) * (0.5f / (float)FN), v2_ = -(float)(nb + 2u) * (0.5f / (float)FN), v3_ = -(float)(nb + 3u) * (0.5f / (float)FN);
                xq[0] = (f32x4){d0 * __builtin_amdgcn_cosf(v0_), d0 * __builtin_amdgcn_sinf(v0_), d1 * __builtin_amdgcn_cosf(v1_), d1 * __builtin_amdgcn_sinf(v1_)};
                xq[1] = (f32x4){d2 * __builtin_amdgcn_cosf(v2_), d2 * __builtin_amdgcn_sinf(v2_), d3 * __builtin_amdgcn_cosf(v3_), d3 * __builtin_amdgcn_sinf(v3_)}; }
                __builtin_amdgcn_sched_barrier(0); }
            __syncthreads(); HSTAMP(2); fft_fwd(X, tid); HSTAMP(3);
            asm volatile("" : "+v"(tq));
#pragma unroll
            for (int c_ = 0; c_ < 8; c_ += 8) {
#pragma unroll
                for (int j_ = 0; j_ < 8; ++j_) { const int g = c_ + j_; const unsigned nb = 4u * tq + 2048u * g; LAS f32x4* xq = (LAS f32x4*)(X + 4u * (tq + (tq >> 4)) + 2176u * g); (void)nb; (void)xq;
                    const f32x4 a = xq[0], b = xq[1]; ks[4 * g] = (f32x2){a.x, a.y}; ks[4 * g + 1] = (f32x2){a.z, a.w}; ks[4 * g + 2] = (f32x2){b.x, b.y}; ks[4 * g + 3] = (f32x2){b.z, b.w};
                f32x2 t_[4];
#pragma unroll
                for (int j = 0; j < 4; ++j) { const float rv = -(float)(nb + j) * (0.5f / (float)FN); t_[j] = cmul(ur[4 * g + j], (f32x2){__builtin_amdgcn_cosf(rv), __builtin_amdgcn_sinf(rv)}); }
                xq[0] = (f32x4){t_[0].x, t_[0].y, t_[1].x, t_[1].y}; xq[1] = (f32x4){t_[2].x, t_[2].y, t_[3].x, t_[3].y}; }
                __builtin_amdgcn_sched_barrier(0); }
            __syncthreads(); HSTAMP(4); fft_fwd(X, tid); HSTAMP(3);
            asm volatile("" : "+v"(tq));
#pragma unroll
            for (int c_ = 0; c_ < 8; c_ += 8) {
#pragma unroll
                for (int j_ = 0; j_ < 8; ++j_) { const int g = c_ + j_; const unsigned nb = 4u * tq + 2048u * g; LAS f32x4* xq = (LAS f32x4*)(X + 4u * (tq + (tq >> 4)) + 2176u * g); (void)nb; (void)xq;
                    const f32x4 a = xq[0], b = xq[1]; const f32x2 m0 = cmul((f32x2){a.x, a.y}, ks[4 * g]), m1 = cmul((f32x2){a.z, a.w}, ks[4 * g + 1]), m2 = cmul((f32x2){b.x, b.y}, ks[4 * g + 2]), m3 = cmul((f32x2){b.z, b.w}, ks[4 * g + 3]);
                xq[0] = (f32x4){m0.x, m0.y, m1.x, m1.y}; xq[1] = (f32x4){m2.x, m2.y, m3.x, m3.y}; }
                __builtin_amdgcn_sched_barrier(0); }
            VM_WAIT();
#pragma unroll
            for (int c_ = 0; c_ < 8; c_ += 8) {
#pragma unroll
                for (int j_ = 0; j_ < 8; ++j_) { const int g = c_ + j_; const unsigned nb = 4u * tq + 2048u * g; LAS f32x4* xq = (LAS f32x4*)(X + 4u * (tq + (tq >> 4)) + 2176u * g); (void)nb; (void)xq;
                    const GAS f32x4* rq_ = (const GAS f32x4*)(R1 + nb); const f32x4 a = rq_[0], b = rq_[1]; ks[4 * g] = (f32x2){a.x, a.y}; ks[4 * g + 1] = (f32x2){a.z, a.w}; ks[4 * g + 2] = (f32x2){b.x, b.y}; ks[4 * g + 3] = (f32x2){b.z, b.w}; }
                __builtin_amdgcn_sched_barrier(0); }
            __syncthreads(); HSTAMP(4); fft_inv(X, tid); HSTAMP(3);
            asm volatile("" : "+v"(tq));
            const GAS float* gx0 = o ? lx20 : lx10; const GAS float* gx1 = gx0 + SEQ;
            float gw0 = o ? b0 : a0, gw1 = o ? b1 : a1, gw2 = o ? b2 : a2, gwb = o ? bb : ab; asm volatile("" : "+v"(gw0), "+v"(gw1), "+v"(gw2), "+v"(gwb));
#pragma unroll
            for (int c_ = 0; c_ < 8; c_ += 8) {
#pragma unroll
                for (int j_ = 0; j_ < 8; ++j_) { const int g = c_ + j_; const unsigned nb = 4u * tq + 2048u * g; LAS f32x4* xq = (LAS f32x4*)(X + 4u * (tq + (tq >> 4)) + 2176u * g); (void)nb; (void)xq;
                    const f32x4 a = xq[0], b = xq[1]; const f32x2 xv[4] = {(f32x2){a.x, a.y}, (f32x2){a.z, a.w}, (f32x2){b.x, b.y}, (f32x2){b.z, b.w}}; f32x2 y[4];
#pragma unroll
                for (int j = 0; j < 4; ++j) { const float rv = -(float)(nb + j) * (0.5f / (float)FN); const f32x2 r2 = cmulc(xv[j], (f32x2){__builtin_amdgcn_cosf(rv), __builtin_amdgcn_sinf(rv)}); y[j] = (ks[4 * g + j] + r2) * (0.5f / (float)FN) + ur[4 * g + j] * sk; }
                const Tap4 ta = tap4_load(gx0, nb), tb = tap4_load(gx1, nb); const f32x4 ga = conv3q(ta, gw0, gw1, gw2, gwb), gb = conv3q(tb, gw0, gw1, gw2, gwb);
                if (o == 0) {
                    ur[4 * g] = (f32x2){y[0].x * ga.x, y[0].y * gb.x}; ur[4 * g + 1] = (f32x2){y[1].x * ga.y, y[1].y * gb.y}; ur[4 * g + 2] = (f32x2){y[2].x * ga.z, y[2].y * gb.z}; ur[4 * g + 3] = (f32x2){y[3].x * ga.w, y[3].y * gb.w}; }
                else {
                    *(GAS f32x4*)(yt0 + nb) = (f32x4){y[0].x * ga.x, y[1].x * ga.y, y[2].x * ga.z, y[3].x * ga.w}; *(GAS f32x4*)(yt1 + nb) = (f32x4){y[0].y * gb.x, y[1].y * gb.y, y[2].y * gb.z, y[3].y * gb.w}; } }
                __builtin_amdgcn_sched_barrier(0); }
            __syncthreads(); HSTAMP(5);
        }
    }
#ifdef HY_STAMP
    if (C.bid == 0 && tid == 0) { unsigned long long* TSX = (unsigned long long*)SCR_TS; for (int k = 0; k < 6; ++k) TSX[k] = hacc[k]; }
#endif
}

__device__ __forceinline__ void ph_hy_transpose(const Ctx& C, const float* YT, bf16_t* YB) {
    LAS float* t = (LAS float*)C.lds;
    const int NIT = (D / 64) * (MROWS / 64);
    for (int it = C.bid; it < NIT; it += C.G) {
        const int c0 = (it % (D / 64)) * 64, t0 = (it / (D / 64)) * 64;
        {   const int tq = C.tid & 15, cc0 = C.tid >> 4;
            f32x4 v[2];
#pragma unroll
            for (int q = 0; q < 2; ++q) v[q] = *(const GAS f32x4*)((const GAS float*)YT + (size_t)(c0 + cc0 + 32 * q) * MROWS + t0 + 4 * tq);
#pragma unroll
            for (int q = 0; q < 2; ++q) { LAS float* d = t + (cc0 + 32 * q) * 65 + 4 * tq; d[0] = v[q].x; d[1] = v[q].y; d[2] = v[q].z; d[3] = v[q].w; } }
        __syncthreads();
        {   const int cq = C.tid & 15, tt0 = C.tid >> 4;
#pragma unroll
            for (int q = 0; q < 2; ++q) { const int tt = tt0 + 32 * q; v2u w; w.x = pk2(t[(4 * cq + 0) * 65 + tt], t[(4 * cq + 1) * 65 + tt]); w.y = pk2(t[(4 * cq + 2) * 65 + tt], t[(4 * cq + 3) * 65 + tt]);
                *(GAS v2u*)((GAS bf16_t*)YB + (size_t)(t0 + tt) * D + c0 + 4 * cq) = w; } }
        __syncthreads();
    }
}
constexpr int RW_H = 16, RW_N = 64;
constexpr int NSTEP = CTXL + SEQ;

__device__ __forceinline__ void ph_rw_mix(const Ctx& C, const ResSrc& src, const float* rstd, const float* g, const float* modl, const float* mu, bf16_t* X6) {
    const int gw = C.bid * NWAVES + C.wave, NGW = C.G * NWAVES, lane = C.lane;
    f32x4 gv[4], muv[6][4];
#pragma unroll
    for (int j = 0; j < 4; ++j) { gv[j] = ((const GAS f32x4*)g + lane)[64 * j];
#pragma unroll
        for (int m = 0; m < 6; ++m) muv[m][j] = ((const GAS f32x4*)(mu + (size_t)m * D) + lane)[64 * j]; }
    for (int r = gw; r < MROWS; r += NGW) {
        int nb[4]; bool ok[4];
        if (r < NCTX) { const int t = r & 255; nb[0] = nb[1] = r - 1; ok[0] = ok[1] = t > 0; nb[2] = nb[3] = r + 1; ok[2] = ok[3] = t < 255; }
        else { const int l = (r - NCTX) & (SEQ - 1), gy = l >> 6, gx = l & 63; nb[0] = r - 1; ok[0] = gx > 0; nb[1] = r + 1; ok[1] = gx < 63; nb[2] = r - 64; ok[2] = gy > 0; nb[3] = r + 64; ok[3] = gy < 255; }
        const int b = row_bidx(r);
        const float so = rstd[r];
        const GAS f32x4* own = (const GAS f32x4*)res_row(src, r) + lane;
        const GAS f32x4* sh4 = (const GAS f32x4*)(modl + (size_t)(b * 6 + 0) * D) + lane; const GAS f32x4* sc4 = (const GAS f32x4*)(modl + (size_t)(b * 6 + 1) * D) + lane;
        f32x4 ov[4], nv[4], shv[4], scv[4]; float sn[4];
#pragma unroll
        for (int j = 0; j < 4; ++j) { ov[j] = own[64 * j]; shv[j] = sh4[64 * j]; scv[j] = sc4[64 * j];
            const int nr = ok[j] ? nb[j] : r; sn[j] = rstd[nr]; nv[j] = ((const GAS f32x4*)res_row(src, nr) + lane)[64 * j]; }
#pragma unroll
        for (int j = 0; j < 4; ++j) {
            const f32x4 gg = gv[j] * (scv[j] + 1.0f), sh = shv[j];
            const f32x4 ho = ov[j] * so * gg + sh;
            const f32x4 hn = ok[j] ? (nv[j] * sn[j] * gg + sh) : (f32x4){0.f, 0.f, 0.f, 0.f};
            const f32x4 xx = hn - ho;
#pragma unroll
            for (int m = 0; m < 6; ++m) { const f32x4 x = ho + xx * muv[m][j];
                v2u w; w.x = pk2(x.x, x.y); w.y = pk2(x.z, x.w); ((GAS v2u*)(X6 + ((size_t)m * MROWS + r) * D) + lane)[64 * j] = w; }
        }
    }
}

struct SchedRw1 {
    const bf16_t* X6; const bf16_t* Wrkv; const bf16_t* Ldn; int nN, G, c;
    __device__ __forceinline__ bool next(int i, Unit& u) const { const bool ok = pg8::static_unit(PMT, nN, G, c, i, u.pm, u.pn); u.aux = 0; return ok; }
    __device__ __forceinline__ const char* a_ptr(const Unit& u) const { const int am = u.pn < 4 ? 0 : u.pn < 8 ? 2 : u.pn < 12 ? 3 : u.pn == 12 ? 1 : u.pn == 13 ? 4 : u.pn == 14 ? 5 : 3;
        return (const char*)(X6 + ((size_t)am * MROWS + (size_t)u.pm * 256) * D); }
    __device__ __forceinline__ const char* b_ptr(const Unit& u) const { return u.pn < 12 ? (const char*)(Wrkv + (size_t)u.pn * 256 * D) : (const char*)(Ldn + (size_t)(u.pn - 12) * 256 * D); }
};
__device__ __forceinline__ float act_sel(float x, int act) { const float e = __expf(act == 1 ? 2.0f * x : -x); const float t = 1.0f - 2.0f / (e + 1.0f), s = 1.0f / (1.0f + e); return act == 1 ? t : (act == 2 ? s : x); }
struct EpiRw1 {
    static constexpr bool PERM = true;
    bf16_t* Rb; bf16_t* Kb; bf16_t* Vb; bf16_t* LD;
    __device__ __forceinline__ void operator()(const AccT& acc, const Unit& u, int wr, int wc, int fr, int fq) const {
        const int row0 = u.pm * 256 + wr * 64 + fr;
        const int grp = u.pn >> 2;
        const size_t doff = (size_t)(grp == 0) * (size_t)Rb + (size_t)(grp == 1) * (size_t)Kb + (size_t)(grp == 2) * (size_t)Vb + (size_t)(grp == 3) * (size_t)LD;
        bf16_t* dst = (bf16_t*)doff;
        const int colt = (u.pn & 3) * 256; const int act = (u.pn == 12) ? 1 : ((u.pn == 14) ? 2 : 0);
        const int col0 = colt + wc * 32 + 8 * fq;
        if (act == 0) {
#pragma unroll
            for (int ai = 0; ai < 2; ++ai)
#pragma unroll
                for (int m = 0; m < 4; ++m) { GAS bf16_t* rowp = (GAS bf16_t*)dst + (size_t)(row0 + ai * 128 + m * 16) * D + col0;
#pragma unroll
                    for (int bj = 0; bj < 2; ++bj) { const f32x4 p = acc[ai][bj][m][0], q = acc[ai][bj][m][1];
                        v4u w; w.x = pk2(p[0], p[1]); w.y = pk2(p[2], p[3]); w.z = pk2(q[0], q[1]); w.w = pk2(q[2], q[3]);
                        *(GAS v4u*)(rowp + bj * 128) = w; } }
        } else {
#pragma unroll
            for (int ai = 0; ai < 2; ++ai)
#pragma unroll
                for (int m = 0; m < 4; ++m) { GAS bf16_t* rowp = (GAS bf16_t*)dst + (size_t)(row0 + ai * 128 + m * 16) * D + col0;
#pragma unroll
                    for (int bj = 0; bj < 2; ++bj) { const f32x4 p = acc[ai][bj][m][0], q = acc[ai][bj][m][1];
                        v4u w; w.x = pk2(act_sel(p[0], act), act_sel(p[1], act)); w.y = pk2(act_sel(p[2], act), act_sel(p[3], act)); w.z = pk2(act_sel(q[0], act), act_sel(q[1], act)); w.w = pk2(act_sel(q[2], act), act_sel(q[3], act));
                        *(GAS v4u*)(rowp + bj * 128) = w; } }
        }
    }
};

struct SchedRw2 {
    const bf16_t* LD; const bf16_t* Lup; int nN, G, c;
    __device__ __forceinline__ bool next(int i, Unit& u) const { const bool ok = pg8::static_unit(PMT, nN, G, c, i, u.pm, u.pn); u.aux = 0; return ok; }
    __device__ __forceinline__ const char* a_ptr(const Unit& u) const { const int grp = u.pn < 8 ? 0 : u.pn < 16 ? 1 : u.pn < 20 ? 2 : 3; return (const char*)(LD + (size_t)u.pm * 256 * D + grp * 256); }
    __device__ __forceinline__ const char* b_ptr(const Unit& u) const { return (const char*)(Lup + (size_t)u.pn * 256 * 256); }
};
struct EpiRw2 {
    static constexpr bool PERM = false;
    bf16_t* DEC; bf16_t* ASIG; bf16_t* Gb; bf16_t* Vb; const bf16_t* VF; const float* w0; const float* a0; const float* v0;
    __device__ __forceinline__ void operator()(const AccT& acc, const Unit& u, int wr, int wc, int fr, int fq) const {
        const int row0 = u.pm * 256 + wr * 64 + fr;
        const int pn = u.pn, colt = (pn & 3) * 256 + wc * 32 + 4 * fq;
        const GAS float* cbp = pn < 8 ? (const GAS float*)w0 + (pn >> 2) * D : (pn < 16 ? (const GAS float*)a0 + ((pn - 8) >> 2) * D : (const GAS float*)v0);
        const float cbs = (pn >= 16 && pn < 20) ? 0.f : 1.f;
        const int mode = pn < 8 ? 0 : (pn < 16 ? 1 : (pn < 20 ? 2 : 3));
        const size_t dsel = (size_t)((pn < 8 ? pn : pn - 8) >> 2) * MROWS;
#pragma unroll
        for (int ai = 0; ai < 2; ++ai)
#pragma unroll
            for (int m = 0; m < 4; ++m) { const size_t row = (size_t)(row0 + ai * 128 + m * 16);
#pragma unroll
                for (int bj = 0; bj < 2; ++bj)
#pragma unroll
                    for (int n = 0; n < 2; ++n) { const int col = colt + bj * 128 + n * 16;
                        const f32x4 x = acc[ai][bj][m][n] + *(const GAS f32x4*)(cbp + col) * cbs;
                        if (mode == 0) { f32x4 o;
#pragma unroll
                            for (int j = 0; j < 4; ++j) { const float z = -x[j]; const float sp = z > 20.f ? z : __logf(1.0f + __expf(z)); o[j] = -__expf(-sp - 0.5f); }
                            { v2u w; w.x = pk2(o[0], o[1]); w.y = pk2(o[2], o[3]); *(GAS v2u*)((GAS bf16_t*)DEC + (dsel + row) * D + col) = w; } }
                        else if (mode == 1) { v2u w; w.x = pk2(sigmoidf_(x[0]), sigmoidf_(x[1])); w.y = pk2(sigmoidf_(x[2]), sigmoidf_(x[3]));
                            *(GAS v2u*)((GAS bf16_t*)ASIG + (dsel + row) * D + col) = w; }
                        else if (mode == 2) { v2u w; w.x = pk2(x[0], x[1]); w.y = pk2(x[2], x[3]); *(GAS v2u*)((GAS bf16_t*)Gb + row * D + col) = w; }
                        else { GAS v2u* vp = (GAS v2u*)((GAS bf16_t*)Vb + row * D + col); const v2u vv = *vp; const v2u ff = *(const GAS v2u*)((const GAS bf16_t*)VF + row * D + col);
                            const float o0 = bflo(vv.x) + (bflo(ff.x) - bflo(vv.x)) * sigmoidf_(x[0]), o1 = bfhi(vv.x) + (bfhi(ff.x) - bfhi(vv.x)) * sigmoidf_(x[1]);
                            const float o2 = bflo(vv.y) + (bflo(ff.y) - bflo(vv.y)) * sigmoidf_(x[2]), o3 = bfhi(vv.y) + (bfhi(ff.y) - bfhi(vv.y)) * sigmoidf_(x[3]);
                            v2u w; w.x = pk2(o0, o1); w.y = pk2(o2, o3); *vp = w; } }
                asm volatile("" ::: "memory"); }
    }
};

__device__ __forceinline__ int rw_step_row(int d, int b, int s) {
    if (s < CTXL) return b * CTXL + (d == 0 ? s : CTXL - 1 - s);
    const int l = s - CTXL; return NCTX + b * SEQ + (d == 0 ? l : SEQ - 1 - l);
}
__device__ __forceinline__ float dpp_xor1(float v) { return __builtin_bit_cast(float, __builtin_amdgcn_update_dpp(0, __builtin_bit_cast(int, v), 0xB1, 0xf, 0xf, false)); }
__device__ __forceinline__ float dpp_xor2(float v) { return __builtin_bit_cast(float, __builtin_amdgcn_update_dpp(0, __builtin_bit_cast(int, v), 0x4E, 0xf, 0xf, false)); }
__device__ __forceinline__ float dpp_hmirror(float v) { return __builtin_bit_cast(float, __builtin_amdgcn_update_dpp(0, __builtin_bit_cast(int, v), 0x141, 0xf, 0xf, false)); }
__device__ __forceinline__ float sum8(float v) { v += dpp_xor1(v); v += dpp_xor2(v); v += dpp_hmirror(v); return v; }

__device__ __forceinline__ void ph_rw_scan_seq(const Ctx& C, const bf16_t* Rb, const bf16_t* Kb, const bf16_t* Vb, const float* DEC, const bf16_t* ASIG, const float* k_k, const float* k_a, const float* r_k, float* Y, float* BON) {
    constexpr int T = 32;
    LAS float* sw = (LAS float*)C.lds;
    LAS float* sa = sw + T * 64; LAS float* sb = sa + T * 64; LAS float* sk = sb + T * 64; LAS float* sr = sk + T * 64; LAS float* sv = sr + T * 64; LAS float* sy = sv + T * 64;
    for (int chain = C.bid; chain < 64; chain += C.G) {
        const int d = chain >> 5, b = (chain >> 4) & 1, h = chain & 15;
        const int v = C.tid >> 3, seg = C.tid & 7;
        float S[8];
#pragma unroll
        for (int j = 0; j < 8; ++j) S[j] = 0.f;
        const int hc = h * 64 + C.lane;
        const float kkw = k_k[hc], kaw = k_a[hc], rkw = r_k[hc];
        for (int s0 = 0; s0 < NSTEP; s0 += T) {
            for (int tt = C.wave; tt < T; tt += NWAVES) {
                const int row = rw_step_row(d, b, s0 + tt); const size_t o = (size_t)row * D + hc;
                const float kx = bf2f(((const GAS bf16_t*)Kb)[o]), rx = bf2f(((const GAS bf16_t*)Rb)[o]), vx = bf2f(((const GAS bf16_t*)Vb)[o]);
                const float lw = ((const GAS float*)DEC)[(size_t)d * MROWS * D + o], as = bf2f(((const GAS bf16_t*)ASIG)[(size_t)d * MROWS * D + o]);
                const float kk = kx * kkw; const float nrm = sqrtf(wave_sum(kk * kk)); const float kkn = kk / fmaxf(nrm, 1e-12f);
                const float kd = kx * (1.0f + (as - 1.0f) * kaw);
                const float bon = wave_sum(rx * kd * rkw);
                if (C.lane == 0) BON[((size_t)d * MROWS + row) * RW_H + h] = bon;
                const int li = tt * 64 + C.lane;
                sw[li] = __expf(lw); sa[li] = -kkn; sb[li] = kkn * as; sk[li] = kd; sr[li] = rx; sv[li] = vx;
            }
            __syncthreads();
#pragma unroll 2
            for (int tt = 0; tt < T; ++tt) {
                const LAS f32x4* pw = (const LAS f32x4*)(sw + tt * 64 + seg * 8); const LAS f32x4* pa = (const LAS f32x4*)(sa + tt * 64 + seg * 8); const LAS f32x4* pb = (const LAS f32x4*)(sb + tt * 64 + seg * 8);
                const LAS f32x4* pk = (const LAS f32x4*)(sk + tt * 64 + seg * 8); const LAS f32x4* pr = (const LAS f32x4*)(sr + tt * 64 + seg * 8);
                const f32x4 a0 = pa[0], a1 = pa[1], w0 = pw[0], w1 = pw[1], b0 = pb[0], b1 = pb[1], k0 = pk[0], k1 = pk[1], r0 = pr[0], r1 = pr[1];
                const float vv = sv[tt * 64 + v];
                float dot = (S[0] * a0.x + S[1] * a0.y) + (S[2] * a0.z + S[3] * a0.w) + (S[4] * a1.x + S[5] * a1.y) + (S[6] * a1.z + S[7] * a1.w);
                dot = sum8(dot);
                S[0] = S[0] * w0.x + dot * b0.x + vv * k0.x; S[1] = S[1] * w0.y + dot * b0.y + vv * k0.y; S[2] = S[2] * w0.z + dot * b0.z + vv * k0.z; S[3] = S[3] * w0.w + dot * b0.w + vv * k0.w;
                S[4] = S[4] * w1.x + dot * b1.x + vv * k1.x; S[5] = S[5] * w1.y + dot * b1.y + vv * k1.y; S[6] = S[6] * w1.z + dot * b1.z + vv * k1.z; S[7] = S[7] * w1.w + dot * b1.w + vv * k1.w;
                float y = (S[0] * r0.x + S[1] * r0.y) + (S[2] * r0.z + S[3] * r0.w) + (S[4] * r1.x + S[5] * r1.y) + (S[6] * r1.z + S[7] * r1.w);
                y = sum8(y);
                if (seg == 0) sy[tt * 64 + v] = y;
            }
            __syncthreads();
            for (int i = C.tid; i < T * 64; i += NTHR) { const int tt = i >> 6, c = i & 63; const int row = rw_step_row(d, b, s0 + tt); ((GAS float*)Y)[((size_t)d * MROWS + row) * D + h * 64 + c] = sy[i]; }
            __syncthreads();
        }
    }
}

__device__ __forceinline__ void ph_rw_prep(const Ctx& C, const bf16_t* Rb, bf16_t* Kb, float* DEC, bf16_t* ASIG, bf16_t* KD, const float* k_k, const float* k_a, const float* r_k, float* BON) {
    const int gw = C.bid * NWAVES + C.wave, NGW = C.G * NWAVES, lane = C.lane;
    for (int r = gw; r < MROWS; r += NGW) {
#pragma unroll
        for (int j = 0; j < 4; ++j) {
            const size_t o4 = (size_t)r * (D / 4) + lane + 64 * j;
            const v2u kw = ((const GAS v2u*)Kb)[o4], rw = ((const GAS v2u*)Rb)[o4];
            const f32x4 kf = (f32x4){bflo(kw.x), bfhi(kw.x), bflo(kw.y), bfhi(kw.y)}, rf = (f32x4){bflo(rw.x), bfhi(rw.x), bflo(rw.y), bfhi(rw.y)};
            const f32x4 kkw = ((const GAS f32x4*)k_k)[lane + 64 * j], kaw = ((const GAS f32x4*)k_a)[lane + 64 * j], rkw = ((const GAS f32x4*)r_k)[lane + 64 * j];
            const f32x4 kk = kf * kkw;
            float ss = (kk.x * kk.x + kk.y * kk.y) + (kk.z * kk.z + kk.w * kk.w);
            ss += __shfl_xor(ss, 1); ss += __shfl_xor(ss, 2); ss += __shfl_xor(ss, 4); ss += __shfl_xor(ss, 8);
            const float inv = 1.0f / fmaxf(sqrtf(ss), 1e-12f);
            const f32x4 kkn = kk * inv;
            { v2u w; w.x = pk2(-kkn.x, -kkn.y); w.y = pk2(-kkn.z, -kkn.w); ((GAS v2u*)Kb)[o4] = w; }
            const int hd = 4 * j + (lane >> 4);
#pragma unroll
            for (int d = 0; d < 2; ++d) {
                const size_t od = (size_t)d * MROWS * (D / 4) + o4;
                const v2u aw = ((const GAS v2u*)ASIG)[od]; const f32x4 af = (f32x4){bflo(aw.x), bfhi(aw.x), bflo(aw.y), bfhi(aw.y)};
                const f32x4 lw = ((const GAS f32x4*)DEC)[od];
                const f32x4 kd = kf * ((af - 1.0f) * kaw + 1.0f), bb = kkn * af;
                float bon = (rf.x * kd.x * rkw.x + rf.y * kd.y * rkw.y) + (rf.z * kd.z * rkw.z + rf.w * kd.w * rkw.w);
                bon += __shfl_xor(bon, 1); bon += __shfl_xor(bon, 2); bon += __shfl_xor(bon, 4); bon += __shfl_xor(bon, 8);
                if ((lane & 15) == 0) BON[((size_t)d * MROWS + r) * RW_H + hd] = bon;
                ((GAS f32x4*)DEC)[od] = (f32x4){__expf(lw.x), __expf(lw.y), __expf(lw.z), __expf(lw.w)};
                { v2u w; w.x = pk2(bb.x, bb.y); w.y = pk2(bb.z, bb.w); ((GAS v2u*)ASIG)[od] = w; }
                { v2u w; w.x = pk2(kd.x, kd.y); w.y = pk2(kd.z, kd.w); ((GAS v2u*)KD)[od] = w; }
            }
        }
    }
}

__device__ __forceinline__ float dpp_rmirror(float v) { return __builtin_bit_cast(float, __builtin_amdgcn_update_dpp(0, __builtin_bit_cast(int, v), 0x140, 0xf, 0xf, false)); }
__device__ __forceinline__ float sum16(float v) { v += dpp_xor1(v); v += dpp_xor2(v); v += dpp_hmirror(v); v += dpp_rmirror(v); return v; }
__device__ __forceinline__ float wave_sum_dpp(float v) {
    v = sum16(v);
    return (__builtin_amdgcn_readlane(__builtin_bit_cast(int, v), 0) , (__builtin_bit_cast(float, __builtin_amdgcn_readlane(__builtin_bit_cast(int, v), 0)) + __builtin_bit_cast(float, __builtin_amdgcn_readlane(__builtin_bit_cast(int, v), 16)))
          + (__builtin_bit_cast(float, __builtin_amdgcn_readlane(__builtin_bit_cast(int, v), 32)) + __builtin_bit_cast(float, __builtin_amdgcn_readlane(__builtin_bit_cast(int, v), 48))));
}
#define SCAN_BAR() do { asm volatile("s_waitcnt lgkmcnt(0)" ::: "memory"); __builtin_amdgcn_s_barrier(); asm volatile("" ::: "memory"); } while (0)
__device__ __forceinline__ void ph_rw_scan_v2(const Ctx& C, const bf16_t* Rb, const bf16_t* Ab, const bf16_t* Vb, const float* Wd, const bf16_t* Bd, const bf16_t* KDd, float* Y) {
    constexpr int T = 32, NCH = NSTEP / T, BUF = 5 * T * 64 + T * 16;
    LAS float* base = (LAS float*)C.lds;
    LAS float* syb = base + 2 * BUF;
    for (int item = C.bid; item < 256; item += C.G) {
        const int chain = item >> 2, rq = item & 3, d = chain >> 5, b = (chain >> 4) & 1, h = chain & 15;
        const bool producer = C.wave >= 4;
        const int vl = (C.tid & 255) >> 4, seg = C.tid & 15;
        const int pw = C.wave - 4, pl2 = (C.lane & 31) * 2, ph = C.lane >> 5;
        float S0 = 0.f, S1 = 0.f, S2 = 0.f, S3 = 0.f;
        f32x2 wx[4]; unsigned ax[4], bx[4], kx[4], rx[4], vx[4];
        auto pload = [&](int cc) {
#pragma unroll
            for (int q = 0; q < 4; ++q) { const int row = rw_step_row(d, b, cc * T + pw * 8 + 2 * q + ph); const size_t o = (size_t)row * D + h * 64 + pl2, od = (size_t)d * MROWS * D + o;
                wx[q] = *(const GAS f32x2*)((const GAS float*)Wd + od); ax[q] = *(const GAS unsigned*)((const GAS bf16_t*)Ab + o); bx[q] = *(const GAS unsigned*)((const GAS bf16_t*)Bd + od);
                kx[q] = *(const GAS unsigned*)((const GAS bf16_t*)KDd + od); rx[q] = *(const GAS unsigned*)((const GAS bf16_t*)Rb + o);
                vx[q] = *(const GAS unsigned*)((const GAS bf16_t*)Vb + (size_t)row * D + h * 64 + rq * 16 + (pl2 & 15)); }
        };
        auto pemit = [&](int cc) {
            LAS float* bw = base + (cc & 1) * BUF; LAS float* ba = bw + T * 64; LAS float* bb = ba + T * 64; LAS float* bk = bb + T * 64; LAS float* br = bk + T * 64; LAS float* bv = br + T * 64;
#pragma unroll
            for (int q = 0; q < 4; ++q) { const int tt = pw * 8 + 2 * q + ph; const int li = tt * 64 + pl2;
                *(LAS f32x2*)(bw + li) = wx[q]; *(LAS f32x2*)(ba + li) = (f32x2){bflo(ax[q]), bfhi(ax[q])}; *(LAS f32x2*)(bb + li) = (f32x2){bflo(bx[q]), bfhi(bx[q])};
                *(LAS f32x2*)(bk + li) = (f32x2){bflo(kx[q]), bfhi(kx[q])}; *(LAS f32x2*)(br + li) = (f32x2){bflo(rx[q]), bfhi(rx[q])};
                if ((C.lane & 31) < 8) *(LAS f32x2*)(bv + tt * 16 + pl2) = (f32x2){bflo(vx[q]), bfhi(vx[q])}; }
        };
        auto flush = [&](int cc) {
            const LAS float* sy = syb + (cc & 1) * T * 16; const int i0 = C.tid - 256;
#pragma unroll
            for (int q = 0; q < 2; ++q) { const int i = i0 + 256 * q, tt = i >> 4, c = i & 15; const int row = rw_step_row(d, b, cc * T + tt); ((GAS float*)Y)[((size_t)d * MROWS + row) * D + h * 64 + rq * 16 + c] = sy[i]; }
        };
        if (producer) { pload(0); pemit(0); pload(1); }
        SCAN_BAR();
        for (int cc = 0; cc < NCH; ++cc) {
            if (producer) { if (cc + 1 < NCH) { pemit(cc + 1); if (cc + 2 < NCH) pload(cc + 2); } if (cc >= 1) flush(cc - 1); }
            else {
                const LAS float* bw = base + (cc & 1) * BUF; const LAS float* ba = bw + T * 64; const LAS float* bb = ba + T * 64; const LAS float* bk = bb + T * 64; const LAS float* br = bk + T * 64; const LAS float* bv = br + T * 64;
                LAS float* sy = syb + (cc & 1) * T * 16;
                f32x4 a4 = *(const LAS f32x4*)(ba + seg * 4), w4 = *(const LAS f32x4*)(bw + seg * 4), b4 = *(const LAS f32x4*)(bb + seg * 4), k4 = *(const LAS f32x4*)(bk + seg * 4), r4 = *(const LAS f32x4*)(br + seg * 4);
                float vv = bv[vl];
#pragma unroll 8
                for (int tt = 0; tt < T; ++tt) {
                    const int tn = (tt + 1 < T) ? tt + 1 : tt;
                    const f32x4 a4n = *(const LAS f32x4*)(ba + tn * 64 + seg * 4), w4n = *(const LAS f32x4*)(bw + tn * 64 + seg * 4), b4n = *(const LAS f32x4*)(bb + tn * 64 + seg * 4), k4n = *(const LAS f32x4*)(bk + tn * 64 + seg * 4), r4n = *(const LAS f32x4*)(br + tn * 64 + seg * 4);
                    const float vvn = bv[tn * 16 + vl];
                    float dot = (S0 * a4.x + S1 * a4.y) + (S2 * a4.z + S3 * a4.w);
                    dot = sum16(dot);
                    S0 = S0 * w4.x + (dot * b4.x + vv * k4.x); S1 = S1 * w4.y + (dot * b4.y + vv * k4.y); S2 = S2 * w4.z + (dot * b4.z + vv * k4.z); S3 = S3 * w4.w + (dot * b4.w + vv * k4.w);
                    float y = (S0 * r4.x + S1 * r4.y) + (S2 * r4.z + S3 * r4.w);
                    y = sum16(y);
                    sy[tt * 16 + vl] = y;
                    a4 = a4n; w4 = w4n; b4 = b4n; k4 = k4n; r4 = r4n; vv = vvn;
                }
            }
            SCAN_BAR();
        }
        if (producer) flush(NCH - 1);
        SCAN_BAR();
    }
}

__device__ __forceinline__ void ph_rw_post(const Ctx& C, const float* Y, const float* BON, const bf16_t* Vb, const bf16_t* Gb, const float* lnw, const float* lnb, bf16_t* YB) {
    const int gw = C.bid * NWAVES + C.wave, NGW = C.G * NWAVES, lane = C.lane;
    for (int r = gw; r < MROWS; r += NGW) {
        const GAS f32x4* y0 = (const GAS f32x4*)(Y + (size_t)r * D) + lane; const GAS f32x4* y1 = (const GAS f32x4*)(Y + ((size_t)MROWS + r) * D) + lane;
#pragma unroll
        for (int j = 0; j < 4; ++j) {
            const f32x4 y = y0[64 * j] + y1[64 * j];
            float s = (y.x + y.y) + (y.z + y.w);
            s += __shfl_xor(s, 1); s += __shfl_xor(s, 2); s += __shfl_xor(s, 4); s += __shfl_xor(s, 8);
            const float mean = s * (1.0f / 64.0f); const f32x4 dd = y - mean;
            float q = (dd.x * dd.x + dd.y * dd.y) + (dd.z * dd.z + dd.w * dd.w);
            q += __shfl_xor(q, 1); q += __shfl_xor(q, 2); q += __shfl_xor(q, 4); q += __shfl_xor(q, 8);
            const float rs = 1.0f / sqrtf(q * (1.0f / 64.0f) + 64e-5f);
            const int hd = 4 * j + (lane >> 4);
            const float bon = BON[(size_t)r * RW_H + hd] + BON[((size_t)MROWS + r) * RW_H + hd];
            const f32x4 lw = ((const GAS f32x4*)lnw + lane)[64 * j], lb = ((const GAS f32x4*)lnb + lane)[64 * j];
            const v2u vv = ((const GAS v2u*)(Vb + (size_t)r * D) + lane)[64 * j], gg = ((const GAS v2u*)(Gb + (size_t)r * D) + lane)[64 * j];
            const f32x4 vf = (f32x4){bflo(vv.x), bfhi(vv.x), bflo(vv.y), bfhi(vv.y)}, gf = (f32x4){bflo(gg.x), bfhi(gg.x), bflo(gg.y), bfhi(gg.y)};
            const f32x4 o = (dd * rs * lw + lb + vf * bon) * gf;
            v2u w; w.x = pk2(o.x, o.y); w.y = pk2(o.z, o.w); ((GAS v2u*)(YB + (size_t)r * D) + lane)[64 * j] = w;
        }
    }
}
__device__ __forceinline__ int slot32(int t) { return ((t & 12) << 1) | ((t >> 4) << 2) | (t & 3); }
constexpr int RC = 32, RNCH = NSTEP / RC;
constexpr int RW_NCHUNKHEAD = 64 * RNCH;
constexpr int RW_NTCH = 16 + 1024;
__device__ __forceinline__ int rwc_rowbase(int d, int b, int c) {
    if (c < 8) return b * CTXL + 32 * (d == 0 ? c : 7 - c);
    const int j = c - 8; return NCTX + b * SEQ + 32 * (d == 0 ? j : 511 - j);
}
__device__ __forceinline__ int rwc_tokchunk(int d, int b, int c) {
    if (c < 8) return b * 8 + (d == 0 ? c : 7 - c);
    const int j = c - 8; return 16 + b * 512 + (d == 0 ? j : 511 - j);
}
__device__ __forceinline__ int kslot64(int k) { return (k & 32) | slot32(k & 31); }

struct RwcImg { bf16_t* WP; bf16_t* RT; bf16_t* TA; bf16_t* ARB; bf16_t* ARK; bf16_t* BT; bf16_t* KT; float* SC; bf16_t* VT; };

template <int DIR>
__device__ __forceinline__ void rwc_prep_one(LAS unsigned char* wl, int lane, int b, int h, int c, const bf16_t* Rb, const bf16_t* Kb, const bf16_t* Vb, const bf16_t* DECb, const bf16_t* ASIGb,
                                             const float* k_k, const float* k_a, const float* r_k, float* BON, const RwcImg& I) {
    constexpr int ZS = 68;
    LAS bf16_t* Zi = (LAS bf16_t*)wl; LAS bf16_t* Wi = Zi + 64 * ZS;
    const int rowbase = rwc_rowbase(DIR, b, c), ci = ((DIR * 2 + b) * 16 + h) * RNCH + c, hk = h * 64 + lane;
    const size_t dofs = (size_t)DIR * MROWS * D;
    const float kkw = k_k[hk], kaw = k_a[hk], rkw = r_k[hk];
    const GAS bf16_t* dp = (const GAS bf16_t*)DECb + dofs + (size_t)rowbase * D; const GAS bf16_t* kp = (const GAS bf16_t*)Kb + (size_t)rowbase * D; const GAS bf16_t* rp = (const GAS bf16_t*)Rb + (size_t)rowbase * D;
    const GAS bf16_t* ap = (const GAS bf16_t*)ASIGb + dofs + (size_t)rowbase * D; const GAS bf16_t* vp_ = (const GAS bf16_t*)Vb + (size_t)rowbase * D;
    GAS float* bonp = (GAS float*)BON + ((size_t)DIR * MROWS + rowbase) * RW_H + h;
    GAS bf16_t* rtp = (GAS bf16_t*)I.RT + (size_t)ci * 2048; GAS bf16_t* wpp = (GAS bf16_t*)I.WP + (size_t)ci * 2048; GAS bf16_t* tap = (GAS bf16_t*)I.TA + (size_t)ci * 1024;
    GAS bf16_t* arbp = (GAS bf16_t*)I.ARB + (size_t)ci * 1024; GAS bf16_t* arkp = (GAS bf16_t*)I.ARK + (size_t)ci * 1024;
    const int ks = kslot64(lane);
    float e1v[32]; float run = 0.f;
#pragma unroll
    for (int t = 0; t < 32; ++t) { run += bf2f(dp[t * D + hk]); e1v[t] = run; }
    const float total = run;
    const float cref = DIR ? (total - e1v[15]) : e1v[15];
    const float cC = total;
    if (DIR) {
#pragma unroll
        for (int t = 31; t >= 1; --t) e1v[t] = __expf(total - e1v[t - 1] - cref);
        e1v[0] = __expf(total - cref);
    } else {
#pragma unroll
        for (int t = 0; t < 32; ++t) e1v[t] = __expf(e1v[t] - cref);
    }
    const float ebound = __expf((DIR ? 0.f : 0.f) - cref);
    float xr[32]; unsigned btp[16], ktp[16];
    float btv = 0.f, ktv = 0.f;
    unsigned kq[16], rq[16], aq[16], kn[16], rn[16], an[16];
#pragma unroll
    for (int j = 0; j < 16; ++j) { kq[j] = kp[j * D + hk]; rq[j] = rp[j * D + hk]; aq[j] = ap[j * D + hk]; }
#pragma unroll
    for (int t = 0; t < 32; ++t) {
        if ((t & 15) == 0) { asm volatile("" ::: "memory");
            if (t + 16 < 32) {
#pragma unroll
                for (int j = 0; j < 16; ++j) { const int tn = (t + 16 + j) & 31; kn[j] = kp[tn * D + hk]; rn[j] = rp[tn * D + hk]; an[j] = ap[tn * D + hk]; } }
            asm volatile("" ::: "memory"); }
        const float kx = bf2f(kq[t & 15]), rx = bf2f(rq[t & 15]), as = bf2f(aq[t & 15]);
        const float kk = kx * kkw; const float kkn = kk * __builtin_amdgcn_rcpf(fmaxf(__builtin_amdgcn_sqrtf(wave_sum_dpp(kk * kk)), 1e-12f));
        const float kd = kx * (1.0f + (as - 1.0f) * kaw);
        const float bon = wave_sum_dpp(rx * kd * rkw);
        if (lane == 0) bonp[t * RW_H] = bon;
        const float e1 = e1v[t], e0 = DIR ? (t < 31 ? e1v[t < 31 ? t + 1 : 31] : ebound) : (t > 0 ? e1v[t > 0 ? t - 1 : 0] : ebound), e2 = __builtin_amdgcn_rcpf(e1);
        const float at = -kkn * e0, rt = rx * e1, bt = kkn * as * e2, kt = kd * e2;
        xr[t] = at;
        const unsigned par = pk2(at, rt), pbk = pk2(bt, kt);
        Zi[t * ZS + lane] = (bf16_t)par; Zi[(32 + t) * ZS + lane] = (bf16_t)(par >> 16); Wi[t * ZS + lane] = (bf16_t)pbk; Wi[(32 + t) * ZS + lane] = (bf16_t)(pbk >> 16);
        rtp[t * 64 + ks] = (bf16_t)(par >> 16);
        if (t & 1) { btp[slot32(t - 1) >> 1] = pk2(btv, bt); ktp[slot32(t - 1) >> 1] = pk2(ktv, kt); } else { btv = bt; ktv = kt; }
        if ((t & 15) == 15) {
#pragma unroll
            for (int j = 0; j < 16; ++j) { kq[j] = kn[j]; rq[j] = rn[j]; aq[j] = an[j]; } }
    }
    {   GAS v4u* pb = (GAS v4u*)((GAS bf16_t*)I.BT + (size_t)ci * 2048); GAS v4u* pk = (GAS v4u*)((GAS bf16_t*)I.KT + (size_t)ci * 2048);
#pragma unroll
        for (int q = 0; q < 4; ++q) { pb[lane * 4 + q] = (v4u){btp[4 * q], btp[4 * q + 1], btp[4 * q + 2], btp[4 * q + 3]}; pk[lane * 4 + q] = (v4u){ktp[4 * q], ktp[4 * q + 1], ktp[4 * q + 2], ktp[4 * q + 3]}; } }
    {   GAS float* sc = (GAS float*)I.SC + (size_t)ci * 192; sc[lane] = __expf(cref); sc[64 + lane] = __expf(cC - cref); sc[128 + lane] = __expf(cC); }
    if (DIR == 0) {
        unsigned vp[16]; unsigned vprev = 0u;
#pragma unroll
        for (int t = 0; t < 32; ++t) { const unsigned vv = vp_[t * D + hk]; if (t & 1) vp[slot32(t - 1) >> 1] = vprev | (vv << 16); else vprev = vv; }
        GAS v4u* pv = (GAS v4u*)((GAS bf16_t*)I.VT + ((size_t)h * RW_NTCH + rwc_tokchunk(0, b, c)) * 2048);
#pragma unroll
        for (int q = 0; q < 4; ++q) pv[lane * 4 + q] = (v4u){vp[4 * q], vp[4 * q + 1], vp[4 * q + 2], vp[4 * q + 3]};
    }
    asm volatile("s_waitcnt lgkmcnt(0)" ::: "memory");
    const int fr = lane & 15, fq = lane >> 4;
    f32x4 acc[4][4];
#pragma unroll
    for (int i = 0; i < 4; ++i)
#pragma unroll
        for (int j = 0; j < 4; ++j) acc[i][j] = (f32x4){0.f, 0.f, 0.f, 0.f};
#pragma unroll
    for (int sg = 0; sg < 2; ++sg) { bf16x8 af[4], bfr[4];
#pragma unroll
        for (int i = 0; i < 4; ++i) { const LAS v2u* pa = (const LAS v2u*)(Zi + (16 * i + fr) * ZS + 32 * sg + 8 * fq); const LAS v2u* pb = (const LAS v2u*)(Wi + (16 * i + fr) * ZS + 32 * sg + 8 * fq);
            const v2u a0 = pa[0], a1 = pa[1], b0 = pb[0], b1 = pb[1]; af[i] = __builtin_bit_cast(bf16x8, (v4u){a0.x, a0.y, a1.x, a1.y}); bfr[i] = __builtin_bit_cast(bf16x8, (v4u){b0.x, b0.y, b1.x, b1.y}); }
#pragma unroll
        for (int i = 0; i < 4; ++i)
#pragma unroll
            for (int j = 0; j < 4; ++j) acc[i][j] = __builtin_amdgcn_mfma_f32_16x16x32_bf16(af[i], bfr[j], acc[i][j], 0, 0, 0); }
    asm volatile("s_waitcnt lgkmcnt(0)" ::: "memory");
    LAS float* Aab = (LAS float*)wl; LAS float* Aak = Aab + 32 * 33;
    const int gcol0 = 4 * fq * 32 + slot32(fr), gcol1 = 4 * fq * 32 + slot32(16 + fr);
#pragma unroll
    for (int i = 0; i < 4; ++i)
#pragma unroll
        for (int j = 0; j < 4; ++j)
#pragma unroll
            for (int r = 0; r < 4; ++r) { const int tt = 16 * (i & 1) + 4 * fq + r, ts = 16 * (j & 1) + fr;
                const bool keep = (i < 2) ? (DIR ? ts > tt : ts < tt) : (DIR ? ts >= tt : ts <= tt);
                const float v = keep ? acc[i][j][r] : 0.f;
                if (i < 2) { if (j < 2) Aab[tt * 33 + ts] = v; else Aak[tt * 33 + ts] = v; }
                else { GAS bf16_t* dst = (j < 2) ? arbp : arkp; dst[(16 * (i & 1) + r) * 32 + ((j & 1) ? gcol1 : gcol0)] = (bf16_t)pk2(v, v); } }
    asm volatile("s_waitcnt lgkmcnt(0)" ::: "memory");
    LAS float* X1 = Aak + 32 * 33;
#pragma unroll
    for (int t = 0; t < 32; ++t) X1[t * 64 + lane] = xr[t];
    asm volatile("s_waitcnt lgkmcnt(0)" ::: "memory");
    const int l31 = lane & 31;
#ifdef RWC_NO_T
    for (int st = 1; st < 0; ++st) { const int tt = 0;
#else
#pragma unroll 1
    for (int st = 1; st < 32; ++st) { const int tt = DIR ? 31 - st : st;
#endif
        float s1a = X1[tt * 64 + lane], s2a = Aak[tt * 33 + l31], s1b = 0.f, s2b = 0.f;
        const LAS float* arow = Aab + tt * 33;
        const int nb = (st + 7) >> 3;
#pragma unroll 1
        for (int bq = 0; bq < nb; ++bq) { const int s0 = bq * 8;
            float av[8], x1v[8], x2v[8];
#pragma unroll
            for (int j = 0; j < 8; ++j) { const int ti = DIR ? 31 - (s0 + j) : s0 + j; av[j] = arow[ti]; x1v[j] = X1[ti * 64 + lane]; x2v[j] = Aak[ti * 33 + l31]; }
#pragma unroll
            for (int j = 0; j < 8; j += 2) { s1a += av[j] * x1v[j]; s2a += av[j] * x2v[j]; s1b += av[j + 1] * x1v[j + 1]; s2b += av[j + 1] * x2v[j + 1]; } }
        asm volatile("s_waitcnt lgkmcnt(0)" ::: "memory");
        X1[tt * 64 + lane] = s1a + s1b; if (lane < 32) Aak[tt * 33 + l31] = s2a + s2b;
        asm volatile("s_waitcnt lgkmcnt(0)" ::: "memory"); }
    const int ts32 = slot32(l31);
#pragma unroll 4
    for (int t = 0; t < 32; ++t) { const unsigned pw = pk2(X1[t * 64 + lane], Aak[t * 33 + l31]); wpp[t * 64 + ks] = (bf16_t)pw; if (lane < 32) tap[t * 32 + ts32] = (bf16_t)(pw >> 16); }
    asm volatile("s_waitcnt lgkmcnt(0)" ::: "memory");
}

__device__ __forceinline__ void ph_rwc_prep(const Ctx& C, const bf16_t* Rb, const bf16_t* Kb, const bf16_t* Vb, const bf16_t* DECb, const bf16_t* ASIGb, const float* k_k, const float* k_a, const float* r_k, float* BON, const RwcImg& I) {
    LAS unsigned char* wl = C.lds + C.wave * 17408;
    const int gw = C.bid * NWAVES + C.wave, NGW = C.G * NWAVES;
    for (int it = gw; it < RW_NCHUNKHEAD; it += NGW) {
        const int c = it % RNCH, ch = it / RNCH, h = ch & 15, b = (ch >> 4) & 1, d = ch >> 5;
        if (d == 0) rwc_prep_one<0>(wl, C.lane, b, h, c, Rb, Kb, Vb, DECb, ASIGb, k_k, k_a, r_k, BON, I);
        else rwc_prep_one<1>(wl, C.lane, b, h, c, Rb, Kb, Vb, DECb, ASIGb, k_k, k_a, r_k, BON, I);
    }
}

__device__ __forceinline__ void ph_rwc_scan(const Ctx& C, const RwcImg& I, float* Y) {
    constexpr int S64 = 72, S32 = 40;
    constexpr int O_WP = 0, O_RT = O_WP + 32 * S64, O_BT = O_RT + 32 * S64, O_KT = O_BT + 64 * S32, O_TA = O_KT + 64 * S32, O_ARB = O_TA + 32 * S32, O_ARK = O_ARB + 32 * S32, O_VT = O_ARK + 32 * S32, O_END = O_VT + 32 * S32;
    constexpr int BUFB = O_END * 2 + 768;
    LAS v4u* SF = (LAS v4u*)(C.lds + 3 * BUFB);
    LAS v4u* UF = SF + 2 * 2 * 2 * 64;
    LAS float* ystage = (LAS float*)(UF + 2 * 2 * 64);
    const int tid = C.tid, lane = C.lane, wave = C.wave, fr = lane & 15, fq = lane >> 4;
    for (int item = C.bid; item < 128; item += C.G) {
        const int chain = item >> 1, vh = item & 1, d = chain >> 5, b = (chain >> 4) & 1, h = chain & 15;
        const size_t ci0 = (size_t)chain * RNCH;
        f32x4 ST[4];
#pragma unroll
        for (int i = 0; i < 4; ++i) ST[i] = (f32x4){0.f, 0.f, 0.f, 0.f};
        const int lt = tid & 255, yw = wave & 1;
        const bool is_state = wave < 2, is_y = (wave == 2 || wave == 3), is_ld = wave >= 4;
        v4u gA[7], gB[7], gC[7], gD[7], gE[7], gF[7];
#define RWC_LOAD(cc, g) do { const size_t ci = ci0 + (cc); const int tc = rwc_tokchunk(d, b, (cc)); const int l7 = lt & 127; \
            g[0] = ((const GAS v4u*)((const GAS bf16_t*)I.WP + ci * 2048))[lt]; g[1] = ((const GAS v4u*)((const GAS bf16_t*)I.RT + ci * 2048))[lt]; g[2] = ((const GAS v4u*)((const GAS bf16_t*)I.BT + ci * 2048))[lt]; g[3] = ((const GAS v4u*)((const GAS bf16_t*)I.KT + ci * 2048))[lt]; \
            g[4] = ((const GAS v4u*)((size_t)(lt < 128) * (size_t)((const GAS bf16_t*)I.VT + ((size_t)h * RW_NTCH + tc) * 2048 + vh * 1024) + (size_t)(lt >= 128) * (size_t)((const GAS bf16_t*)I.TA + ci * 1024)))[l7]; \
            g[5] = ((const GAS v4u*)((const GAS bf16_t*)((size_t)(lt < 128) * (size_t)I.ARB + (size_t)(lt >= 128) * (size_t)I.ARK) + ci * 1024))[l7]; \
            g[6] = ((const GAS v4u*)((const GAS float*)I.SC + ci * 192))[lt < 48 ? lt : 0]; } while (0)
#define RWC_STORE(boff, g) do { LAS bf16_t* B = (LAS bf16_t*)(C.lds + (boff)); const int r8 = lt >> 3, c8 = (lt & 7) * 8, r4 = lt >> 2, c4 = (lt & 3) * 8, r4b = (lt & 127) >> 2; \
            *(LAS v4u*)(B + O_WP + r8 * S64 + c8) = g[0]; *(LAS v4u*)(B + O_RT + r8 * S64 + c8) = g[1]; *(LAS v4u*)(B + O_BT + r4 * S32 + c4) = g[2]; *(LAS v4u*)(B + O_KT + r4 * S32 + c4) = g[3]; \
            *(LAS v4u*)(B + (lt < 128 ? O_VT : O_TA) + r4b * S32 + c4) = g[4]; *(LAS v4u*)(B + (lt < 128 ? O_ARB : O_ARK) + r4b * S32 + c4) = g[5]; \
            if (lt < 48) *(LAS v4u*)((LAS float*)(B + O_END) + lt * 4) = g[6]; } while (0)
        auto slice = [&](int cc, int boff) {
            const LAS bf16_t* B = (const LAS bf16_t*)(C.lds + boff); const LAS float* sc = (const LAS float*)(B + O_END);
            f32x4 ec[2][2], e2[4], pc[4]; bf16x8 fW[2][2], fT[2], fB[4], fK[4];
#pragma unroll
            for (int sg = 0; sg < 2; ++sg) { ec[sg][0] = *(const LAS f32x4*)(sc + 32 * sg + 4 * fq); ec[sg][1] = *(const LAS f32x4*)(sc + 32 * sg + 16 + 4 * fq); }
            const bf16x8 vfrag = *(const LAS bf16x8*)(B + O_VT + (16 * wave + fr) * S32 + 8 * fq);
#pragma unroll
            for (int ti = 0; ti < 2; ++ti) { fW[ti][0] = *(const LAS bf16x8*)(B + O_WP + (16 * ti + fr) * S64 + 8 * fq); fW[ti][1] = *(const LAS bf16x8*)(B + O_WP + (16 * ti + fr) * S64 + 32 + 8 * fq); fT[ti] = *(const LAS bf16x8*)(B + O_TA + (16 * ti + fr) * S32 + 8 * fq); }
#pragma unroll
            for (int i = 0; i < 4; ++i) { fB[i] = *(const LAS bf16x8*)(B + O_BT + (16 * i + fr) * S32 + 8 * fq); fK[i] = *(const LAS bf16x8*)(B + O_KT + (16 * i + fr) * S32 + 8 * fq);
                e2[i] = *(const LAS f32x4*)(sc + 64 + 16 * i + 4 * fq); pc[i] = *(const LAS f32x4*)(sc + 128 + 16 * i + 4 * fq); }
            __builtin_amdgcn_sched_barrier(0);
            bf16x8 sfrag[2];
#pragma unroll
            for (int sg = 0; sg < 2; ++sg) { const f32x4 s0 = ST[2 * sg] * ec[sg][0], s1 = ST[2 * sg + 1] * ec[sg][1];
                v4u w; w.x = pk2(s0[0], s0[1]); w.y = pk2(s0[2], s0[3]); w.z = pk2(s1[0], s1[1]); w.w = pk2(s1[2], s1[3]); sfrag[sg] = __builtin_bit_cast(bf16x8, w);
                SF[(((cc & 1) * 2 + wave) * 2 + sg) * 64 + lane] = w; }
            f32x4 U[2];
#pragma unroll
            for (int ti = 0; ti < 2; ++ti) { f32x4 u = (f32x4){0.f, 0.f, 0.f, 0.f};
                u = __builtin_amdgcn_mfma_f32_16x16x32_bf16(fT[ti], vfrag, u, 0, 0, 0);
                u = __builtin_amdgcn_mfma_f32_16x16x32_bf16(fW[ti][0], sfrag[0], u, 0, 0, 0);
                U[ti] = __builtin_amdgcn_mfma_f32_16x16x32_bf16(fW[ti][1], sfrag[1], u, 0, 0, 0); }
            bf16x8 ufrag; { v4u w; w.x = pk2(U[0][0], U[0][1]); w.y = pk2(U[0][2], U[0][3]); w.z = pk2(U[1][0], U[1][1]); w.w = pk2(U[1][2], U[1][3]); ufrag = __builtin_bit_cast(bf16x8, w); UF[((cc & 1) * 2 + wave) * 64 + lane] = w; }
#pragma unroll
            for (int i = 0; i < 4; ++i) { f32x4 n = (f32x4){0.f, 0.f, 0.f, 0.f};
                n = __builtin_amdgcn_mfma_f32_16x16x32_bf16(fK[i], vfrag, n, 0, 0, 0);
                n = __builtin_amdgcn_mfma_f32_16x16x32_bf16(fB[i], ufrag, n, 0, 0, 0);
                ST[i] = ST[i] * pc[i] + n * e2[i]; }
        };
        auto youts = [&](int cc, int boff) {
            const LAS bf16_t* B = (const LAS bf16_t*)(C.lds + boff);
            const bf16x8 vfrag = *(const LAS bf16x8*)(B + O_VT + (16 * yw + fr) * S32 + 8 * fq);
            const bf16x8 s0 = __builtin_bit_cast(bf16x8, SF[(((cc & 1) * 2 + yw) * 2 + 0) * 64 + lane]), s1 = __builtin_bit_cast(bf16x8, SF[(((cc & 1) * 2 + yw) * 2 + 1) * 64 + lane]);
            const bf16x8 ufrag = __builtin_bit_cast(bf16x8, UF[((cc & 1) * 2 + yw) * 64 + lane]);
            bf16x8 fR[2][2], fRB[2], fRK[2];
#pragma unroll
            for (int ti = 0; ti < 2; ++ti) { fR[ti][0] = *(const LAS bf16x8*)(B + O_RT + (16 * ti + fr) * S64 + 8 * fq); fR[ti][1] = *(const LAS bf16x8*)(B + O_RT + (16 * ti + fr) * S64 + 32 + 8 * fq);
                fRB[ti] = *(const LAS bf16x8*)(B + O_ARB + (16 * ti + fr) * S32 + 8 * fq); fRK[ti] = *(const LAS bf16x8*)(B + O_ARK + (16 * ti + fr) * S32 + 8 * fq); }
            __builtin_amdgcn_sched_barrier(0);
#pragma unroll
            for (int ti = 0; ti < 2; ++ti) { f32x4 y = (f32x4){0.f, 0.f, 0.f, 0.f};
                y = __builtin_amdgcn_mfma_f32_16x16x32_bf16(fRK[ti], vfrag, y, 0, 0, 0);
                y = __builtin_amdgcn_mfma_f32_16x16x32_bf16(fR[ti][0], s0, y, 0, 0, 0);
                y = __builtin_amdgcn_mfma_f32_16x16x32_bf16(fR[ti][1], s1, y, 0, 0, 0);
                y = __builtin_amdgcn_mfma_f32_16x16x32_bf16(fRB[ti], ufrag, y, 0, 0, 0);
#pragma unroll
                for (int r = 0; r < 4; ++r) ystage[(cc & 1) * 1024 + (16 * ti + 4 * fq + r) * 32 + 16 * yw + fr] = y[r]; }
        };
        f32x4 yfA = (f32x4){0.f, 0.f, 0.f, 0.f}, yfB = yfA;
#define RWC_YFLUSH(cc, yf) do { yf = *(const LAS f32x4*)(ystage + ((cc) & 1) * 1024 + (lt >> 3) * 32 + (lt & 7) * 4); \
            *(GAS f32x4*)((GAS float*)Y + ((size_t)d * MROWS + rwc_rowbase(d, b, (cc)) + (lt >> 3)) * D + h * 64 + 32 * vh + (lt & 7) * 4) = yf; } while (0)
        if (is_state) {
            SCAN_BAR();
            int bcur = 0;
#pragma unroll 1
            for (int cc = 0; cc < RNCH; ++cc) { slice(cc, bcur); SCAN_BAR(); bcur = (bcur == 2 * BUFB) ? 0 : bcur + BUFB; }
            SCAN_BAR(); SCAN_BAR();
        } else if (is_y) {
            SCAN_BAR();
            int bprev = 2 * BUFB;
#pragma unroll 1
            for (int cc = 0; cc < RNCH; ++cc) { if (cc >= 1) youts(cc - 1, bprev); SCAN_BAR(); bprev = (bprev == 2 * BUFB) ? 0 : bprev + BUFB; }
            youts(RNCH - 1, bprev); SCAN_BAR(); SCAN_BAR();
        } else {
            RWC_LOAD(0, gA); RWC_STORE(0, gA); RWC_LOAD(1, gB); RWC_LOAD(2, gC); RWC_LOAD(3, gD); RWC_LOAD(4, gE); RWC_LOAD(5, gF); RWC_LOAD(6, gA);
            SCAN_BAR();
            int bnext = BUFB;
#define RWC_LSTEP(cc, g, yf, yfo) do { if ((cc) + 1 < RNCH) { RWC_STORE(bnext, g); if ((cc) + 7 < RNCH) RWC_LOAD((cc) + 7, g); } asm volatile("" :: "v"(yfo)); if ((cc) >= 2) RWC_YFLUSH((cc) - 2, yf); \
                SCAN_BAR(); bnext = (bnext == 2 * BUFB) ? 0 : bnext + BUFB; } while (0)
            static_assert(RNCH % 6 == 4, "loop shape");
#pragma unroll 1
            for (int cc = 0; cc + 5 < RNCH; cc += 6) { RWC_LSTEP(cc, gB, yfA, yfB); RWC_LSTEP(cc + 1, gC, yfB, yfA); RWC_LSTEP(cc + 2, gD, yfA, yfB); RWC_LSTEP(cc + 3, gE, yfB, yfA); RWC_LSTEP(cc + 4, gF, yfA, yfB); RWC_LSTEP(cc + 5, gA, yfB, yfA); }
            RWC_LSTEP(RNCH - 4, gB, yfA, yfB); RWC_LSTEP(RNCH - 3, gC, yfB, yfA); RWC_LSTEP(RNCH - 2, gD, yfA, yfB); RWC_LSTEP(RNCH - 1, gE, yfB, yfA);
#undef RWC_LSTEP
            RWC_YFLUSH(RNCH - 2, yfA); SCAN_BAR();
            RWC_YFLUSH(RNCH - 1, yfB); SCAN_BAR();
        }
#undef RWC_YFLUSH
#undef RWC_LOAD
#undef RWC_STORE
    }
}
constexpr int HG_H = 8, HG_DK = 128;
__device__ __forceinline__ void ph_hg_lb(const Ctx& C, const float* hg_lb, int layer, float* LB) {
    for (int i = C.bid * NTHR + C.tid; i < 2 * D; i += C.G * NTHR) {
        float x[DEPTH], mx = -3.0e38f;
#pragma unroll
        for (int l = 0; l < DEPTH; ++l) { x[l] = hg_lb[(size_t)l * 2 * D + i]; mx = fmaxf(mx, x[l]); }
        float den = 0.f, num = 0.f;
#pragma unroll
        for (int l = 0; l < DEPTH; ++l) { const float e = __expf(x[l] - mx); den += e; if (l >= 1 && l <= layer) num += e; }
        LB[i] = num / den;
    }
}
struct EpiHg {
    static constexpr bool PERM = false;
    bf16_t* QVG; float* FG; const float* LB;
    __device__ __forceinline__ void operator()(const AccT& acc, const Unit& u, int wr, int wc, int fr, int fq) const {
        const int row0 = u.pm * 256 + wr * 64 + fr, grp = u.pn >> 2, colt = (u.pn & 3) * 256 + wc * 32 + 4 * fq;
        const int isf = (grp == 1 || grp == 2) ? 1 : 0, d = grp == 2 ? 1 : 0, bsel = grp == 0 ? 0 : (grp == 3 ? 1 : 2), act = grp != 3;
#pragma unroll
        for (int ai = 0; ai < 2; ++ai)
#pragma unroll
            for (int m = 0; m < 4; ++m) { const size_t row = (size_t)(row0 + ai * 128 + m * 16);
#pragma unroll
                for (int bj = 0; bj < 2; ++bj)
#pragma unroll
                    for (int n = 0; n < 2; ++n) { const int col = colt + bj * 128 + n * 16; const f32x4 x = acc[ai][bj][m][n];
                        if (isf) { const f32x4 lb = *(const GAS f32x4*)((const GAS float*)LB + d * D + col); f32x4 o;
#pragma unroll
                            for (int j = 0; j < 4; ++j) o[j] = lb[j] + (1.0f - lb[j]) * sigmoidf_(x[j]);
                            *(GAS f32x4*)((GAS float*)FG + ((size_t)d * MROWS + row) * D + col) = o; }
                        else { v2u w; if (act) { w.x = pk2(siluf_(x[0]), siluf_(x[1])); w.y = pk2(siluf_(x[2]), siluf_(x[3])); } else { w.x = pk2(x[0], x[1]); w.y = pk2(x[2], x[3]); }
                            *(GAS v2u*)((GAS bf16_t*)QVG + ((size_t)bsel * MROWS + row) * D + col) = w; } }
                asm volatile("" ::: "memory"); }
    }
};
__device__ __forceinline__ void ph_hg_scan_seq(const Ctx& C, const bf16_t* QVG, const float* FG, float* O) {
    constexpr int T = 32;
    LAS float* sf = (LAS float*)C.lds;
    LAS float* sk = sf + T * 128; LAS float* sq = sk + T * 128; LAS float* sv = sq + T * 128; LAS float* so = sv + T * 64;
    const bf16_t* Qb = QVG; const bf16_t* Vb = QVG + (size_t)MROWS * D;
    for (int item = C.bid; item < 64; item += C.G) {
        const int chain = item >> 1, vh = item & 1, d = chain >> 4, b = (chain >> 3) & 1, h = chain & 7;
        const int v = C.tid >> 3, seg = C.tid & 7;
        float S[16];
#pragma unroll
        for (int j = 0; j < 16; ++j) S[j] = 0.f;
        for (int s0 = 0; s0 < NSTEP; s0 += T) {
            for (int i = C.tid; i < T * 128; i += NTHR) { const int tt = i >> 7, c = i & 127; const int row = rw_step_row(d, b, s0 + tt); const size_t o = (size_t)row * D + h * 128 + c;
                const float f = ((const GAS float*)FG)[(size_t)d * MROWS * D + o]; sf[i] = f; sk[i] = 1.0f - f; sq[i] = bf2f(((const GAS bf16_t*)Qb)[o]);
                if ((c >> 6) == vh) sv[tt * 64 + (c & 63)] = bf2f(((const GAS bf16_t*)Vb)[o]); }
            __syncthreads();
#pragma unroll 2
            for (int tt = 0; tt < T; ++tt) {
                const LAS f32x4* pf = (const LAS f32x4*)(sf + tt * 128 + seg * 16); const LAS f32x4* pk = (const LAS f32x4*)(sk + tt * 128 + seg * 16); const LAS f32x4* pq = (const LAS f32x4*)(sq + tt * 128 + seg * 16);
                const float vv = sv[tt * 64 + v]; float y = 0.f;
#pragma unroll
                for (int jj = 0; jj < 4; ++jj) { const f32x4 f = pf[jj], k = pk[jj], q = pq[jj];
#pragma unroll
                    for (int i = 0; i < 4; ++i) { S[4 * jj + i] = S[4 * jj + i] * f[i] + k[i] * vv; y += S[4 * jj + i] * q[i]; } }
                y = sum8(y);
                if (seg == 0) so[tt * 64 + v] = y;
            }
            __syncthreads();
            for (int i = C.tid; i < T * 64; i += NTHR) { const int tt = i >> 6, c = i & 63; const int row = rw_step_row(d, b, s0 + tt); ((GAS float*)O)[((size_t)d * MROWS + row) * D + h * 128 + vh * 64 + c] = so[i]; }
            __syncthreads();
        }
    }
}
__device__ __forceinline__ void ph_hg_scan_v2(const Ctx& C, const bf16_t* QVG, const float* FG, float* O) {
    constexpr int T = 32, NCH = NSTEP / T, BUF = 2 * T * 128 + T * 16;
    LAS float* base = (LAS float*)C.lds;
    LAS float* syb = base + 2 * BUF;
    const bf16_t* Qb = QVG; const bf16_t* Vb = QVG + (size_t)MROWS * D;
    for (int item = C.bid; item < 256; item += C.G) {
        const int chain = item >> 3, ve = item & 7, d = chain >> 4, b = (chain >> 3) & 1, h = chain & 7;
        const bool producer = C.wave >= 4;
        const int vl = (C.tid & 255) >> 4, seg = C.tid & 15, pw = C.wave - 4;
        float S[8];
#pragma unroll
        for (int j = 0; j < 8; ++j) S[j] = 0.f;
        float f0[8], f1[8]; unsigned q0[8], q1[8], vx[8];
        auto pload = [&](int cc) {
#pragma unroll
            for (int q = 0; q < 8; ++q) { const int row = rw_step_row(d, b, cc * T + pw * 8 + q); const size_t o = (size_t)row * D + h * 128 + C.lane;
                f0[q] = ((const GAS float*)FG)[(size_t)d * MROWS * D + o]; f1[q] = ((const GAS float*)FG)[(size_t)d * MROWS * D + o + 64];
                q0[q] = ((const GAS bf16_t*)Qb)[o]; q1[q] = ((const GAS bf16_t*)Qb)[o + 64];
                vx[q] = ((const GAS bf16_t*)Vb)[(size_t)row * D + h * 128 + ve * 16 + (C.lane & 15)]; }
        };
        auto pemit = [&](int cc) {
            LAS float* bf = base + (cc & 1) * BUF; LAS float* bq = bf + T * 128; LAS float* bv = bq + T * 128;
#pragma unroll
            for (int q = 0; q < 8; ++q) { const int tt = pw * 8 + q; bf[tt * 128 + C.lane] = f0[q]; bf[tt * 128 + 64 + C.lane] = f1[q]; bq[tt * 128 + C.lane] = bf2f(q0[q]); bq[tt * 128 + 64 + C.lane] = bf2f(q1[q]); if (C.lane < 16) bv[tt * 16 + C.lane] = bf2f(vx[q]); }
        };
        auto flush = [&](int cc) {
            const LAS float* sy = syb + (cc & 1) * T * 16; const int i0 = C.tid - 256;
#pragma unroll
            for (int q = 0; q < 2; ++q) { const int i = i0 + 256 * q, tt = i >> 4, c = i & 15; const int row = rw_step_row(d, b, cc * T + tt); ((GAS float*)O)[((size_t)d * MROWS + row) * D + h * 128 + ve * 16 + c] = sy[i]; }
        };
        if (producer) { pload(0); pemit(0); pload(1); }
        SCAN_BAR();
        for (int cc = 0; cc < NCH; ++cc) {
            if (producer) { if (cc + 1 < NCH) { pemit(cc + 1); if (cc + 2 < NCH) pload(cc + 2); } if (cc >= 1) flush(cc - 1); }
            else {
                const LAS float* bf = base + (cc & 1) * BUF; const LAS float* bq = bf + T * 128; const LAS float* bv = bq + T * 128;
                LAS float* sy = syb + (cc & 1) * T * 16;
                f32x4 fa = *(const LAS f32x4*)(bf + seg * 8), fb = *(const LAS f32x4*)(bf + seg * 8 + 4), qa = *(const LAS f32x4*)(bq + seg * 8), qb = *(const LAS f32x4*)(bq + seg * 8 + 4);
                float vv = bv[vl];
#pragma unroll 8
                for (int tt = 0; tt < T; ++tt) {
                    const int tn = (tt + 1 < T) ? tt + 1 : tt;
                    const f32x4 fan = *(const LAS f32x4*)(bf + tn * 128 + seg * 8), fbn = *(const LAS f32x4*)(bf + tn * 128 + seg * 8 + 4), qan = *(const LAS f32x4*)(bq + tn * 128 + seg * 8), qbn = *(const LAS f32x4*)(bq + tn * 128 + seg * 8 + 4);
                    const float vvn = bv[tn * 16 + vl];
#pragma unroll
                    for (int i = 0; i < 4; ++i) { S[i] = S[i] * fa[i] + (1.0f - fa[i]) * vv; S[4 + i] = S[4 + i] * fb[i] + (1.0f - fb[i]) * vv; }
                    float y = ((S[0] * qa.x + S[1] * qa.y) + (S[2] * qa.z + S[3] * qa.w)) + ((S[4] * qb.x + S[5] * qb.y) + (S[6] * qb.z + S[7] * qb.w));
                    y = sum16(y);
                    sy[tt * 16 + vl] = y;
                    fa = fan; fb = fbn; qa = qan; qb = qbn; vv = vvn;
                }
            }
            SCAN_BAR();
        }
        if (producer) flush(NCH - 1);
        SCAN_BAR();
    }
}
__device__ __forceinline__ void ph_hg_scan_chunk(const Ctx& C, const bf16_t* QVG, const float* FG, float* O, const int only_d0 = 0) {
    constexpr int CH = 32, NCH = NSTEP / CH, RS = 136, TS = 40;
    constexpr int IMG = 3 * CH * RS + 128 * TS + 64 * TS;
    constexpr int SETB = IMG * 2 + 2048 + 512;
    LAS float* gt = (LAS float*)(C.lds + 2 * SETB);
    LAS float* ostage = gt + 8 * 128;
    const bf16_t* Qb = QVG; const bf16_t* Vb = QVG + (size_t)MROWS * D;
    const int tid = C.tid, lane = C.lane, wave = C.wave, fr = lane & 15, fq = lane >> 4;
    for (int item = C.bid; item < 64; item += C.G) {
        const int chain = item >> 1, vh = item & 1, d = chain >> 4, b = (chain >> 3) & 1, h = chain & 7;
        if (only_d0 && d != 0) continue;
        const int kp = tid & 63, k0 = 2 * kp, ptg = tid >> 6;
        const int pv = tid & 31, pvg = tid >> 5;
        f32x4 ST[8];
#pragma unroll
        for (int i = 0; i < 8; ++i) ST[i] = (f32x4){0.f, 0.f, 0.f, 0.f};
        f32x2 fxA[4], fxB[4]; unsigned qxA[4], qxB[4]; unsigned vxA[2], vxB[2];
#define HG_PLOAD(cc, fx, qx, vx) do { _Pragma("unroll") for (int i = 0; i < 4; ++i) { const int row = rw_step_row(d, b, (cc) * CH + ptg * 4 + i); const size_t o = (size_t)row * D + h * 128; \
            fx[i] = *(const GAS f32x2*)((const GAS float*)FG + (size_t)d * MROWS * D + o + k0); qx[i] = *(const GAS unsigned*)((const GAS bf16_t*)Qb + o + k0); } \
            _Pragma("unroll") for (int i = 0; i < 2; ++i) { const int row = rw_step_row(d, b, (cc) * CH + pvg * 2 + i); vx[i] = *(const GAS unsigned*)((const GAS bf16_t*)Vb + (size_t)row * D + h * 128 + vh * 64 + 2 * pv); } } while (0)
#define HG_PREP(cc, fx, qx, vx) do { \
            LAS bf16_t* QH = (LAS bf16_t*)(C.lds + ((cc) & 1) * SETB); LAS bf16_t* QT = QH + CH * RS; LAS bf16_t* KN = QT + CH * RS; LAS bf16_t* KT = KN + CH * RS; LAS bf16_t* VT = KT + 128 * TS; LAS float* ac = (LAS float*)(VT + 64 * TS) + 512; \
            f32x2 g[4], cs = (f32x2){0.f, 0.f}; \
            _Pragma("unroll") for (int i = 0; i < 4; ++i) { cs.x += __logf(fx[i].x); cs.y += __logf(fx[i].y); g[i] = cs; } \
            *(LAS f32x2*)(gt + ptg * 128 + k0) = cs; \
            { *(LAS unsigned*)(VT + (2 * pv) * TS + slot32(pvg * 2)) = (vx[0] & 0xffffu) | (vx[1] << 16); *(LAS unsigned*)(VT + (2 * pv + 1) * TS + slot32(pvg * 2)) = (vx[0] >> 16) | (vx[1] & 0xffff0000u); } \
            SCAN_BAR(); \
            { f32x2 off = (f32x2){0.f, 0.f}, gref = off, gc = off; \
              _Pragma("unroll") for (int q = 0; q < 8; ++q) { const f32x2 t = *(const LAS f32x2*)(gt + q * 128 + k0); if (q < ptg) off += t; if (q < 4) gref += t; gc += t; } \
              const f32x2 egref = (f32x2){__expf(gref.x), __expf(gref.y)}, egc = (f32x2){__expf(gc.x - gref.x), __expf(gc.y - gref.y)}; unsigned kt0[2], kt1[2]; float ka[4], kb[4]; \
              const int qhp = (k0 & ~31) + slot32(k0 & 31); \
              _Pragma("unroll") for (int i = 0; i < 4; ++i) { const int t = ptg * 4 + i; const f32x2 G = off + g[i]; \
                  const float e1x = __expf(G.x - gref.x), e1y = __expf(G.y - gref.y), e2x = __builtin_amdgcn_rcpf(e1x), e2y = __builtin_amdgcn_rcpf(e1y); \
                  const float qx_ = bflo(qx[i]), qy_ = bfhi(qx[i]), kx_ = 1.0f - fx[i].x, ky_ = 1.0f - fx[i].y; \
                  *(LAS unsigned*)(QT + t * RS + k0) = pk2(qx_ * e1x, qy_ * e1y); *(LAS unsigned*)(QH + t * RS + qhp) = pk2(qx_ * e1x * egref.x, qy_ * e1y * egref.y); *(LAS unsigned*)(KN + t * RS + k0) = pk2(kx_ * e2x, ky_ * e2y); \
                  ka[i] = kx_ * e2x * egc.x; kb[i] = ky_ * e2y * egc.y; } \
              { v2u w; w.x = pk2(ka[0], ka[1]); w.y = pk2(ka[2], ka[3]); *(LAS v2u*)(KT + k0 * TS + slot32(ptg * 4)) = w; w.x = pk2(kb[0], kb[1]); w.y = pk2(kb[2], kb[3]); *(LAS v2u*)(KT + (k0 + 1) * TS + slot32(ptg * 4)) = w; } \
              if (ptg == 7) { *(LAS f32x2*)(ac + k0) = egref * egc; } } \
            SCAN_BAR(); } while (0)
        HG_PLOAD(0, fxA, qxA, vxA); HG_PLOAD(1, fxB, qxB, vxB);
        HG_PREP(0, fxA, qxA, vxA); HG_PLOAD(2, fxA, qxA, vxA);
        auto helper = [&](int cc) {
            const LAS bf16_t* QH = (const LAS bf16_t*)(C.lds + (cc & 1) * SETB); const LAS bf16_t* QT = QH + CH * RS; const LAS bf16_t* KN = QT + CH * RS; LAS v4u* PF = (LAS v4u*)(KN + CH * RS + 128 * TS + 64 * TS);
            const int ti = wave - 4;
            f32x4 p0 = (f32x4){0.f, 0.f, 0.f, 0.f}, p1 = p0;
#pragma unroll
            for (int sg = 0; sg < 4; ++sg) { const bf16x8 bq = *(const LAS bf16x8*)(QT + (16 * ti + fr) * RS + 32 * sg + 8 * fq);
                const bf16x8 a0 = *(const LAS bf16x8*)(KN + fr * RS + 32 * sg + 8 * fq); p0 = __builtin_amdgcn_mfma_f32_16x16x32_bf16(a0, bq, p0, 0, 0, 0);
                if (ti == 1) { const bf16x8 a1 = *(const LAS bf16x8*)(KN + (16 + fr) * RS + 32 * sg + 8 * fq); p1 = __builtin_amdgcn_mfma_f32_16x16x32_bf16(a1, bq, p1, 0, 0, 0); } }
            v4u w; float m[4];
            if (ti == 0) {
#pragma unroll
                for (int r = 0; r < 4; ++r) m[r] = (4 * fq + r <= fr) ? p0[r] : 0.f;
                w.x = pk2(m[0], m[1]); w.y = pk2(m[2], m[3]); w.z = 0u; w.w = 0u; }
            else {
#pragma unroll
                for (int r = 0; r < 4; ++r) m[r] = (4 * fq + r <= fr) ? p1[r] : 0.f;
                w.x = pk2(p0[0], p0[1]); w.y = pk2(p0[2], p0[3]); w.z = pk2(m[0], m[1]); w.w = pk2(m[2], m[3]); }
            PF[ti * 64 + lane] = w;
        };
        auto slice = [&](int cc) {
            const LAS bf16_t* QH = (const LAS bf16_t*)(C.lds + (cc & 1) * SETB); const LAS bf16_t* KT = QH + 3 * CH * RS; const LAS bf16_t* VT = KT + 128 * TS; const LAS v4u* PF = (const LAS v4u*)(VT + 64 * TS); const LAS float* ac = (const LAS float*)PF + 512;
            const bf16x8 vfrag = *(const LAS bf16x8*)(VT + (16 * wave + fr) * TS + 8 * fq);
            bf16x8 sfrag[4];
#pragma unroll
            for (int sg = 0; sg < 4; ++sg) { v4u w; w.x = pk2(ST[2 * sg][0], ST[2 * sg][1]); w.y = pk2(ST[2 * sg][2], ST[2 * sg][3]); w.z = pk2(ST[2 * sg + 1][0], ST[2 * sg + 1][1]); w.w = pk2(ST[2 * sg + 1][2], ST[2 * sg + 1][3]); sfrag[sg] = __builtin_bit_cast(bf16x8, w); }
#pragma unroll
            for (int ti = 0; ti < 2; ++ti) { f32x4 o = (f32x4){0.f, 0.f, 0.f, 0.f};
#pragma unroll
                for (int sg = 0; sg < 4; ++sg) { const bf16x8 a = *(const LAS bf16x8*)(QH + (16 * ti + fr) * RS + 32 * sg + 8 * fq); o = __builtin_amdgcn_mfma_f32_16x16x32_bf16(a, sfrag[sg], o, 0, 0, 0); }
                const bf16x8 pa = __builtin_bit_cast(bf16x8, PF[ti * 64 + lane]);
                o = __builtin_amdgcn_mfma_f32_16x16x32_bf16(pa, vfrag, o, 0, 0, 0);
#pragma unroll
                for (int r = 0; r < 4; ++r) ostage[(cc & 1) * 2048 + (16 * ti + 4 * fq + r) * 64 + 16 * wave + fr] = o[r]; }
#pragma unroll
            for (int i = 0; i < 8; ++i) { const f32x4 av = *(const LAS f32x4*)(ac + 16 * i + 4 * fq); const bf16x8 a = *(const LAS bf16x8*)(KT + (16 * i + fr) * TS + 8 * fq);
                ST[i] = __builtin_amdgcn_mfma_f32_16x16x32_bf16(a, vfrag, ST[i] * av, 0, 0, 0); }
        };
        auto oflush = [&](int cc) {
            const int ft = tid - 384;
#pragma unroll
            for (int q = 0; q < 4; ++q) { const int idx = ft + 128 * q, t = idx >> 4, c4 = idx & 15; const int row = rw_step_row(d, b, cc * CH + t);
                *(GAS f32x4*)((GAS float*)O + ((size_t)d * MROWS + row) * D + h * 128 + vh * 64 + 4 * c4) = *(const LAS f32x4*)(ostage + (cc & 1) * 2048 + t * 64 + 4 * c4); }
        };
        if (wave == 4 || wave == 5) helper(0);
        SCAN_BAR();
        for (int cc = 0; cc < NCH; cc += 2) {
            if (cc + 1 < NCH) { HG_PREP(cc + 1, fxB, qxB, vxB); if (cc + 3 < NCH) HG_PLOAD(cc + 3, fxB, qxB, vxB); }
            if (wave < 4) slice(cc); else if ((wave == 4 || wave == 5) && cc + 1 < NCH) helper(cc + 1); else if (wave >= 6 && cc >= 1) oflush(cc - 1);
            SCAN_BAR();
            if (cc + 1 < NCH) {
                if (cc + 2 < NCH) { HG_PREP(cc + 2, fxA, qxA, vxA); if (cc + 4 < NCH) HG_PLOAD(cc + 4, fxA, qxA, vxA); }
                if (wave < 4) slice(cc + 1); else if ((wave == 4 || wave == 5) && cc + 2 < NCH) helper(cc + 2); else if (wave >= 6) oflush(cc);
                SCAN_BAR();
            }
        }
        if (wave >= 6) oflush(NCH - 1);
        SCAN_BAR();
#undef HG_PLOAD
#undef HG_PREP
    }
}
__device__ __forceinline__ void ph_hg_post(const Ctx& C, const float* O, const bf16_t* GS, const float* gn, bf16_t* YB) {
    const int gw = C.bid * NWAVES + C.wave, NGW = C.G * NWAVES, lane = C.lane;
    for (int r = gw; r < MROWS; r += NGW) {
        const GAS f32x4* o0 = (const GAS f32x4*)(O + (size_t)r * D) + lane; const GAS f32x4* o1 = (const GAS f32x4*)(O + ((size_t)MROWS + r) * D) + lane;
#pragma unroll
        for (int j = 0; j < 4; ++j) {
            const f32x4 y = o0[64 * j] + o1[64 * j];
            float q = (y.x * y.x + y.y * y.y) + (y.z * y.z + y.w * y.w);
            q += __shfl_xor(q, 1); q += __shfl_xor(q, 2); q += __shfl_xor(q, 4); q += __shfl_xor(q, 8); q += __shfl_xor(q, 16);
            const float rs = 1.0f / sqrtf(q * (1.0f / 128.0f) + NORM_EPS);
            const f32x4 gw4 = ((const GAS f32x4*)gn)[(lane & 31)];
            const v2u gg = ((const GAS v2u*)(GS + (size_t)r * D) + lane)[64 * j];
            const f32x4 gf = (f32x4){bflo(gg.x), bfhi(gg.x), bflo(gg.y), bfhi(gg.y)};
            const f32x4 o = y * rs * gw4 * gf;
            v2u w; w.x = pk2(o.x, o.y); w.y = pk2(o.z, o.w); ((GAS v2u*)(YB + (size_t)r * D) + lane)[64 * j] = w;
        }
    }
}

__device__ __forceinline__ void ph_diff(const Ctx& C, const float* A, const float* B, size_t n, unsigned* res) {
    float md = 0.f, ma = 0.f;
    for (size_t i = (size_t)C.bid * NTHR + C.tid; i < n; i += (size_t)C.G * NTHR) { const float a = A[i], b = B[i]; md = fmaxf(md, fabsf(a - b)); ma = fmaxf(ma, fabsf(a)); }
#pragma unroll
    for (int o = 1; o < 64; o <<= 1) { md = fmaxf(md, __shfl_xor(md, o)); ma = fmaxf(ma, __shfl_xor(ma, o)); }
    if (C.lane == 0) { atomicMax(res, __builtin_bit_cast(unsigned, md)); atomicMax(res + 1, __builtin_bit_cast(unsigned, ma)); }
}
constexpr int HGC_NITEM = 32 * RNCH;
struct HgImg { bf16_t* QT; v4u* PF; bf16_t* KT; float* SC; bf16_t* VT; };
__device__ __forceinline__ int kslot128(int k) { return (k & 96) | slot32(k & 31); }

template <int DIR>
__device__ __forceinline__ void hgc_prep_one(LAS unsigned char* wl, int lane, int b, int h, int c, const bf16_t* Qb, const bf16_t* Vb, const float* FGd, const HgImg& I) {
    constexpr int LS = 136; LAS bf16_t* QL = (LAS bf16_t*)wl; LAS bf16_t* KL = QL + 32 * LS;
    const int rowbase = rwc_rowbase(DIR, b, c), ci = ((DIR * 2 + b) * 8 + h) * RNCH + c, k0 = 2 * lane;
    const GAS float* fp = (const GAS float*)FGd + (size_t)rowbase * D + h * 128 + k0;
    const GAS bf16_t* qp = (const GAS bf16_t*)Qb + (size_t)rowbase * D + h * 128 + k0;
    GAS bf16_t* qtp = (GAS bf16_t*)I.QT + (size_t)ci * 4096 + kslot128(k0);
    f32x2 fv[32], P[32]; unsigned qv[32];
#pragma unroll
    for (int t = 0; t < 32; ++t) { fv[t] = *(const GAS f32x2*)(fp + t * D); qv[t] = *(const GAS unsigned*)(qp + t * D); }
    f32x2 run = (f32x2){0.f, 0.f};
#pragma unroll
    for (int t = 0; t < 32; ++t) { run.x += __logf(fv[t].x); run.y += __logf(fv[t].y); P[t] = run; }
    const f32x2 total = run, gref = DIR ? (total - P[15]) : P[15];
    unsigned kta[16], ktb[16]; f32x2 kprev = (f32x2){0.f, 0.f};
#pragma unroll
    for (int t = 0; t < 32; ++t) {
        const f32x2 pm1 = t ? P[t ? t - 1 : 0] : (f32x2){0.f, 0.f}; const f32x2 cum = DIR ? (total - pm1) : P[t];
        const float e1x = __expf(cum.x - gref.x), e1y = __expf(cum.y - gref.y), e2x = __builtin_amdgcn_rcpf(e1x), e2y = __builtin_amdgcn_rcpf(e1y);
        const float kx = (1.0f - fv[t].x) * e2x, ky = (1.0f - fv[t].y) * e2y;
        const unsigned qpk = pk2(bflo(qv[t]) * e1x, bfhi(qv[t]) * e1y), kpk = pk2(kx, ky);
        *(GAS unsigned*)(qtp + t * 128) = qpk;
        *(LAS unsigned*)(QL + t * LS + k0) = qpk; *(LAS unsigned*)(KL + t * LS + k0) = kpk;
        if (t & 1) { kta[slot32(t - 1) >> 1] = pk2(kprev.x, kx); ktb[slot32(t - 1) >> 1] = pk2(kprev.y, ky); } else kprev = (f32x2){kx, ky};
    }
    {   GAS v4u* pk = (GAS v4u*)((GAS bf16_t*)I.KT + (size_t)ci * 4096 + (size_t)k0 * 32);
#pragma unroll
        for (int q = 0; q < 4; ++q) { pk[q] = (v4u){kta[4 * q], kta[4 * q + 1], kta[4 * q + 2], kta[4 * q + 3]}; pk[4 + q] = (v4u){ktb[4 * q], ktb[4 * q + 1], ktb[4 * q + 2], ktb[4 * q + 3]}; } }
    {   GAS float* sc = (GAS float*)I.SC + (size_t)ci * 384;
        *(GAS f32x2*)(sc + k0) = (f32x2){__expf(gref.x), __expf(gref.y)}; *(GAS f32x2*)(sc + 128 + k0) = (f32x2){__expf(total.x - gref.x), __expf(total.y - gref.y)}; *(GAS f32x2*)(sc + 256 + k0) = (f32x2){__expf(total.x), __expf(total.y)}; }
    {
        asm volatile("s_waitcnt lgkmcnt(0)" ::: "memory");
        const int fr = lane & 15, fq = lane >> 4;
#pragma unroll
        for (int ti = 0; ti < 2; ++ti) { f32x4 p0 = (f32x4){0.f, 0.f, 0.f, 0.f}, p1 = p0;
#pragma unroll
            for (int sg = 0; sg < 4; ++sg) { const bf16x8 bq = *(const LAS bf16x8*)(QL + (16 * ti + fr) * LS + 32 * sg + 8 * fq);
                p0 = __builtin_amdgcn_mfma_f32_16x16x32_bf16(*(const LAS bf16x8*)(KL + fr * LS + 32 * sg + 8 * fq), bq, p0, 0, 0, 0);
                p1 = __builtin_amdgcn_mfma_f32_16x16x32_bf16(*(const LAS bf16x8*)(KL + (16 + fr) * LS + 32 * sg + 8 * fq), bq, p1, 0, 0, 0); }
            float m0[4], m1[4];
#pragma unroll
            for (int r = 0; r < 4; ++r) { const int ts0 = 4 * fq + r, ts1 = 16 + 4 * fq + r, tt = 16 * ti + fr; m0[r] = (DIR ? ts0 >= tt : ts0 <= tt) ? p0[r] : 0.f; m1[r] = (DIR ? ts1 >= tt : ts1 <= tt) ? p1[r] : 0.f; }
            v4u w; w.x = pk2(m0[0], m0[1]); w.y = pk2(m0[2], m0[3]); w.z = pk2(m1[0], m1[1]); w.w = pk2(m1[2], m1[3]);
            ((GAS v4u*)I.PF)[(size_t)ci * 128 + ti * 64 + lane] = w; }
        asm volatile("s_waitcnt lgkmcnt(0)" ::: "memory");
    }
    if (DIR == 0) {
        const GAS bf16_t* vp = (const GAS bf16_t*)Vb + (size_t)rowbase * D + h * 128 + k0;
        unsigned va[16], vb[16], vprev = 0u;
#pragma unroll
        for (int t = 0; t < 32; ++t) { const unsigned vv = *(const GAS unsigned*)(vp + t * D); if (t & 1) { va[slot32(t - 1) >> 1] = (vprev & 0xffffu) | (vv << 16); vb[slot32(t - 1) >> 1] = (vprev >> 16) | (vv & 0xffff0000u); } else vprev = vv; }
        GAS v4u* pv = (GAS v4u*)((GAS bf16_t*)I.VT + ((size_t)(b * 8 + h) * RNCH + c) * 4096 + (size_t)k0 * 32);
#pragma unroll
        for (int q = 0; q < 4; ++q) { pv[q] = (v4u){va[4 * q], va[4 * q + 1], va[4 * q + 2], va[4 * q + 3]}; pv[4 + q] = (v4u){vb[4 * q], vb[4 * q + 1], vb[4 * q + 2], vb[4 * q + 3]}; }
    }
}
__device__ __forceinline__ int hgc_vtslot(int d, int c) { if (c < 8) return d == 0 ? c : 7 - c; return 8 + (d == 0 ? c - 8 : 511 - (c - 8)); }

__device__ __forceinline__ void ph_hgc_prep(const Ctx& C, const bf16_t* QVG, const float* FG, const HgImg& I) {
    const bf16_t* Qb = QVG; const bf16_t* Vb = QVG + (size_t)MROWS * D;
    const int gw = C.bid * NWAVES + C.wave, NGW = C.G * NWAVES;
    LAS unsigned char* wl = C.lds + C.wave * 17408;
    for (int it = gw; it < HGC_NITEM; it += NGW) {
        const int c = it % RNCH, ch = it / RNCH, h = ch & 7, b = (ch >> 3) & 1, d = ch >> 4;
        if (d == 0) hgc_prep_one<0>(wl, C.lane, b, h, c, Qb, Vb, FG, I);
        else hgc_prep_one<1>(wl, C.lane, b, h, c, Qb, Vb, FG + (size_t)MROWS * D, I);
    }
}

__device__ __forceinline__ void ph_hgc_scan(const Ctx& C, const HgImg& I, float* O) {
    constexpr int RS = 136, TS = 40;
    constexpr int O_QT = 0, O_KT = 32 * RS, O_VT = O_KT + 128 * TS, O_END = O_VT + 64 * TS;
    constexpr int BUFB = O_END * 2 + 1536 + 2048;
    LAS float* ostage = (LAS float*)(C.lds + 2 * BUFB);
    const int tid = C.tid, lane = C.lane, wave = C.wave, fr = lane & 15, fq = lane >> 4;
    for (int item = C.bid; item < 64; item += C.G) {
        const int chain = item >> 1, vh = item & 1, d = chain >> 4, b = (chain >> 3) & 1, h = chain & 7;
        const size_t ci0 = (size_t)chain * RNCH;
        if (wave < 4) {
            f32x4 ST[8];
#pragma unroll
            for (int i = 0; i < 8; ++i) ST[i] = (f32x4){0.f, 0.f, 0.f, 0.f};
            SCAN_BAR();
#pragma unroll 1
            for (int cc = 0; cc < RNCH; ++cc) {
                const LAS bf16_t* B = (const LAS bf16_t*)(C.lds + (cc & 1) * BUFB); const LAS float* sc = (const LAS float*)(B + O_END); const LAS v4u* PF = (const LAS v4u*)(sc + 384);
                bf16x8 fQ[2][4], fKT[8]; f32x4 eg[8];
                const bf16x8 vfrag = *(const LAS bf16x8*)(B + O_VT + (16 * wave + fr) * TS + 8 * fq);
                const bf16x8 pf0 = __builtin_bit_cast(bf16x8, PF[lane]), pf1 = __builtin_bit_cast(bf16x8, PF[64 + lane]);
#pragma unroll
                for (int ti = 0; ti < 2; ++ti)
#pragma unroll
                    for (int sg = 0; sg < 4; ++sg) fQ[ti][sg] = *(const LAS bf16x8*)(B + O_QT + (16 * ti + fr) * RS + 32 * sg + 8 * fq);
#pragma unroll
                for (int i = 0; i < 8; ++i) { fKT[i] = *(const LAS bf16x8*)(B + O_KT + (16 * i + fr) * TS + 8 * fq); eg[i] = *(const LAS f32x4*)(sc + 16 * i + 4 * fq); }
                __builtin_amdgcn_sched_barrier(0);
                bf16x8 sfrag[4];
#pragma unroll
                for (int sg = 0; sg < 4; ++sg) { const f32x4 s0 = ST[2 * sg] * eg[2 * sg], s1 = ST[2 * sg + 1] * eg[2 * sg + 1]; v4u w; w.x = pk2(s0[0], s0[1]); w.y = pk2(s0[2], s0[3]); w.z = pk2(s1[0], s1[1]); w.w = pk2(s1[2], s1[3]); sfrag[sg] = __builtin_bit_cast(bf16x8, w); }
#pragma unroll
                for (int ti = 0; ti < 2; ++ti) { f32x4 o = (f32x4){0.f, 0.f, 0.f, 0.f};
                    o = __builtin_amdgcn_mfma_f32_16x16x32_bf16(ti ? pf1 : pf0, vfrag, o, 0, 0, 0);
#pragma unroll
                    for (int sg = 0; sg < 4; ++sg) o = __builtin_amdgcn_mfma_f32_16x16x32_bf16(fQ[ti][sg], sfrag[sg], o, 0, 0, 0);
#pragma unroll
                    for (int r = 0; r < 4; ++r) ostage[(cc & 1) * 2048 + (16 * ti + 4 * fq + r) * 64 + 16 * wave + fr] = o[r]; }
#pragma unroll
                for (int i = 0; i < 8; ++i) { const f32x4 ec = *(const LAS f32x4*)(sc + 128 + 16 * i + 4 * fq), ea = *(const LAS f32x4*)(sc + 256 + 16 * i + 4 * fq); f32x4 n = (f32x4){0.f, 0.f, 0.f, 0.f}; n = __builtin_amdgcn_mfma_f32_16x16x32_bf16(fKT[i], vfrag, n, 0, 0, 0); ST[i] = ST[i] * ea + n * ec; }
                SCAN_BAR();
            }
            SCAN_BAR();
        } else {
            const int lt = tid - 256;
            v4u gA[7], gB[7], gC[7], gD[7], gE[7], gF[7];
#define HGC_LOAD(cc, g) do { const size_t ci = ci0 + (cc); const GAS v4u* pq = (const GAS v4u*)((const GAS bf16_t*)I.QT + ci * 4096); const GAS v4u* pk = (const GAS v4u*)((const GAS bf16_t*)I.KT + ci * 4096); \
            g[0] = pq[lt]; g[1] = pq[lt + 256]; g[2] = pk[lt]; g[3] = pk[lt + 256]; \
            g[4] = ((const GAS v4u*)((const GAS bf16_t*)I.VT + ((size_t)(b * 8 + h) * RNCH + hgc_vtslot(d, (cc))) * 4096 + vh * 2048))[lt]; \
            g[5] = ((const GAS v4u*)((const GAS float*)I.SC + ci * 384))[lt < 96 ? lt : 0]; g[6] = ((const GAS v4u*)I.PF)[ci * 128 + (lt & 127)]; } while (0)
#define HGC_STORE(cc, g) do { LAS bf16_t* B = (LAS bf16_t*)(C.lds + ((cc) & 1) * BUFB); const int r16 = lt >> 4, c16 = (lt & 15) * 8, r4 = lt >> 2, c4 = (lt & 3) * 8; \
            *(LAS v4u*)(B + O_QT + r16 * RS + c16) = g[0]; *(LAS v4u*)(B + O_QT + (r16 + 16) * RS + c16) = g[1]; \
            *(LAS v4u*)(B + O_KT + r4 * TS + c4) = g[2]; *(LAS v4u*)(B + O_KT + (r4 + 64) * TS + c4) = g[3]; *(LAS v4u*)(B + O_VT + r4 * TS + c4) = g[4]; \
            if (lt < 96) *(LAS v4u*)((LAS float*)(B + O_END) + lt * 4) = g[5]; if (lt < 128) *((LAS v4u*)((LAS float*)(B + O_END) + 384) + lt) = g[6]; } while (0)
            f32x4 ofA[2], ofB[2];
#pragma unroll
            for (int q = 0; q < 2; ++q) { ofA[q] = (f32x4){0.f, 0.f, 0.f, 0.f}; ofB[q] = ofA[q]; }
#define HGC_OFLUSH(cc, of) do { const int rowbase = rwc_rowbase(d, b, (cc)); _Pragma("unroll") for (int q = 0; q < 2; ++q) { const int idx = lt + 256 * q, tau = idx >> 4, c4 = idx & 15; \
                of[q] = *(const LAS f32x4*)(ostage + ((cc) & 1) * 2048 + tau * 64 + 4 * c4); \
                *(GAS f32x4*)((GAS float*)O + ((size_t)d * MROWS + rowbase + tau) * D + h * 128 + vh * 64 + 4 * c4) = of[q]; } } while (0)
            HGC_LOAD(0, gA); HGC_STORE(0, gA); HGC_LOAD(1, gB); HGC_LOAD(2, gC); HGC_LOAD(3, gD); HGC_LOAD(4, gE); HGC_LOAD(5, gF); HGC_LOAD(6, gA);
            SCAN_BAR();
#define HGC_LSTEP(cc, g, of, ofo) do { if ((cc) + 1 < RNCH) { HGC_STORE((cc) + 1, g); if ((cc) + 7 < RNCH) HGC_LOAD((cc) + 7, g); } \
                asm volatile("" :: "v"(ofo[0]), "v"(ofo[1])); if ((cc) >= 1) HGC_OFLUSH((cc) - 1, of); SCAN_BAR(); } while (0)
            static_assert(RNCH % 6 == 4, "loop shape");
#pragma unroll 1
            for (int cc = 0; cc + 5 < RNCH; cc += 6) { HGC_LSTEP(cc, gB, ofA, ofB); HGC_LSTEP(cc + 1, gC, ofB, ofA); HGC_LSTEP(cc + 2, gD, ofA, ofB); HGC_LSTEP(cc + 3, gE, ofB, ofA); HGC_LSTEP(cc + 4, gF, ofA, ofB); HGC_LSTEP(cc + 5, gA, ofB, ofA); }
            HGC_LSTEP(RNCH - 4, gB, ofA, ofB); HGC_LSTEP(RNCH - 3, gC, ofB, ofA); HGC_LSTEP(RNCH - 2, gD, ofA, ofB); HGC_LSTEP(RNCH - 1, gE, ofB, ofA);
            HGC_OFLUSH(RNCH - 1, ofA);
            SCAN_BAR();
#undef HGC_LSTEP
#undef HGC_OFLUSH
#undef HGC_LOAD
#undef HGC_STORE
        }
    }
}
constexpr int MOE_MAXROWS = 68608;
constexpr int MOE_MAXT = MOE_MAXROWS / 256;

__device__ __forceinline__ void ph_moe_route(const Ctx& C, const float* res, const float* g, const float* modl, const float* router, bf16_t* H2, int* TOKE, float* TOKG, int* BCNT, unsigned* tc = nullptr) {
    LAS float* rt = (LAS float*)C.lds;
    LAS int* cnt = (LAS int*)(rt + D * NEXP);
    for (int i = C.tid; i < D * NEXP; i += NTHR) rt[i] = router[i];
    if (C.tid < NEXP) cnt[C.tid] = 0;
    __syncthreads();
    const int lane = C.lane; const bool split = tc != nullptr; const RowIt it = row_part(C, split);
    for (int r = it.r0; r < it.r1; r += it.step) {
        f32x4 v[4]; load_row(res + (size_t)r * D, lane, v); const float s = row_rstd(v);
        const int b = row_bidx(r);
        const GAS f32x4* g4 = (const GAS f32x4*)g + lane; const GAS f32x4* sh4 = (const GAS f32x4*)(modl + (size_t)(b * 6 + 3) * D) + lane; const GAS f32x4* sc4 = (const GAS f32x4*)(modl + (size_t)(b * 6 + 4) * D) + lane;
        GAS v2u* o = (GAS v2u*)(H2 + (size_t)r * D) + lane;
        float lg[NEXP];
#pragma unroll
        for (int e = 0; e < NEXP; ++e) lg[e] = 0.f;
#pragma unroll
        for (int j = 0; j < 4; ++j) { const f32x4 h = v[j] * s * g4[64 * j] * (sc4[64 * j] + 1.0f) + sh4[64 * j];
            v2u w; w.x = pk2(h.x, h.y); w.y = pk2(h.z, h.w); o[64 * j] = w;
#pragma unroll
            for (int i = 0; i < 4; ++i) { const LAS f32x4* rr = (const LAS f32x4*)(rt + (size_t)(256 * j + 4 * lane + i) * NEXP); const f32x4 r0 = rr[0], r1 = rr[1]; const float hv = h[i];
                lg[0] += hv * r0.x; lg[1] += hv * r0.y; lg[2] += hv * r0.z; lg[3] += hv * r0.w; lg[4] += hv * r1.x; lg[5] += hv * r1.y; lg[6] += hv * r1.z; lg[7] += hv * r1.w; } }
#pragma unroll
        for (int e = 0; e < NEXP; ++e) lg[e] = wave_sum(lg[e]);
        int i0 = 0; float l0 = lg[0];
#pragma unroll
        for (int e = 1; e < NEXP; ++e) if (lg[e] > l0) { l0 = lg[e]; i0 = e; }
        int i1 = -1; float l1 = -3.0e38f;
#pragma unroll
        for (int e = 0; e < NEXP; ++e) if (e != i0 && lg[e] > l1) { l1 = lg[e]; i1 = e; }
        const float g0 = 1.0f / (1.0f + __expf(l1 - l0));
        if (lane == 0) { TOKE[2 * r] = i0; TOKE[2 * r + 1] = i1; TOKG[2 * r] = g0; TOKG[2 * r + 1] = 1.0f - g0; __hip_atomic_fetch_add(&cnt[i0], 1, __ATOMIC_RELAXED, __HIP_MEMORY_SCOPE_WORKGROUP); __hip_atomic_fetch_add(&cnt[i1], 1, __ATOMIC_RELAXED, __HIP_MEMORY_SCOPE_WORKGROUP); }
    }
    __syncthreads();
    if (C.tid < NEXP) BCNT[C.bid * NEXP + C.tid] = cnt[C.tid];
    __syncthreads();
}
__device__ __forceinline__ void ph_moe_scatter(const Ctx& C, const bf16_t* H2, const int* TOKE, const int* BCNT, int* DEST, int* TILE, bf16_t* ABUF, bool split = false) {
    LAS int* cur = (LAS int*)C.lds;
    if (C.tid < NEXP) { int tot = 0, mine = 0; for (int b = 0; b < C.G; ++b) { const int c = BCNT[b * NEXP + C.tid]; tot += c; mine += (b < C.bid) ? c : 0; } cur[16 + C.tid] = tot; cur[24 + C.tid] = mine; }
    __syncthreads();
    if (C.tid == 0) { int st = 0; for (int e = 0; e < NEXP; ++e) { const int nt = (cur[16 + e] + 255) >> 8; cur[8 + e] = st; cur[e] = st * 256 + cur[24 + e]; if (C.bid == 0) for (int q = 0; q < nt; ++q) TILE[st + q] = e; st += nt; } if (C.bid == 0) TILE[MOE_MAXT] = st; }
    __syncthreads();
    const int lane = C.lane; const RowIt it = row_part(C, split);
    for (int r = it.r0; r < it.r1; r += it.step) {
        int p0 = 0, p1 = 0;
        if (lane == 0) { p0 = __hip_atomic_fetch_add(&cur[TOKE[2 * r]], 1, __ATOMIC_RELAXED, __HIP_MEMORY_SCOPE_WORKGROUP); p1 = __hip_atomic_fetch_add(&cur[TOKE[2 * r + 1]], 1, __ATOMIC_RELAXED, __HIP_MEMORY_SCOPE_WORKGROUP); DEST[2 * r] = p0; DEST[2 * r + 1] = p1; }
        p0 = __shfl(p0, 0); p1 = __shfl(p1, 0);
        const GAS v4u* src = (const GAS v4u*)(H2 + (size_t)r * D) + lane; const v4u a = src[0], b = src[64];
        GAS v4u* d0 = (GAS v4u*)(ABUF + (size_t)p0 * D) + lane; GAS v4u* d1 = (GAS v4u*)(ABUF + (size_t)p1 * D) + lane;
        d0[0] = a; d0[64] = b; d1[0] = a; d1[64] = b;
    }
}
struct SchedMoe {
    const bf16_t* A; const bf16_t* Bt; const int* TILE; int lda, ldb, npl  , G, c; int mode = 0;
    __device__ __forceinline__ bool next(int i, Unit& u) const { const int nt = TILE[MOE_MAXT]; const long tot = (long)nt * npl, mainu = (tot / G) * G;
        const long L = mode == 2 ? mainu + c : (long)i * G + c; if (L >= (mode == 1 ? mainu : tot) || (mode == 2 && i > 0)) return false;
        u.pm = (int)(L / npl); u.aux = (int)(L % npl); u.pn = TILE[u.pm] * npl + u.aux; return true; }
    __device__ __forceinline__ const char* a_ptr(const Unit& u) const { return (const char*)(A + (size_t)u.pm * 256 * lda); }
    __device__ __forceinline__ const char* b_ptr(const Unit& u) const { return (const char*)(Bt + (size_t)u.pn * 256 * ldb); }
};
__device__ __forceinline__ void ph_moe_combine(const Ctx& C, float* res, const float* modl, const float* OUT, const int* DEST, const float* TOKG, const float* fin_g = nullptr, float* out = nullptr,
                                               const float* nx_g = nullptr, const float* nx_modl = nullptr, bf16_t* nx_hb = nullptr, unsigned* tc = nullptr, int b0 = 0, int pm_main = 0x7fffffff, int pm_end = 0) {
    if (C.bid < b0) return;
    const int gw = (C.bid - b0) * NWAVES + C.wave, NGW = (C.G - b0) * NWAVES, lane = C.lane;
    const bool fin = out != nullptr;
    auto one_row = [&](int r, int d0, int d1) {
        const float g0 = TOKG[2 * r], g1 = TOKG[2 * r + 1]; const int b = row_bidx(r);
        const GAS f32x4* o0 = (const GAS f32x4*)(OUT + (size_t)d0 * D) + lane; const GAS f32x4* o1 = (const GAS f32x4*)(OUT + (size_t)d1 * D) + lane;
        const GAS f32x4* gt = (const GAS f32x4*)(modl + (size_t)(b * 6 + 5) * D) + lane; GAS f32x4* rp = (GAS f32x4*)(res + (size_t)r * D) + lane;
        f32x4 v[4];
#pragma unroll
        for (int j = 0; j < 4; ++j) v[j] = rp[64 * j] + gt[64 * j] * (o0[64 * j] * g0 + o1[64 * j] * g1);
        if (!fin) {
#pragma unroll
            for (int j = 0; j < 4; ++j) rp[64 * j] = v[j];
            if (nx_hb != nullptr) {
                const float s = row_rstd(v);
                const GAS f32x4* g4 = (const GAS f32x4*)nx_g + lane; const GAS f32x4* sh4 = (const GAS f32x4*)(nx_modl + (size_t)(b * 6 + 0) * D) + lane; const GAS f32x4* sc4 = (const GAS f32x4*)(nx_modl + (size_t)(b * 6 + 1) * D) + lane;
                GAS v2u* o = (GAS v2u*)(nx_hb + (size_t)r * D) + lane;
#pragma unroll
                for (int j = 0; j < 4; ++j) { const f32x4 h = v[j] * s * g4[64 * j] * (sc4[64 * j] + 1.0f) + sh4[64 * j]; v2u w; w.x = pk2(h.x, h.y); w.y = pk2(h.z, h.w); o[64 * j] = w; }
            }
        } else {
            const float s = row_rstd(v);
            const GAS f32x4* g4 = (const GAS f32x4*)fin_g + lane; GAS f32x4* o = (GAS f32x4*)(out + (size_t)(r - NCTX) * D) + lane;
#pragma unroll
            for (int j = 0; j < 4; ++j) o[64 * j] = v[j] * s * g4[64 * j];
        }
    };
    unsigned defer = 0u; int k = 0;
    for (int r = gw + (fin ? NCTX : 0); r < MROWS; r += NGW, ++k) {
        const int d0 = DEST[2 * r], d1 = DEST[2 * r + 1];
        if ((d0 >> 8) >= pm_main || (d1 >> 8) >= pm_main) { defer |= 1u << k; continue; }
        one_row(r, d0, d1);
    }
    if (tc != nullptr && pm_main < pm_end) {
        __syncthreads();
        if (C.tid == 0) { for (int t = pm_main; t < pm_end; ++t) { unsigned sp = 0; while (__hip_atomic_load(tc + t, __ATOMIC_RELAXED, __HIP_MEMORY_SCOPE_AGENT) < (unsigned)(D / 256)) { __builtin_amdgcn_s_sleep(2); if (++sp > (1u << 22)) break; } }
            __builtin_amdgcn_fence(__ATOMIC_ACQUIRE, "agent"); asm volatile("s_waitcnt vmcnt(0)" ::: "memory"); }
        __syncthreads();
        k = 0;
        for (int r = gw + (fin ? NCTX : 0); r < MROWS; r += NGW, ++k) if ((defer >> k) & 1u) { const int d0 = DEST[2 * r], d1 = DEST[2 * r + 1]; one_row(r, d0, d1); }
    }
}
constexpr size_t HY_H = 0;
constexpr size_t HY_PROJT = al256(HY_H + SZ_ACT_BF);
constexpr size_t HY_HB = al256(HY_PROJT + (size_t)3 * D * MROWS * 4);
constexpr size_t HY_FILT = al256(HY_HB + (size_t)HY_NPOS * 256 * 2);
constexpr size_t HY_YT = al256(HY_FILT + (size_t)4096 * HY_NPOS * 4);
constexpr size_t HY_YB = al256(HY_YT + (size_t)D * MROWS * 4);
constexpr size_t HY_SCR = al256(HY_YB + SZ_ACT_BF);
constexpr size_t HY_END = HY_SCR + (size_t)256 * 3 * FN * 8;
static_assert(HY_END <= ARENA_BYTES, "hyena arena");
constexpr size_t HYW_WIN = (size_t)8 << 20, HYW_WO = ((size_t)8 << 20) + (size_t)3 * D * D * 2;

__device__ __forceinline__ void hy_cvt(const Ctx& C, const Args& args, unsigned char* ws) {
    bf16_t* WinT = (bf16_t*)(ws + WS_WREG + HYW_WIN); bf16_t* WoT = (bf16_t*)(ws + WS_WREG + HYW_WO);
    const CvtJob jobs[2] = { {args.in[I_HY_WIN], WinT, D, 3 * D, 3 * D, D, 0, 0, 3 * D, 0}, {args.in[I_HY_WO], WoT, D, D, D, D, 0, 0, D, 0} };
    cvt_run(C, jobs);
}
__device__ __forceinline__ SchedPlain res_sched(const Ctx& C, const bf16_t* A, const bf16_t* Bt, int ld, int part) {
    if (part == 1) return SchedPlain{A, Bt, ld, ld, PMT - NCTX / 256, D / 256, C.G, C.bid, NCTX / 256};
    if (part == 2) return SchedPlain{A, Bt, ld, ld, NCTX / 256, D / 256, TAILB, C.bid, 0};
    return SchedPlain{A, Bt, ld, ld, PMT, D / 256, C.G, C.bid, 0};
}
__device__ __forceinline__ unsigned* tail_tc(unsigned char* ws, int inst) { return (unsigned*)(ws + WS_CTL) + CW_TC + 8 * inst; }
__device__ __forceinline__ void tail_done(const Ctx& C, unsigned* tc) { int pm, pn; (void)pg8::static_unit(NCTX / 256, D / 256, TAILB, C.bid, 0, pm, pn); tile_signal(C, tc + pm); tile_wait_block(C, tc, NCTX / 256, D / 256); }
enum { TI_RW0 = 0, TI_FF0, TI_HY, TI_HG, TI_FF2 };
__device__ __forceinline__ void rw_phase_wo(const Ctx& C, const Args& args, unsigned char* ws, int layer, int slot, int part = -1);
__device__ __forceinline__ void ff_phase_g2(const Ctx& C, unsigned char* ws, int layer, int part = -1);
__device__ __forceinline__ void hg_phase_wo(const Ctx& C, unsigned char* ws, int layer, int part = -1);
__device__ __forceinline__ void hy_phase_a(const Ctx& C, const Args& args, unsigned char* ws, int layer) {
    const bool split = tail_split(C); unsigned* tc = tail_tc(ws, TI_FF0);
    if (split && C.bid < TAILB) { ff_phase_g2(C, ws, layer - 1, 2); tail_done(C, tc); }
    ph_hy_w4split(C, args.in[I_HY_FW4], (bf16_t*)(ws + WS_ZREG + Z_AW));
    ph_hy_filter_mlp(C, args.in[I_HY_FW1], args.in[I_HY_FB1], args.in[I_HY_FW2], args.in[I_HY_FB2], args.in[I_HY_FW3], args.in[I_HY_FB3], args.in[I_HY_FREQ], (bf16_t*)(ws + WS_ARENA + HY_HB));
    ph_norm_mod_bf16(C, (const float*)(ws + WS_RES), args.in[I_NORMG] + (size_t)(layer * 2 + 0) * D, (const float*)(ws + WS_MOD) + (size_t)layer * 18 * D, 0, 1, (bf16_t*)(ws + WS_ARENA + HY_H), split ? tc : nullptr);
}
__device__ __forceinline__ void hy_phase_b(const Ctx& C, const Args& args, unsigned char* ws) {
    {   SchedPlain S{(const bf16_t*)(ws + WS_WREG + HYW_WIN), (const bf16_t*)(ws + WS_ARENA + HY_H), D, D, 3 * D / 256, PMT, C.G, C.bid};
        EpiF32RowBias E{(float*)(ws + WS_ARENA + HY_PROJT), MROWS, args.in[I_HY_BIN]};
        pg8::gemm_phase(C.lds, D, D, D, S, E); }
    {   SchedPlain S{(const bf16_t*)(ws + WS_ZREG + Z_AW), (const bf16_t*)(ws + WS_ARENA + HY_HB), 256, 256, 4096 / 256, HY_NPOS / 256, C.G, C.bid};
        EpiHyFilt E{(float*)(ws + WS_ARENA + HY_FILT)};
        pg8::gemm_phase(C.lds, 256, 256, 256, S, E); }
}
__device__ __forceinline__ void hy_phase_wo(const Ctx& C, const Args& args, unsigned char* ws, int layer, int part = -1) {
    if (part < 0) part = tail_split(C) ? 1 : 0;
    SchedPlain S = res_sched(C, (const bf16_t*)(ws + WS_ARENA + HY_YB), (const bf16_t*)(ws + WS_WREG + HYW_WO), D, part);
    EpiRes E{(float*)(ws + WS_RES), (const float*)(ws + WS_MOD) + (size_t)layer * 18 * D, 2, args.in[I_HY_BO]};
    pg8::gemm_phase(C.lds, D, D, D, S, E);
}

__device__ __forceinline__ void ff_cvt(const Ctx& C, const Args& args, unsigned char* ws, int layer);
__device__ __forceinline__ void hg_cvt(const Ctx& C, const Args& args, unsigned char* ws, int slot);
__device__ __forceinline__ void mo_cvt(const Ctx& C, const Args& args, unsigned char* ws, int layer);
constexpr size_t RW_X6 = 0;
constexpr size_t RW_RKV = al256(RW_X6 + 6 * SZ_ACT_BF);
constexpr size_t RW_LD = al256(RW_RKV + 3 * SZ_ACT_BF);
constexpr size_t RW_DEC = al256(RW_LD + SZ_ACT_BF);
constexpr size_t RW_ASIG = RW_DEC + 2 * SZ_ACT_BF;
constexpr size_t RW_Y = RW_DEC;
constexpr size_t RW_YB = RW_LD;
constexpr size_t RW_G = al256(RW_ASIG + 2 * SZ_ACT_BF);
constexpr size_t RW_BON = al256(RW_G + SZ_ACT_BF);
constexpr size_t RW_IMG_BT = al256(RW_BON + (size_t)2 * MROWS * RW_H * 4);
constexpr size_t RW_IMG_KT = RW_IMG_BT + (size_t)RW_NCHUNKHEAD * 4096;
constexpr size_t RW_IMG_SC = RW_IMG_KT + (size_t)RW_NCHUNKHEAD * 4096;
constexpr size_t RW_IMG_VT = RW_IMG_SC + (size_t)RW_NCHUNKHEAD * 768;
constexpr size_t RW_END = RW_IMG_VT + (size_t)16 * RW_NTCH * 4096;
static_assert((size_t)RW_NCHUNKHEAD * 4096 == 2 * SZ_ACT_BF && 2 * SZ_ACT_F32 == 4 * SZ_ACT_BF && RW_END <= ARENA_BYTES, "rwkv arena");
constexpr size_t RWW_RKV = 0, RWW_WO = (size_t)3 * D * D * 2;

__device__ __forceinline__ bf16_t* rw_vbuf(unsigned char* ws, int slot) { return slot == 0 ? (bf16_t*)(ws + WS_VFIRST) : (bf16_t*)(ws + WS_ARENA + RW_RKV + 2 * SZ_ACT_BF); }
__device__ __forceinline__ RwcImg rw_img(unsigned char* ws) {
    RwcImg I; unsigned char* a = ws + WS_ARENA;
    I.WP = (bf16_t*)(a + RW_X6); I.RT = (bf16_t*)(a + RW_X6 + 2 * SZ_ACT_BF); I.TA = (bf16_t*)(a + RW_X6 + 4 * SZ_ACT_BF); I.ARB = (bf16_t*)(a + RW_X6 + 5 * SZ_ACT_BF); I.ARK = (bf16_t*)(a + RW_LD);
    I.BT = (bf16_t*)(a + RW_IMG_BT); I.KT = (bf16_t*)(a + RW_IMG_KT); I.SC = (float*)(a + RW_IMG_SC); I.VT = (bf16_t*)(a + RW_IMG_VT); return I;
}

__device__ __forceinline__ void rw_cvt(const Ctx& C, const Args& args, unsigned char* ws, int slot) {
    bf16_t* Wrkv = (bf16_t*)(ws + WS_WREG + RWW_RKV); bf16_t* WoT = (bf16_t*)(ws + WS_WREG + RWW_WO);
    bf16_t* Ldn = (bf16_t*)(ws + WS_ZREG + slot * Z_SLOT + Z_LDN); bf16_t* Lup = (bf16_t*)(ws + WS_ZREG + slot * Z_SLOT + Z_LUP);
    const float* wrkv = args.in[I_RW_WRKV] + (size_t)slot * 3 * D * D;
    const float* w1 = args.in[I_RW_W1] + (size_t)slot * 2 * D * 64; const float* a1 = args.in[I_RW_A1] + (size_t)slot * 2 * D * 64;
    const float* w2 = args.in[I_RW_W2] + (size_t)slot * 2 * 64 * D; const float* a2 = args.in[I_RW_A2] + (size_t)slot * 2 * 64 * D;
    const CvtJob jobs[14] = {
        {wrkv, Wrkv, D, D, D, D, 0, 0, D, 0}, {wrkv + (size_t)D * D, Wrkv, D, D, D, D, D, 0, D, 0}, {wrkv + (size_t)2 * D * D, Wrkv, D, D, D, D, 2 * D, 0, D, 0},
        {args.in[I_RW_WO] + (size_t)slot * D * D, WoT, D, D, D, D, 0, 0, D, 0},
        {w1, Ldn, D, 64, 64, D, 0, 0, 64, 0}, {w1 + (size_t)D * 64, Ldn, D, 64, 64, D, 64, 0, 64, 0},
        {a1, Ldn, D, 64, 64, D, 256, 0, 64, 0}, {a1 + (size_t)D * 64, Ldn, D, 64, 64, D, 256 + 64, 0, 64, 0},
        {args.in[I_RW_G1] + (size_t)slot * D * 160, Ldn, D, 160, 160, D, 512, 0, 160, 0},
        {w2, Lup, 64, D, D, 256, 0, 0, D, 0}, {w2 + (size_t)64 * D, Lup, 64, D, D, 256, D, 64, D, 0},
        {a2, Lup, 64, D, D, 256, 2 * D, 0, D, 0}, {a2 + (size_t)64 * D, Lup, 64, D, D, 256, 3 * D, 64, D, 0},
        {args.in[I_RW_G2] + (size_t)slot * 160 * D, Lup, 160, D, D, 256, 4 * D, 0, D, 0} };
    cvt_run(C, jobs);
    if (slot > 0) { const CvtJob jv[2] = { {args.in[I_RW_V1] + (size_t)(slot - 1) * D * 32, Ldn, D, 32, 32, D, 768, 0, 32, 0}, {args.in[I_RW_V2] + (size_t)(slot - 1) * 32 * D, Lup, 32, D, D, 256, 5 * D, 0, D, 0} }; cvt_run(C, jv); }
}
__device__ __forceinline__ void rw_phase_a(const Ctx& C, const Args& args, unsigned char* ws, int layer, int slot) {
    const bool split = layer > 0 && tail_split(C); unsigned* tc = tail_tc(ws, TI_FF2);
    if (split && C.bid < TAILB) { ff_phase_g2(C, ws, layer - 1, 2); tail_done(C, tc); }
    const ResSrc src{(const float*)(ws + WS_RES), layer == 0 ? args.in[I_X] : nullptr, layer == 0 ? args.in[I_CTX] : nullptr};
    ph_rstd(C, src, (float*)(ws + WS_RSTD), split ? tc : nullptr);
}
__device__ __forceinline__ void rw_phase_mix(const Ctx& C, const Args& args, unsigned char* ws, int layer, int slot) {
    const ResSrc src{(const float*)(ws + WS_RES), layer == 0 ? args.in[I_X] : nullptr, layer == 0 ? args.in[I_CTX] : nullptr};
    ph_rw_mix(C, src, (const float*)(ws + WS_RSTD), args.in[I_NORMG] + (size_t)(layer * 2) * D, (const float*)(ws + WS_MOD) + (size_t)layer * 18 * D, args.in[I_RW_MU] + (size_t)slot * 6 * D, (bf16_t*)(ws + WS_ARENA + RW_X6));
}
__device__ __forceinline__ void rw_phase_g1(const Ctx& C, const Args& args, unsigned char* ws, int layer, int slot) {
    SchedRw1 S{(const bf16_t*)(ws + WS_ARENA + RW_X6), (const bf16_t*)(ws + WS_WREG + RWW_RKV), (const bf16_t*)(ws + WS_ZREG + slot * Z_SLOT + Z_LDN), slot > 0 ? 16 : 15, C.G, C.bid};
    EpiRw1 E{(bf16_t*)(ws + WS_ARENA + RW_RKV), (bf16_t*)(ws + WS_ARENA + RW_RKV + SZ_ACT_BF), rw_vbuf(ws, slot), (bf16_t*)(ws + WS_ARENA + RW_LD)};
    pg8::gemm_phase(C.lds, D, D, D, S, E);
}
__device__ __forceinline__ void rw_phase_g2(const Ctx& C, const Args& args, unsigned char* ws, int layer, int slot) {
    SchedRw2 S{(const bf16_t*)(ws + WS_ARENA + RW_LD), (const bf16_t*)(ws + WS_ZREG + slot * Z_SLOT + Z_LUP), slot > 0 ? 24 : 20, C.G, C.bid};
    EpiRw2 E{(bf16_t*)(ws + WS_ARENA + RW_DEC), (bf16_t*)(ws + WS_ARENA + RW_ASIG), (bf16_t*)(ws + WS_ARENA + RW_G), rw_vbuf(ws, slot), (const bf16_t*)(ws + WS_VFIRST),
             args.in[I_RW_W0] + (size_t)slot * 2 * D, args.in[I_RW_A0] + (size_t)slot * 2 * D, args.in[I_RW_V0] + (size_t)(slot > 0 ? slot - 1 : 0) * D};
    pg8::gemm_phase(C.lds, 256, D, 256, S, E);
}
__device__ __forceinline__ void rw_phase_prep(const Ctx& C, const Args& args, unsigned char* ws, int layer, int slot) {
    const RwcImg I = rw_img(ws);
    ph_rwc_prep(C, (const bf16_t*)(ws + WS_ARENA + RW_RKV), (const bf16_t*)(ws + WS_ARENA + RW_RKV + SZ_ACT_BF), rw_vbuf(ws, slot), (const bf16_t*)(ws + WS_ARENA + RW_DEC), (const bf16_t*)(ws + WS_ARENA + RW_ASIG),
                args.in[I_RW_KK] + (size_t)slot * D, args.in[I_RW_KA] + (size_t)slot * D, args.in[I_RW_RK] + (size_t)slot * D, (float*)(ws + WS_ARENA + RW_BON), I);
}
__device__ __forceinline__ void rw_phase_scan(const Ctx& C, const Args& args, unsigned char* ws, int layer, int slot) {
    const RwcImg I = rw_img(ws);
    ph_rwc_scan(C, I, (float*)(ws + WS_ARENA + RW_Y));
    if (layer == 0 && C.G > 128 && C.bid >= 128) { Ctx C2 = C; C2.bid = C.bid - 128; C2.G = C.G - 128; hy_cvt(C2, args, ws); ff_cvt(C2, args, ws, 0); hg_cvt(C2, args, ws, 0); mo_cvt(C2, args, ws, 1); }
    else if (layer == 0 && C.G <= 128) { hy_cvt(C, args, ws); ff_cvt(C, args, ws, 0); hg_cvt(C, args, ws, 0); mo_cvt(C, args, ws, 1); }
    if (layer == 3 && C.G > 128 && C.bid >= 128) { Ctx C2 = C; C2.bid = C.bid - 128; C2.G = C.G - 128; mo_cvt(C2, args, ws, 3); }
    else if (layer == 3 && C.G <= 128) mo_cvt(C, args, ws, 3);
}
__device__ __forceinline__ void rw_phase_post(const Ctx& C, const Args& args, unsigned char* ws, int layer, int slot) {
    ph_rw_post(C, (const float*)(ws + WS_ARENA + RW_Y), (const float*)(ws + WS_ARENA + RW_BON), rw_vbuf(ws, slot), (const bf16_t*)(ws + WS_ARENA + RW_G), args.in[I_RW_LNW] + (size_t)slot * D, args.in[I_RW_LNB] + (size_t)slot * D, (bf16_t*)(ws + WS_ARENA + RW_YB));
}
__device__ __forceinline__ void rw_phase_wo(const Ctx& C, const Args& args, unsigned char* ws, int layer, int slot, int part) {
    if (part < 0) part = (layer == DEPTH - 1 || tail_split(C)) ? 1 : 0;
    SchedPlain S = res_sched(C, (const bf16_t*)(ws + WS_ARENA + RW_YB), (const bf16_t*)(ws + WS_WREG + RWW_WO), D, part);
    EpiRes E{(float*)(ws + WS_RES), (const float*)(ws + WS_MOD) + (size_t)layer * 18 * D, 2, nullptr, layer == 0 ? args.in[I_X] : nullptr, layer == 0 ? args.in[I_CTX] : nullptr};
    pg8::gemm_phase(C.lds, D, D, D, S, E);
}
constexpr size_t FF_H2 = 0, FF_ACT = al256(SZ_ACT_BF);
constexpr size_t WREG_FFN = (size_t)16 << 20, WREG_MOE = (size_t)34 << 20;
constexpr size_t FFW_13 = WREG_FFN, FFW_2 = WREG_FFN + (size_t)2 * FFN * D * 2;
__device__ __forceinline__ void ff_cvt(const Ctx& C, const Args& args, unsigned char* ws, int layer) {
    const float* w13 = args.in[I_FFN_W13] + (size_t)(layer / 2) * D * 2 * FFN; const float* w2 = args.in[I_FFN_W2] + (size_t)(layer / 2) * FFN * D;
    bf16_t* W13T = (bf16_t*)(ws + WS_WREG + FFW_13); bf16_t* W2T = (bf16_t*)(ws + WS_WREG + FFW_2);
    const CvtJob jobs[3] = { {w13, W13T, D, FFN, 2 * FFN, D, 0, 0, 128, 256}, {w13 + FFN, W13T, D, FFN, 2 * FFN, D, 128, 0, 128, 256}, {w2, W2T, FFN, D, D, FFN, 0, 0, D, 0} };
    cvt_run(C, jobs);
}
__device__ __forceinline__ void ff_phase_a(const Ctx& C, const Args& args, unsigned char* ws, int layer) {
    const bool split = tail_split(C); unsigned* tc = tail_tc(ws, layer == 0 ? TI_RW0 : TI_HG);
    if (split && C.bid < TAILB) { if (layer == 0) rw_phase_wo(C, args, ws, 0, 0, 2); else hg_phase_wo(C, ws, layer, 2); tail_done(C, tc); }
    ph_norm_mod_bf16(C, (const float*)(ws + WS_RES), args.in[I_NORMG] + (size_t)(layer * 2 + 1) * D, (const float*)(ws + WS_MOD) + (size_t)layer * 18 * D, 3, 4, (bf16_t*)(ws + WS_ARENA + FF_H2), split ? tc : nullptr);
}
__device__ __forceinline__ void ff_phase_g1(const Ctx& C, unsigned char* ws) {
    SchedPlain S{(const bf16_t*)(ws + WS_ARENA + FF_H2), (const bf16_t*)(ws + WS_WREG + FFW_13), D, D, PMT, 2 * FFN / 256, C.G, C.bid};
    EpiSwiGLU E{(bf16_t*)(ws + WS_ARENA + FF_ACT), FFN};
    pg8::gemm_phase(C.lds, D, D, D, S, E);
}
__device__ __forceinline__ void ff_phase_g2(const Ctx& C, unsigned char* ws, int layer, int part) {
    if (part < 0) part = tail_split(C) ? 1 : 0;
    SchedPlain S = res_sched(C, (const bf16_t*)(ws + WS_ARENA + FF_ACT), (const bf16_t*)(ws + WS_WREG + FFW_2), FFN, part);
    EpiRes E{(float*)(ws + WS_RES), (const float*)(ws + WS_MOD) + (size_t)layer * 18 * D, 5, nullptr};
    pg8::gemm_phase(C.lds, FFN, FFN, FFN, S, E);
}
constexpr size_t MO_H2 = 0;
constexpr size_t MO_ABUF = al256(MO_H2 + SZ_ACT_BF);
constexpr size_t MO_ACT = al256(MO_ABUF + (size_t)MOE_MAXROWS * D * 2);
constexpr size_t MO_OUT = al256(MO_ACT + (size_t)MOE_MAXROWS * EDIM * 2);
constexpr size_t MO_TOKE = al256(MO_OUT + (size_t)MOE_MAXROWS * D * 4);
constexpr size_t MO_TOKG = al256(MO_TOKE + (size_t)MROWS * 8);
constexpr size_t MO_DEST = al256(MO_TOKG + (size_t)MROWS * 8);
constexpr size_t MO_BCNT = al256(MO_DEST + (size_t)MROWS * 8);
constexpr size_t MO_TILE = al256(MO_BCNT + (size_t)1024 * NEXP * 4);
constexpr size_t MO_END = MO_TILE + 4096;
static_assert(MO_END <= ARENA_BYTES, "moe arena");
constexpr size_t MOW_13 = WREG_MOE, MOW_2 = WREG_MOE + (size_t)NEXP * 2 * EDIM * D * 2;
static_assert(MOW_2 + (size_t)NEXP * D * EDIM * 2 <= WREG_BYTES, "moe weights");
__device__ __forceinline__ void mo_cvt(const Ctx& C, const Args& args, unsigned char* ws, int layer) {
    const float* w13 = args.in[I_MOE_W13] + (size_t)(layer / 2) * NEXP * D * 2 * EDIM; const float* w2 = args.in[I_MOE_W2] + (size_t)(layer / 2) * NEXP * EDIM * D;
    bf16_t* W13T = (bf16_t*)(ws + WS_WREG + MOW_13); bf16_t* W2T = (bf16_t*)(ws + WS_WREG + MOW_2);
#pragma unroll 1
    for (int e = 0; e < NEXP; ++e) {
        const CvtJob jobs[3] = { {w13 + (size_t)e * D * 2 * EDIM, W13T + (size_t)e * 2 * EDIM * D, D, EDIM, 2 * EDIM, D, 0, 0, 128, 256}, {w13 + (size_t)e * D * 2 * EDIM + EDIM, W13T + (size_t)e * 2 * EDIM * D, D, EDIM, 2 * EDIM, D, 128, 0, 128, 256},
                                 {w2 + (size_t)e * EDIM * D, W2T + (size_t)e * D * EDIM, EDIM, D, D, EDIM, 0, 0, D, 0} };
        cvt_run(C, jobs); }
}
__device__ __forceinline__ void mo_phase_a(const Ctx& C, const Args& args, unsigned char* ws, int layer) {
    const bool split = layer == 1 && tail_split(C); unsigned* tc = tail_tc(ws, TI_HY);
    if (split && C.bid < TAILB) { hy_phase_wo(C, args, ws, layer, 2); tail_done(C, tc); }
    ph_moe_route(C, (const float*)(ws + WS_RES), args.in[I_NORMG] + (size_t)(layer * 2 + 1) * D, (const float*)(ws + WS_MOD) + (size_t)layer * 18 * D, args.in[I_MOE_ROUTER] + (size_t)(layer / 2) * D * NEXP,
                 (bf16_t*)(ws + WS_ARENA + MO_H2), (int*)(ws + WS_ARENA + MO_TOKE), (float*)(ws + WS_ARENA + MO_TOKG), (int*)(ws + WS_ARENA + MO_BCNT), split ? tc : nullptr);
}
__device__ __forceinline__ void mo_phase_b(const Ctx& C, unsigned char* ws, int layer) {
    ph_moe_scatter(C, (const bf16_t*)(ws + WS_ARENA + MO_H2), (const int*)(ws + WS_ARENA + MO_TOKE), (const int*)(ws + WS_ARENA + MO_BCNT), (int*)(ws + WS_ARENA + MO_DEST), (int*)(ws + WS_ARENA + MO_TILE), (bf16_t*)(ws + WS_ARENA + MO_ABUF),
                   layer == 1 && tail_split(C));
}
__device__ __forceinline__ void mo_phase_g1(const Ctx& C, unsigned char* ws) {
    SchedMoe S{(const bf16_t*)(ws + WS_ARENA + MO_ABUF), (const bf16_t*)(ws + WS_WREG + MOW_13), (const int*)(ws + WS_ARENA + MO_TILE), D, D, 2 * EDIM / 256, C.G, C.bid};
    EpiSwiGLU E{(bf16_t*)(ws + WS_ARENA + MO_ACT), EDIM};
    pg8::gemm_phase(C.lds, D, D, D, S, E);
}
constexpr int MO_TAILMAX = 64;
__device__ __forceinline__ int mo_ntail(const Ctx& C, unsigned char* ws) { const int tot = ((const int*)(ws + WS_ARENA + MO_TILE))[MOE_MAXT] * (D / 256); const int nt = tot % C.G; return (tail_split(C) && nt <= MO_TAILMAX && C.G % (D / 256) == 0) ? nt : 0; }
__device__ __forceinline__ void mo_phase_g2(const Ctx& C, unsigned char* ws, int mode = -1) {
    if (mode < 0) mode = mo_ntail(C, ws) > 0 ? 1 : 0;
    SchedMoe S{(const bf16_t*)(ws + WS_ARENA + MO_ACT), (const bf16_t*)(ws + WS_WREG + MOW_2), (const int*)(ws + WS_ARENA + MO_TILE), EDIM, EDIM, D / 256, C.G, C.bid, mode};
    EpiF32RowBias E{(float*)(ws + WS_ARENA + MO_OUT), D, nullptr};
    pg8::gemm_phase(C.lds, EDIM, EDIM, EDIM, S, E);
}
__device__ __forceinline__ void mo_phase_c(const Ctx& C, const Args& args, unsigned char* ws, int layer) {
    const bool last = layer == DEPTH - 1;
    const bool nx = layer == 1;
    const int ntail = mo_ntail(C, ws); unsigned* tc = (unsigned*)(ws + WS_CTL) + CW_TC + 64 + (layer / 2) * 512; int pm_main = 0x7fffffff; const int pm_end = ((const int*)(ws + WS_ARENA + MO_TILE))[MOE_MAXT];
    if (ntail > 0) { const int tot = ((const int*)(ws + WS_ARENA + MO_TILE))[MOE_MAXT] * (D / 256); const int mainu = (tot / C.G) * C.G; pm_main = mainu / (D / 256);
        if (C.bid < ntail) { mo_phase_g2(C, ws, 2); tile_signal(C, tc + (mainu + C.bid) / (D / 256)); } }
    ph_moe_combine(C, (float*)(ws + WS_RES), (const float*)(ws + WS_MOD) + (size_t)layer * 18 * D, (const float*)(ws + WS_ARENA + MO_OUT), (const int*)(ws + WS_ARENA + MO_DEST), (const float*)(ws + WS_ARENA + MO_TOKG),
                   last ? args.in[I_FINALG] : nullptr, last ? args.out : nullptr,
                   nx ? args.in[I_NORMG] + (size_t)((layer + 1) * 2) * D : nullptr, nx ? (const float*)(ws + WS_MOD) + (size_t)(layer + 1) * 18 * D : nullptr, nx ? (bf16_t*)(ws + WS_ARENA) : nullptr, ntail > 0 ? tc : nullptr, ntail, pm_main, pm_end);
}

constexpr size_t HG_HB = 0;
constexpr size_t HG_QVG = al256(HG_HB + SZ_ACT_BF);
constexpr size_t HG_FG = al256(HG_QVG + 3 * SZ_ACT_BF);
constexpr size_t HG_O = al256(HG_FG + 2 * SZ_ACT_F32);
constexpr size_t HG_YB = al256(HG_O + 2 * SZ_ACT_F32);
constexpr size_t HG_LB_OLD = al256(HG_YB + SZ_ACT_BF);
constexpr size_t HG_IMG_QT = al256(HG_LB_OLD + 2 * D * 4);
constexpr size_t HG_IMG_PF = HG_IMG_QT + (size_t)HGC_NITEM * 8192;
constexpr size_t HG_IMG_KT = HG_IMG_PF + (size_t)HGC_NITEM * 2048;
constexpr size_t HG_IMG_SC = HG_IMG_KT + (size_t)HGC_NITEM * 8192;
constexpr size_t HG_IMG_VT = HG_IMG_SC + (size_t)HGC_NITEM * 1536;
constexpr size_t HG_END = HG_IMG_VT + (size_t)16 * RNCH * 8192;
static_assert(HG_END <= ARENA_BYTES, "hgrn arena");
__device__ __forceinline__ HgImg hg_img(unsigned char* ws) { HgImg I; unsigned char* a = ws + WS_ARENA; I.QT = (bf16_t*)(a + HG_IMG_QT); I.PF = (v4u*)(a + HG_IMG_PF); I.KT = (bf16_t*)(a + HG_IMG_KT); I.SC = (float*)(a + HG_IMG_SC); I.VT = (bf16_t*)(a + HG_IMG_VT); return I; }
constexpr size_t HGW_WIN = (size_t)202 << 20, HGW_WO = ((size_t)202 << 20) + (size_t)5 * D * D * 2;
__device__ __forceinline__ void hg_cvt(const Ctx& C, const Args& args, unsigned char* ws, int slot) {
    const CvtJob jobs[2] = { {args.in[I_HG_WIN] + (size_t)slot * D * 5 * D, (bf16_t*)(ws + WS_WREG + HGW_WIN), D, 5 * D, 5 * D, D, 0, 0, 5 * D, 0}, {args.in[I_HG_WO] + (size_t)slot * D * D, (bf16_t*)(ws + WS_WREG + HGW_WO), D, D, D, D, 0, 0, D, 0} };
    cvt_run(C, jobs);
}
constexpr size_t WS_HGLB = WS_CTL + 49152;
__device__ __forceinline__ void hg_phase_init(const Ctx& C, const Args& args, unsigned char* ws) { ph_hg_lb(C, args.in[I_HG_LB], 2, (float*)(ws + WS_HGLB)); }
__device__ __forceinline__ void hg_phase_g1(const Ctx& C, unsigned char* ws) {
    SchedPlain S{(const bf16_t*)(ws + WS_ARENA + HG_HB), (const bf16_t*)(ws + WS_WREG + HGW_WIN), D, D, PMT, 5 * D / 256, C.G, C.bid};
    EpiHg E{(bf16_t*)(ws + WS_ARENA + HG_QVG), (float*)(ws + WS_ARENA + HG_FG), (const float*)(ws + WS_HGLB)};
    pg8::gemm_phase(C.lds, D, D, D, S, E);
}
__device__ __forceinline__ void hg_phase_scan(const Ctx& C, const Args& args, unsigned char* ws) {
#ifdef HG_SCAN_OLD
    ph_hg_scan_chunk(C, (const bf16_t*)(ws + WS_ARENA + HG_QVG), (const float*)(ws + WS_ARENA + HG_FG), (float*)(ws + WS_ARENA + HG_O));
#else
    { const HgImg I = hg_img(ws); ph_hgc_scan(C, I, (float*)(ws + WS_ARENA + HG_O)); }
#endif
    if (C.G > 64 && C.bid >= 64) { Ctx C2 = C; C2.bid = C.bid - 64; C2.G = C.G - 64; rw_cvt(C2, args, ws, 1); ff_cvt(C2, args, ws, 2); }
    else if (C.G <= 64) { rw_cvt(C, args, ws, 1); ff_cvt(C, args, ws, 2); }
}
__device__ __forceinline__ void hg_phase_prep(const Ctx& C, unsigned char* ws) { const HgImg I = hg_img(ws); ph_hgc_prep(C, (const bf16_t*)(ws + WS_ARENA + HG_QVG), (const float*)(ws + WS_ARENA + HG_FG), I); }
__device__ __forceinline__ void hg_phase_post(const Ctx& C, const Args& args, unsigned char* ws, int slot) {
    ph_hg_post(C, (const float*)(ws + WS_ARENA + HG_O), (const bf16_t*)(ws + WS_ARENA + HG_QVG + 2 * SZ_ACT_BF), args.in[I_HG_GN] + (size_t)slot * 128, (bf16_t*)(ws + WS_ARENA + HG_YB));
}
__device__ __forceinline__ void hg_phase_wo(const Ctx& C, unsigned char* ws, int layer, int part) {
    if (part < 0) part = tail_split(C) ? 1 : 0;
    SchedPlain S = res_sched(C, (const bf16_t*)(ws + WS_ARENA + HG_YB), (const bf16_t*)(ws + WS_WREG + HGW_WO), D, part);
    EpiRes E{(float*)(ws + WS_RES), (const float*)(ws + WS_MOD) + (size_t)layer * 18 * D, 2, nullptr};
    pg8::gemm_phase(C.lds, D, D, D, S, E);
}

__device__ __forceinline__ void ph_rw_diag(const Ctx& C, unsigned char* ws) {
    unsigned* res = (unsigned*)(ws + WS_CTL) + 8200;
    const size_t gt = (size_t)C.bid * NTHR + C.tid, gs = (size_t)C.G * NTHR;
    const RwcImg I = rw_img(ws);
    const bf16_t* ptr[7] = {I.WP, I.TA, I.ARB, I.BT, I.RT, I.ARK, I.KT};
    const size_t cnt[7] = {(size_t)RW_NCHUNKHEAD * 2048, (size_t)RW_NCHUNKHEAD * 1024, (size_t)RW_NCHUNKHEAD * 1024, (size_t)RW_NCHUNKHEAD * 2048, (size_t)RW_NCHUNKHEAD * 2048, (size_t)RW_NCHUNKHEAD * 1024, (size_t)RW_NCHUNKHEAD * 2048};
#pragma unroll
    for (int q = 0; q < 7; ++q) { float mx = 0.f; const GAS bf16_t* p = (const GAS bf16_t*)ptr[q];
        for (size_t i = gt; i < cnt[q]; i += gs) { const unsigned b = p[i]; const float v = fabsf(bf2f(b)); mx = ((b & 0x7f80u) == 0x7f80u) ? 3.0e38f : fmaxf(mx, v); }
        atomicMax(res + q, __builtin_bit_cast(unsigned, mx)); }
}
enum PhaseId { PH_INIT = 0, PH_RW0_A, PH_RW0_MIX, PH_RW0_G1, PH_RW0_G2, PH_RW0_PREP, PH_RW0_SCAN, PH_RW0_POST, PH_RW0_WO, PH_FF0_A, PH_FF0_G1, PH_FF0_G2,
               PH_HY_A, PH_HY_B, PH_HY_CONV, PH_HY_TR, PH_HY_WO, PH_MO1_A, PH_MO1_B, PH_MO1_G1, PH_MO1_G2, PH_MO1_C,
               PH_HG_A, PH_HG_G1, PH_HG_PREP, PH_HG_SCAN, PH_HG_POST, PH_HG_WO, PH_FF2_A, PH_FF2_G1, PH_FF2_G2,
               PH_RW3_A, PH_RW3_MIX, PH_RW3_G1, PH_RW3_G2, PH_RW3_PREP, PH_RW3_SCAN, PH_RW3_POST, PH_RW3_WO, PH_MO3_A, PH_MO3_B, PH_MO3_G1, PH_MO3_G2, PH_MO3_C, PH_FINAL, N_PHASES };
#define RW_PROGRAM(P, layer, slot) \
    if (IN(P##_A)) { rw_phase_a(C, args, ws, layer, slot); SEAM(P##_A); } \
    if (IN(P##_MIX)) { rw_phase_mix(C, args, ws, layer, slot); SEAM(P##_MIX); } \
    if (IN(P##_G1)) { rw_phase_g1(C, args, ws, layer, slot); SEAM(P##_G1); } \
    if (IN(P##_G2)) { rw_phase_g2(C, args, ws, layer, slot); SEAM(P##_G2); } \
    if (IN(P##_PREP)) { rw_phase_prep(C, args, ws, layer, slot); SEAM(P##_PREP); } \
    if (IN(P##_SCAN)) { rw_phase_scan(C, args, ws, layer, slot); SEAM(P##_SCAN); } \
    if (IN(P##_POST)) { rw_phase_post(C, args, ws, layer, slot); SEAM(P##_POST); } \
    if (IN(P##_WO)) { rw_phase_wo(C, args, ws, layer, slot); SEAM(P##_WO); }
#define HY_PROGRAM \
    if (IN(PH_HY_A)) { hy_phase_a(C, args, ws, 1); SEAM(PH_HY_A); } \
    if (IN(PH_HY_B)) { hy_phase_b(C, args, ws); SEAM(PH_HY_B); } \
    if (IN(PH_HY_CONV)) { ph_hy_conv(C, (const float*)(ws + WS_ARENA + HY_PROJT), (const float*)(ws + WS_ARENA + HY_FILT), args.in[I_HY_CW], args.in[I_HY_CB], args.in[I_HY_SKIP], (float*)(ws + WS_ARENA + HY_YT), (f32x2*)(ws + WS_ARENA + HY_SCR), (void*)(ws + WS_CTL + 32768 + 800)); SEAM(PH_HY_CONV); } \
    if (IN(PH_HY_TR)) { ph_hy_transpose(C, (const float*)(ws + WS_ARENA + HY_YT), (bf16_t*)(ws + WS_ARENA + HY_YB)); SEAM(PH_HY_TR); } \
    if (IN(PH_HY_WO)) { hy_phase_wo(C, args, ws, 1); SEAM(PH_HY_WO); }
#define FF_PROGRAM(P, layer) \
    if (IN(P##_A)) { ff_phase_a(C, args, ws, layer); SEAM(P##_A); } \
    if (IN(P##_G1)) { ff_phase_g1(C, ws); SEAM(P##_G1); } \
    if (IN(P##_G2)) { ff_phase_g2(C, ws, layer); SEAM(P##_G2); }
#define MO_PROGRAM(P, layer) \
    if (IN(P##_A)) { mo_phase_a(C, args, ws, layer); SEAM(P##_A); } \
    if (IN(P##_B)) { mo_phase_b(C, ws, layer); SEAM(P##_B); } \
    if (IN(P##_G1)) { mo_phase_g1(C, ws); SEAM(P##_G1); } \
    if (IN(P##_G2)) { mo_phase_g2(C, ws); SEAM(P##_G2); } \
    if (IN(P##_C)) { mo_phase_c(C, args, ws, layer); if ((layer) != DEPTH - 1) SEAM(P##_C); }
#define HG_PROGRAM \
      \
    if (IN(PH_HG_G1)) { hg_phase_g1(C, ws); SEAM(PH_HG_G1); } \
    if (IN(PH_HG_PREP)) { hg_phase_prep(C, ws); SEAM(PH_HG_PREP); } \
    if (IN(PH_HG_SCAN)) { hg_phase_scan(C, args, ws); SEAM(PH_HG_SCAN); } \
    if (IN(PH_HG_POST)) { hg_phase_post(C, args, ws, 0); SEAM(PH_HG_POST); } \
    if (IN(PH_HG_WO)) { hg_phase_wo(C, ws, 2); SEAM(PH_HG_WO); }
#define PHASE_PROGRAM RW_PROGRAM(PH_RW0, 0, 0) FF_PROGRAM(PH_FF0, 0) HY_PROGRAM MO_PROGRAM(PH_MO1, 1) HG_PROGRAM FF_PROGRAM(PH_FF2, 2) RW_PROGRAM(PH_RW3, 3, 1) MO_PROGRAM(PH_MO3, 3)
#ifndef MK_ONE_LAUNCH
#define MK_ONE_LAUNCH 1
#endif

__global__ void __launch_bounds__(NTHR, 2) mega_fwd(Args args) {
    extern __shared__ __attribute__((aligned(16))) unsigned char lds_raw[];
    Ctx C;
    C.lds = (LAS unsigned char*)lds_raw;
    C.tid = threadIdx.x; C.lane = C.tid & 63; C.wave = __builtin_amdgcn_readfirstlane(C.tid >> 6); C.G = gridDim.x; C.bid = blockIdx.x;
    volatile LAS unsigned* MISC = (volatile LAS unsigned*)(C.lds + LDS_MISC);
    if (C.tid < 64) MISC[C.tid] = 0u;
    __syncthreads();
    unsigned char* ws = args.ws;
    unsigned* ctl = (unsigned*)(ws + WS_CTL);
    XcdBarrier bar; bar.bar = ctl + CW_BAR; bar.x = 0; bar.st = nullptr;
    if (MK_ONE_LAUNCH) bar = xcd_barrier_post(ctl + CW_BAR, MISC + 8);
    const int lo = args.ph_lo, hi = args.ph_hi;
#define IN(k) (lo <= (k) && (k) < hi)
#ifdef PROBE_TS
    unsigned long long* TS = (unsigned long long*)(ws + WS_CTL + 32768);
    if (C.bid == 0 && C.tid == 0) TS[0] = __builtin_amdgcn_s_memrealtime();
#define SEAM(k) do { if (MK_ONE_LAUNCH && IN((k) + 1)) xcd_barrier(bar); else __syncthreads(); if (C.bid == 0 && C.tid == 0) TS[(k) + 1] = __builtin_amdgcn_s_memrealtime(); } while (0)
#else
#define SEAM(k) do { if (MK_ONE_LAUNCH && IN((k) + 1)) xcd_barrier(bar); else __syncthreads(); } while (0)
#endif
    float* RES = (float*)(ws + WS_RES);
    float* MOD = (float*)(ws + WS_MOD);

    if (IN(PH_INIT)) { ph_adaln(C, args.in[I_C], args.in[I_CCTX], args.in[I_ADAW], args.in[I_ADAB], MOD); rw_cvt(C, args, ws, 0); hg_phase_init(C, args, ws); SEAM(PH_INIT); }

    PHASE_PROGRAM

#ifdef PROBE_RWDIAG
    if (IN(PH_FINAL)) { xcd_barrier(bar); const unsigned* r = (const unsigned*)(ws + WS_CTL) + 8200;
        float code = 0.f, best = -1.f; for (int q = 0; q < 7; ++q) { const float lg = fminf(9.f, fmaxf(0.f, log10f(__builtin_bit_cast(float, r[q]) + 1e-30f))); if (lg > best) { best = lg; code = 10.f * (q + 1) + lg; } }
        for (size_t i = (size_t)C.bid * NTHR + C.tid; i < (size_t)NLAT * D; i += (size_t)C.G * NTHR) args.out[i] = (i == 0) ? code : 0.f; }
#endif
#ifdef PROBE_DIFF
    if (C.bid == 0) { __syncthreads(); if (C.tid == 0) { const unsigned* r = (const unsigned*)(ws + WS_CTL) + 8192; const float md = __builtin_bit_cast(float, r[0]), ma = __builtin_bit_cast(float, r[1]);
        asm volatile("s_waitcnt vmcnt(0)" ::: "memory"); args.out[0] = 1.0f + 1000.0f * md / fmaxf(ma, 1e-30f); } }
#endif
#ifdef PROBE_TS
    if (C.bid == 0) { __syncthreads(); if (C.tid == 0) {
#ifdef HY_STAMP
        const unsigned long long d1 = TS[100 + HY_K1], d2 = TS[100 + HY_K2];
#else
        const unsigned long long d1 = TS[PROBE_B1] - TS[PROBE_A1], d2 = TS[PROBE_B2] - TS[PROBE_A2];
#endif
        asm volatile("s_waitcnt vmcnt(0)" ::: "memory");
        args.out[0] = (float)d2 * 1e-4f;
        const unsigned long long t0 = __builtin_amdgcn_s_memrealtime(); while (__builtin_amdgcn_s_memrealtime() - t0 < 4ull * d1) __builtin_amdgcn_s_sleep(8);
    } }
#endif
#undef IN
#undef SEAM
}

extern "C" void kernel_launch(void* const* d_in, const int* in_sizes, int n_in, void* d_out, int out_size, void* d_ws, size_t ws_size, hipStream_t stream) {
    static int grid = 0;
    if (grid == 0) {
        if (n_in != N_IN || out_size != NLAT * D || ws_size < WS_END) { fprintf(stderr, "kernel_launch: unexpected shapes (n_in %d out %d ws %zu need %zu)\n", n_in, out_size, ws_size, (size_t)WS_END); grid = -1; return; }
        int dev = 0, cus = 0, per_cu = 0;
        if (hipGetDevice(&dev) != hipSuccess || hipDeviceGetAttribute(&cus, hipDeviceAttributeMultiprocessorCount, dev) != hipSuccess) { grid = -1; return; }
        if (hipFuncSetAttribute((const void*)mega_fwd, hipFuncAttributeMaxDynamicSharedMemorySize, LDS_BYTES) != hipSuccess) { fprintf(stderr, "kernel_launch: hipFuncSetAttribute failed\n"); grid = -1; return; }
        if (hipOccupancyMaxActiveBlocksPerMultiprocessor(&per_cu, (const void*)mega_fwd, NTHR, LDS_BYTES) != hipSuccess || per_cu < 1) { fprintf(stderr, "kernel_launch: occupancy query says %d\n", per_cu); }
        (void)hipGetLastError();
        grid = cus;
    }
    if (grid < 0) return;
    (void)hipMemsetAsync((char*)d_ws + WS_CTL, 0, CTL_BYTES + ZREG_BYTES, stream);
    Args a{};
    for (int i = 0; i < N_IN; ++i) a.in[i] = (const float*)d_in[i];
    a.out = (float*)d_out; a.ws = (unsigned char*)d_ws;
#if MK_ONE_LAUNCH
    a.ph_lo = 0; a.ph_hi = N_PHASES;
    hipLaunchKernelGGL(mega_fwd, dim3(grid), dim3(NTHR), LDS_BYTES, stream, a);
#else
    for (int p = 0; p < N_PHASES; ++p) { a.ph_lo = p; a.ph_hi = p + 1; hipLaunchKernelGGL(mega_fwd, dim3(grid), dim3(NTHR), LDS_BYTES, stream, a); }
#endif
}
```

```cpp
#include <hip/hip_runtime.h>
#include <cstdio>
#include <cstdint>

#define GAS __attribute__((address_space(1)))
#define LAS __attribute__((address_space(3)))
typedef unsigned short bf16_t;
typedef unsigned v4u __attribute__((ext_vector_type(4)));
typedef unsigned v2u __attribute__((ext_vector_type(2)));
typedef float f32x4 __attribute__((ext_vector_type(4)));
typedef float f32x2 __attribute__((ext_vector_type(2)));
typedef short bf16x8 __attribute__((ext_vector_type(8)));
typedef GAS unsigned gu32;
#define RLX_AGENT __ATOMIC_RELAXED, __HIP_MEMORY_SCOPE_AGENT
#define LDS_WAIT() asm volatile("s_waitcnt lgkmcnt(0)" ::: "memory")
#define VM_WAIT() asm volatile("s_waitcnt vmcnt(0)" ::: "memory")

constexpr int D = 1024, NB = 2, SEQ = 16384, CTXL = 256, GRIDW = 64;
constexpr int NCTX = NB * CTXL;
constexpr int NLAT = NB * SEQ;
constexpr int MROWS = NCTX + NLAT;
constexpr int PMT = MROWS / 256;
constexpr int DEPTH = 4;
constexpr int FFN = 2816, NEXP = 8, EDIM = 3584;
constexpr int NWAVES = 8, NTHR = 512;
constexpr float NORM_EPS = 1e-6f;

__device__ __forceinline__ unsigned f2bf(float f) { unsigned u = __builtin_bit_cast(unsigned, f); return (u + 0x7fffu + ((u >> 16) & 1u)) >> 16; }
typedef __bf16 bf16x2_t __attribute__((ext_vector_type(2)));
__device__ __forceinline__ unsigned pk2(float lo, float hi) { const bf16x2_t v = __builtin_convertvector((f32x2){lo, hi}, bf16x2_t); return __builtin_bit_cast(unsigned, v); }
__device__ __forceinline__ float bf2f(unsigned b) { return __builtin_bit_cast(float, b << 16); }
__device__ __forceinline__ float bflo(unsigned w) { return __builtin_bit_cast(float, w << 16); }
__device__ __forceinline__ float bfhi(unsigned w) { return __builtin_bit_cast(float, w & 0xffff0000u); }
__device__ __forceinline__ float sigmoidf_(float x) { return 1.0f / (1.0f + __expf(-x)); }
__device__ __forceinline__ float siluf_(float x) { return x / (1.0f + __expf(-x)); }
__device__ __forceinline__ float wave_sum(float v) {
#pragma unroll
    for (int o = 1; o < 64; o <<= 1) v += __shfl_xor(v, o);
    return v;
}
__device__ __forceinline__ int row_bidx(int r) { return r < NCTX ? 0 : 1 + ((r - NCTX) >> 14); }

#define XB_TMO      128
#define XB_XCNT(j)  (256  + 64 * (j))
#define XB_XSUB(j)  (1280 + 64 * (j))
#define XB_XGEN(j)  (2304 + 64 * (j))
#define XB_TOP      3328
#define XB_TOPGEN   3392
#define XCD_BAR_WORDS 3456
#define XB_SPIN_CAP (1u << 20)

__device__ __forceinline__ unsigned xb_ld(unsigned* p)              { return __hip_atomic_load(p, __ATOMIC_RELAXED, __HIP_MEMORY_SCOPE_AGENT); }
__device__ __forceinline__ unsigned xb_add(unsigned* p, unsigned v) { return __hip_atomic_fetch_add(p, v, __ATOMIC_RELAXED, __HIP_MEMORY_SCOPE_AGENT); }
__device__ __forceinline__ unsigned xb_xcc_id() { return (unsigned)__builtin_amdgcn_s_getreg((3 << 11) | 20) & 0xFu; }
#define XB_SPIN(cond, bar) do { unsigned _sp = 0; while (cond) { __builtin_amdgcn_s_sleep(1); \
    if ((++_sp & 255u) == 0u) { if (xb_ld(&(bar)[XB_TMO])) break; if (_sp > XB_SPIN_CAP) { atomicAdd(&(bar)[XB_TMO], 1u); break; } } } } while (0)

struct XcdBarrier { unsigned* bar; unsigned x; volatile LAS unsigned* st; };

__device__ __forceinline__ XcdBarrier xcd_barrier_post(unsigned* bar, volatile LAS unsigned* st) {
    XcdBarrier b; b.bar = bar; b.x = xb_xcc_id(); b.st = st;
    if (threadIdx.x == 0) (void)xb_add(&bar[XB_XCNT(b.x)], 1u);
    return b;
}
__device__ __forceinline__ void xcd_barrier_complete(unsigned* bar, unsigned x, unsigned& nloc, unsigned& nx) {
    const unsigned G = gridDim.x * gridDim.y * gridDim.z;
    unsigned sum, cnt, mine, sp = 0u;
    for (;;) {
        sum = 0u; cnt = 0u; mine = 0u;
#pragma unroll
        for (unsigned j = 0; j < 16; ++j) { const unsigned c = xb_ld(&bar[XB_XCNT(j)]); sum += c; cnt += (c > 0u) ? 1u : 0u; mine = (j == x) ? c : mine; }
        if (sum == G) break;
        __builtin_amdgcn_s_sleep(1);
        if ((++sp & 255u) == 0u) { if (xb_ld(&bar[XB_TMO])) break; if (sp > XB_SPIN_CAP) { atomicAdd(&bar[XB_TMO], 1u); break; } }
    }
    nloc = mine > 0u ? mine : 1u; nx = cnt > 0u ? cnt : 1u;
}
__device__ __forceinline__ void xcd_barrier(const XcdBarrier& b) {
    asm volatile("s_waitcnt vmcnt(0)" ::: "memory");
    __syncthreads();
    if (threadIdx.x == 0) {
        unsigned* bar = b.bar;
        __builtin_amdgcn_s_waitcnt(0);
        unsigned nloc = b.st[0], nx = b.st[1];
        if (nloc == 0u) { xcd_barrier_complete(bar, b.x, nloc, nx); b.st[0] = nloc; b.st[1] = nx; }
        const unsigned old = xb_add(&bar[XB_XSUB(b.x)], 1u);
        const unsigned gen = old / nloc;
        if (old + 1u == (gen + 1u) * nloc) {
            __builtin_amdgcn_fence(__ATOMIC_RELEASE, "agent");
            asm volatile("s_waitcnt vmcnt(0)" ::: "memory");
            const unsigned og = xb_add(&bar[XB_TOP], 1u);
            const unsigned tg = og / nx;
            if (og + 1u == (tg + 1u) * nx) xb_add(&bar[XB_TOPGEN], 1u);
            else XB_SPIN(xb_ld(&bar[XB_TOPGEN]) == tg, bar);
            __builtin_amdgcn_fence(__ATOMIC_ACQUIRE, "agent");
            xb_add(&bar[XB_XGEN(b.x)], 1u);
            asm volatile("s_waitcnt vmcnt(0)" ::: "memory");
        } else {
            XB_SPIN(xb_ld(&bar[XB_XGEN(b.x)]) == gen, bar);
            __builtin_amdgcn_fence(__ATOMIC_ACQUIRE, "agent");
            asm volatile("s_waitcnt vmcnt(0)" ::: "memory");
        }
    }
    __syncthreads();
}
namespace pg8 {
constexpr int BM = 256, BK = 64, HALF = 128, HTB = HALF * BK * 2, STAGE_BYTES = 8 * HTB, NXCD = 8, WGM = 8;
__host__ __device__ __forceinline__ int lds_byte(int r, int c) { const int st = (r >> 4) * 2 + (c >> 5), rr = r & 15, cc = c & 31, ob = rr * 64 + cc * 2; return st * 1024 + (ob ^ (((ob >> 9) & 1) << 5)); }
__host__ __device__ __forceinline__ void stage_rc(int b, int& R, int& C) { const int st = b / 1024, sb = b % 1024, swz = sb ^ (((sb >> 9) & 1) << 5); R = (st >> 1) * 16 + swz / 64; C = (st & 1) * 32 + (swz % 64) / 2; }
__host__ __device__ __forceinline__ int perm32(int rho) { const int n = rho >> 4, i = rho & 15; return 8 * (i >> 2) + 4 * n + (i & 3); }

struct Unit { int pm, pn, aux; };

__device__ __forceinline__ bool static_unit(int nM, int nN, int G, int c, int i, int& pm, int& pn) {
    const int nwg = nM * nN; const long L = (long)i * G + c; if (L >= nwg) return false;
    int wgid = (int)L; { const int q = nwg / NXCD, r = nwg % NXCD, xcd = wgid % NXCD, off = wgid / NXCD; wgid = (xcd < r ? xcd * (q + 1) : r * (q + 1) + (xcd - r) * q) + off; }
    const int nig = WGM * nN, gid = wgid / nig, fm = gid * WGM, gsz = (nM - fm) < WGM ? (nM - fm) : WGM;
    pm = fm + ((wgid % nig) % gsz); pn = (wgid % nig) / gsz; return true;
}

__device__ __forceinline__ unsigned cvt_pk_bf16(float lo, float hi) { unsigned r; asm volatile("v_cvt_pk_bf16_f32 %0, %1, %2" : "=v"(r) : "v"(lo), "v"(hi)); return r; }

template <class Epi, class Sched>
__device__ __forceinline__ void gemm_phase(LAS unsigned char* lds, const int K_, const int lda, const int ldb, const Sched& S, const Epi& E) {
    int K = K_; asm volatile("" : "+s"(K));
    const int tid = threadIdx.x, wid = __builtin_amdgcn_readfirstlane(tid >> 6), lane = tid & 63, wr = wid >> 2, wc = wid & 3, fr = lane & 15, fq = lane >> 4;
    const int nt = K / BK;
    unsigned voffA[2], voffB[2];
#pragma unroll
    for (int i = 0; i < 2; ++i) { int R, C; stage_rc(tid * 16 + i * 8192, R, C); const int Rb = Epi::PERM ? ((R & ~31) + perm32(R & 31)) : R;
        voffA[i] = (unsigned)(R * lda + C) * 2u; voffB[i] = (unsigned)(Rb * ldb + C) * 2u; }
    const size_t kstep = (size_t)(BK * 2);
    const size_t hstepA = (size_t)HALF * lda * 2, hstepB = (size_t)HALF * ldb * 2;
    const unsigned ldsw = (unsigned)wid * 1024u;
    const int aoff = lds_byte(wr * 64 + fr, fq * 8), boff = lds_byte(wc * 32 + fr, fq * 8);
#define PG8_SA(b, h) (((b) * 2 + (h)) * HTB)
#define PG8_SB(b, h) ((4 + (b) * 2 + (h)) * HTB)
#define PG8_STAGE(bufoff, gbase, voff) do { _Pragma("unroll") for (int _i = 0; _i < 2; ++_i) \
        __builtin_amdgcn_global_load_lds((const GAS unsigned*)((const char*)(gbase) + (voff)[_i]), (LAS unsigned*)(lds + (bufoff) + ldsw + _i * 8192), 16, 0, 0); } while (0)
#define PG8_LDA(dst, b, h) do { _Pragma("unroll") for (int m = 0; m < 4; ++m) _Pragma("unroll") for (int k = 0; k < 2; ++k) dst[m][k] = *(const LAS bf16x8*)(lds + PG8_SA(b, h) + aoff + m * 2048 + k * 1024); } while (0)
#define PG8_LDB(dst, b, h) do { _Pragma("unroll") for (int n = 0; n < 2; ++n) _Pragma("unroll") for (int k = 0; k < 2; ++k) dst[n][k] = *(const LAS bf16x8*)(lds + PG8_SB(b, h) + boff + n * 2048 + k * 1024); } while (0)
#define PG8_MMA(ai, bj, At, Bt) do { __builtin_amdgcn_s_setprio(1); _Pragma("unroll") for (int m = 0; m < 4; ++m) _Pragma("unroll") for (int n = 0; n < 2; ++n) _Pragma("unroll") for (int k = 0; k < 2; ++k) \
        acc[ai][bj][m][n] = __builtin_amdgcn_mfma_f32_16x16x32_bf16(Bt[n][k], At[m][k], acc[ai][bj][m][n], 0, 0, 0); __builtin_amdgcn_s_setprio(0); } while (0)
#define PG8_WAIT_V(n) asm volatile("s_waitcnt vmcnt(" #n ")" ::: "memory")
#define PG8_WAIT_L(n) asm volatile("s_waitcnt lgkmcnt(" #n ")" ::: "memory")
#define PG8_BAR __builtin_amdgcn_s_barrier()
#define PG8_SCHED __builtin_amdgcn_sched_barrier(0)
    Unit cur, nxt; int ui = 0;
    if (!S.next(0, cur)) return;
    f32x4 acc[2][2][4][2];
#pragma unroll
    for (int a = 0; a < 2; ++a)
#pragma unroll
        for (int b = 0; b < 2; ++b)
#pragma unroll
            for (int m = 0; m < 4; ++m)
#pragma unroll
                for (int n = 0; n < 2; ++n) acc[a][b][m][n] = (f32x4){0.f, 0.f, 0.f, 0.f};
    bf16x8 At[4][2], B0[2][2], B1[2][2];
    const char* cA = S.a_ptr(cur); const char* cB = S.b_ptr(cur);
    PG8_STAGE(PG8_SB(0, 0), cB, voffB); PG8_STAGE(PG8_SA(0, 0), cA, voffA); PG8_STAGE(PG8_SB(0, 1), cB + hstepB, voffB); PG8_STAGE(PG8_SA(0, 1), cA + hstepA, voffA);
    if (wr == 1) PG8_BAR;
    PG8_WAIT_V(4); PG8_BAR;
    PG8_STAGE(PG8_SB(1, 0), cB + kstep, voffB); PG8_STAGE(PG8_SA(1, 0), cA + kstep, voffA); PG8_STAGE(PG8_SB(1, 1), cB + hstepB + kstep, voffB);
    PG8_WAIT_V(6); PG8_BAR;
    for (;;) {
        const bool has_next = S.next(ui + 1, nxt);
        const char* nA = has_next ? S.a_ptr(nxt) : cA; const char* nB = has_next ? S.b_ptr(nxt) : cB;
#pragma unroll 1
        for (int t = 0; t < nt; t += 2) {
            const bool last = (t == nt - 2);
            const char* a1 = cA + (size_t)(t + 1) * kstep;
            const char* a2 = last ? nA : cA + (size_t)(t + 2) * kstep; const char* b2 = last ? nB : cB + (size_t)(t + 2) * kstep;
            const char* a3 = a2 + kstep; const char* b3 = b2 + kstep;
            PG8_LDB(B0, 0, 0); PG8_SCHED; PG8_LDA(At, 0, 0); PG8_STAGE(PG8_SA(1, 1), a1 + hstepA, voffA);
            PG8_WAIT_L(8); PG8_BAR; PG8_WAIT_L(0); PG8_MMA(0, 0, At, B0); PG8_BAR; PG8_SCHED;
            PG8_LDB(B1, 0, 1); PG8_STAGE(PG8_SB(0, 0), b2, voffB);
            PG8_BAR; PG8_WAIT_L(0); PG8_MMA(0, 1, At, B1); PG8_BAR;
            PG8_LDA(At, 0, 1); PG8_STAGE(PG8_SA(0, 0), a2, voffA);
            PG8_BAR; PG8_WAIT_L(0); PG8_MMA(1, 0, At, B0); PG8_BAR; PG8_SCHED;
            PG8_STAGE(PG8_SB(0, 1), b2 + hstepB, voffB);
            PG8_WAIT_V(6); PG8_BAR; PG8_MMA(1, 1, At, B1); PG8_BAR;
            PG8_LDB(B0, 1, 0); PG8_SCHED; PG8_LDA(At, 1, 0); PG8_STAGE(PG8_SA(0, 1), a2 + hstepA, voffA);
            PG8_WAIT_L(8); PG8_BAR; PG8_WAIT_L(0); PG8_MMA(0, 0, At, B0); PG8_BAR; PG8_SCHED;
            PG8_LDB(B1, 1, 1); PG8_STAGE(PG8_SB(1, 0), b3, voffB);
            PG8_BAR; PG8_WAIT_L(0); PG8_MMA(0, 1, At, B1); PG8_BAR;
            PG8_LDA(At, 1, 1); PG8_STAGE(PG8_SA(1, 0), a3, voffA);
            PG8_BAR; PG8_WAIT_L(0); PG8_MMA(1, 0, At, B0); PG8_BAR; PG8_SCHED;
            PG8_STAGE(PG8_SB(1, 1), b3 + hstepB, voffB);
            PG8_WAIT_V(6); PG8_BAR; PG8_MMA(1, 1, At, B1); PG8_BAR;
        }
        E(acc, cur, wr, wc, fr, fq);
        if (!has_next) break;
#pragma unroll
        for (int a = 0; a < 2; ++a)
#pragma unroll
            for (int b = 0; b < 2; ++b)
#pragma unroll
                for (int m = 0; m < 4; ++m)
#pragma unroll
                    for (int n = 0; n < 2; ++n) acc[a][b][m][n] = (f32x4){0.f, 0.f, 0.f, 0.f};
        cur = nxt; cA = nA; cB = nB; ++ui;
    }
    PG8_WAIT_V(0);
    if (wr == 0) PG8_BAR;
    PG8_BAR;
#undef PG8_SA
#undef PG8_SB
#undef PG8_STAGE
#undef PG8_LDA
#undef PG8_LDB
#undef PG8_MMA
#undef PG8_WAIT_V
#undef PG8_WAIT_L
#undef PG8_BAR
#undef PG8_SCHED
}
}
using pg8::Unit;
constexpr size_t al256(size_t x) { return (x + 255) & ~(size_t)255; }
constexpr size_t SZ_ACT_BF = (size_t)MROWS * D * 2;
constexpr size_t SZ_ACT_F32 = (size_t)MROWS * D * 4;
constexpr size_t WS_CTL = 0, CTL_BYTES = 65536;
constexpr size_t WS_ZREG = WS_CTL + CTL_BYTES;
constexpr size_t Z_LDN = 0;
constexpr size_t Z_LUP = Z_LDN + (size_t)1024 * 1024 * 2;
constexpr size_t Z_SLOT = Z_LUP + (size_t)6144 * 256 * 2;
constexpr size_t Z_AW = 2 * Z_SLOT;
constexpr size_t ZREG_BYTES = al256(Z_AW + (size_t)4096 * 256 * 2);
constexpr size_t WS_MOD = WS_ZREG + ZREG_BYTES;
constexpr size_t WS_RSTD = WS_MOD + al256((size_t)DEPTH * 3 * 6 * D * 4);
constexpr size_t WS_RES = WS_RSTD + al256((size_t)MROWS * 4);
constexpr size_t WS_VFIRST = WS_RES + SZ_ACT_F32;
constexpr size_t WS_WREG = WS_VFIRST + SZ_ACT_BF;
constexpr size_t WREG_BYTES = (size_t)216 * 1024 * 1024;
constexpr size_t WS_ARENA = WS_WREG + WREG_BYTES;
constexpr size_t ARENA_BYTES = (size_t)1400 * 1000 * 1000;
constexpr size_t WS_END = WS_ARENA + ARENA_BYTES;

constexpr int CW_BAR = 0;
constexpr int CW_MOE = 4096;
constexpr int CW_TC = 14336;
constexpr int TAILB = 8;

constexpr int LDS_MAIN = 139264;
constexpr int LDS_MISC = LDS_MAIN;
constexpr int LDS_BYTES = LDS_MAIN + 256;

struct Args { const float* in[51]; float* out; unsigned char* ws; int ph_lo, ph_hi; };

enum InIdx { I_X = 0, I_C, I_CTX, I_CCTX, I_NORMG, I_ADAW, I_ADAB, I_FINALG, I_RW_MU, I_RW_WRKV, I_RW_WO, I_RW_W0, I_RW_W1, I_RW_W2, I_RW_A0, I_RW_A1, I_RW_A2,
             I_RW_V0, I_RW_V1, I_RW_V2, I_RW_G1, I_RW_G2, I_RW_KK, I_RW_KA, I_RW_RK, I_RW_LNW, I_RW_LNB, I_HY_WIN, I_HY_BIN, I_HY_CW, I_HY_CB, I_HY_FW1, I_HY_FB1,
             I_HY_FW2, I_HY_FB2, I_HY_FW3, I_HY_FB3, I_HY_FW4, I_HY_FREQ, I_HY_SKIP, I_HY_WO, I_HY_BO, I_HG_WIN, I_HG_LB, I_HG_GN, I_HG_WO, I_FFN_W13, I_FFN_W2,
             I_MOE_ROUTER, I_MOE_W13, I_MOE_W2, N_IN };

struct Ctx {
    LAS unsigned char* lds;
    int tid, lane, wave, G, bid;
};

__device__ __forceinline__ void ph_init_res(const Ctx& C, const float* x, const float* ctx, float* res) {
    const size_t nctx4 = (size_t)NCTX * D / 4, n4 = (size_t)MROWS * D / 4;
    const GAS f32x4* c4 = (const GAS f32x4*)ctx; const GAS f32x4* x4 = (const GAS f32x4*)x; GAS f32x4* r4 = (GAS f32x4*)res;
    for (size_t i = (size_t)C.bid * NTHR + C.tid; i < n4; i += (size_t)C.G * NTHR) r4[i] = i < nctx4 ? c4[i] : x4[i - nctx4];
}

struct ResSrc { const float* res; const float* x; const float* ctx; };
__device__ __forceinline__ const float* res_row(const ResSrc& s, int r) { return s.x == nullptr ? s.res + (size_t)r * D : (r < NCTX ? s.ctx + (size_t)r * D : s.x + (size_t)(r - NCTX) * D); }

__device__ __forceinline__ void ph_adaln(const Ctx& C, const float* c, const float* c_ctx, const float* ada_w, const float* ada_b, float* mod) {
    LAS float* sv = (LAS float*)C.lds;
    LAS float* red = sv + 3 * D;
    for (int i = C.tid; i < 3 * D; i += NTHR) { const int b = i / D, k = i % D; const float v = (b == 0) ? c_ctx[k] : c[(b - 1) * D + k]; sv[i] = siluf_(v); }
    __syncthreads();
    const int NITEM = DEPTH * (6 * D / 32);
    const int col = C.tid & 31, ks = C.tid >> 5;
    for (int it = C.bid; it < NITEM; it += C.G) {
        const int layer = it / (6 * D / 32), cb = it % (6 * D / 32);
        const GAS float* W = (const GAS float*)ada_w + (size_t)layer * D * 6 * D + cb * 32 + col;
        float a0 = 0.f, a1 = 0.f, a2 = 0.f;
#pragma unroll 16
        for (int k = ks * 64; k < ks * 64 + 64; ++k) { const float w = W[(size_t)k * 6 * D]; a0 += sv[k] * w; a1 += sv[D + k] * w; a2 += sv[2 * D + k] * w; }
        red[(ks * 3 + 0) * 32 + col] = a0; red[(ks * 3 + 1) * 32 + col] = a1; red[(ks * 3 + 2) * 32 + col] = a2;
        __syncthreads();
        if (C.tid < 96) { const int b = C.tid / 32, cc = C.tid % 32; float s = 0.f;
#pragma unroll
            for (int q = 0; q < 16; ++q) s += red[(q * 3 + b) * 32 + cc];
            const int n = cb * 32 + cc;
            mod[((size_t)(layer * 3 + b) * 6 * D) + n] = s + ada_b[(size_t)layer * 6 * D + n]; }
        __syncthreads();
    }
}

__device__ __forceinline__ void load_row(const float* row, int lane, f32x4 (&v)[4]) {
    const GAS f32x4* p = (const GAS f32x4*)row + lane;
#pragma unroll
    for (int j = 0; j < 4; ++j) v[j] = p[64 * j];
}
__device__ __forceinline__ float row_rstd(const f32x4 (&v)[4]) {
    float s = 0.f;
#pragma unroll
    for (int j = 0; j < 4; ++j) s += (v[j].x * v[j].x + v[j].y * v[j].y) + (v[j].z * v[j].z + v[j].w * v[j].w);
    return 1.0f / sqrtf(wave_sum(s) * (1.0f / D) + NORM_EPS);
}

struct RowIt { int r0, r1, step; };
__device__ __forceinline__ bool tail_split(const Ctx& C) { return C.G >= 64; }
__device__ __forceinline__ RowIt row_part(const Ctx& C, bool split) {
    RowIt it;
    if (!split) { it.r0 = C.bid * NWAVES + C.wave; it.r1 = MROWS; it.step = C.G * NWAVES; }
    else if (C.bid < TAILB) { it.r0 = C.bid * NWAVES + C.wave; it.r1 = NCTX; it.step = TAILB * NWAVES; }
    else { it.r0 = NCTX + (C.bid - TAILB) * NWAVES + C.wave; it.r1 = MROWS; it.step = (C.G - TAILB) * NWAVES; }
    return it;
}
__device__ __forceinline__ void tile_signal(const Ctx& C, unsigned* tc) {
    asm volatile("s_waitcnt vmcnt(0)" ::: "memory");
    __syncthreads();
    if (C.tid == 0) { __builtin_amdgcn_fence(__ATOMIC_RELEASE, "agent"); asm volatile("s_waitcnt vmcnt(0)" ::: "memory"); (void)__hip_atomic_fetch_add(tc, 1u, __ATOMIC_RELAXED, __HIP_MEMORY_SCOPE_AGENT); }
    __syncthreads();
}
__device__ __forceinline__ void tile_wait(unsigned* tc, unsigned need) {
    unsigned sp = 0;
    while (__hip_atomic_load(tc, __ATOMIC_RELAXED, __HIP_MEMORY_SCOPE_AGENT) < need) { __builtin_amdgcn_s_sleep(2); if (++sp > (1u << 22)) break; }
    __builtin_amdgcn_fence(__ATOMIC_ACQUIRE, "agent");
}

__device__ __forceinline__ void tile_wait_block(const Ctx& C, unsigned* tc, int ntile, unsigned need) {
    __syncthreads();
    if (C.tid == 0) { for (int t = 0; t < ntile; ++t) { unsigned sp = 0; while (__hip_atomic_load(tc + t, __ATOMIC_RELAXED, __HIP_MEMORY_SCOPE_AGENT) < need) { __builtin_amdgcn_s_sleep(2); if (++sp > (1u << 22)) break; } }
        __builtin_amdgcn_fence(__ATOMIC_ACQUIRE, "agent"); asm volatile("s_waitcnt vmcnt(0)" ::: "memory"); }
    __syncthreads();
}

__device__ __forceinline__ void ph_rstd(const Ctx& C, const ResSrc& src, float* rstd, unsigned* tc = nullptr) {
    const bool split = tc != nullptr; const RowIt it = row_part(C, split);
    for (int r = it.r0; r < it.r1; r += it.step) { f32x4 v[4]; load_row(res_row(src, r), C.lane, v); const float s = row_rstd(v); if (C.lane == 0) rstd[r] = s; }
}

__device__ __forceinline__ void ph_norm_mod_bf16(const Ctx& C, const float* res, const float* g, const float* modl, int i_shift, int i_scale, bf16_t* hb, unsigned* tc = nullptr) {
    const bool split = tc != nullptr; const RowIt it = row_part(C, split);
    for (int r = it.r0; r < it.r1; r += it.step) {
        f32x4 v[4]; load_row(res + (size_t)r * D, C.lane, v); const float s = row_rstd(v);
        const int b = row_bidx(r);
        const GAS f32x4* g4 = (const GAS f32x4*)g + C.lane; const GAS f32x4* sh4 = (const GAS f32x4*)(modl + (size_t)(b * 6 + i_shift) * D) + C.lane; const GAS f32x4* sc4 = (const GAS f32x4*)(modl + (size_t)(b * 6 + i_scale) * D) + C.lane;
        GAS v2u* o = (GAS v2u*)(hb + (size_t)r * D) + C.lane;
#pragma unroll
        for (int j = 0; j < 4; ++j) { const f32x4 gg = g4[64 * j], sh = sh4[64 * j], sc = sc4[64 * j];
            const f32x4 h = v[j] * s * gg * (sc + 1.0f) + sh;
            v2u w; w.x = pk2(h.x, h.y); w.y = pk2(h.z, h.w); o[64 * j] = w; }
    }
}

__device__ __forceinline__ void ph_final(const Ctx& C, const float* res, const float* g, float* out) {
    const int gw = C.bid * NWAVES + C.wave, NGW = C.G * NWAVES;
    for (int r = gw; r < NLAT; r += NGW) {
        f32x4 v[4]; load_row(res + (size_t)(NCTX + r) * D, C.lane, v); const float s = row_rstd(v);
        const GAS f32x4* g4 = (const GAS f32x4*)g + C.lane; GAS f32x4* o = (GAS f32x4*)(out + (size_t)r * D) + C.lane;
#pragma unroll
        for (int j = 0; j < 4; ++j) o[64 * j] = v[j] * s * g4[64 * j];
    }
}

struct CvtJob { const float* src; bf16_t* dst; int K, N, sld, ldd, roff, coff, nseg, nstride; };
__device__ __forceinline__ void cvt_wave_load(const CvtJob& j, int item, int lane, float (&v)[32]) {
    const int nb = (j.N + 31) / 32, k0 = (item / nb) * 64, n0 = (item % nb) * 32, nn = lane & 31, kh = lane >> 5;
#pragma unroll
    for (int q = 0; q < 32; ++q) { const int k = k0 + 2 * q + kh, n = n0 + nn; v[q] = (k < j.K && n < j.N) ? ((const GAS float*)j.src)[(size_t)k * j.sld + n] : 0.f; }
}
__device__ __forceinline__ void cvt_wave_emit(LAS float* t, const CvtJob& j, int item, int lane, const float (&v)[32]) {
    const int nb = (j.N + 31) / 32, k0 = (item / nb) * 64, n0 = (item % nb) * 32, nn = lane & 31, kh = lane >> 5;
#pragma unroll
    for (int q = 0; q < 32; ++q) t[(2 * q + kh) * 33 + nn] = v[q];
    asm volatile("s_waitcnt lgkmcnt(0)" ::: "memory");
    const int c = lane & 7;
#pragma unroll
    for (int q = 0; q < 4; ++q) { const int n_ = (lane >> 3) + 8 * q, n = n0 + n_, k = k0 + 8 * c; const LAS float* s_ = t + (8 * c) * 33 + n_;
        if (n < j.N && k < j.K) { const int r = j.roff + (n / j.nseg) * j.nstride + (n % j.nseg);
            v4u o; o.x = pk2(s_[0], s_[33]); o.y = pk2(s_[66], s_[99]); o.z = pk2(s_[132], s_[165]); o.w = pk2(s_[198], s_[231]);
            *(GAS v4u*)(j.dst + (size_t)r * j.ldd + j.coff + k) = o; } }
    asm volatile("s_waitcnt lgkmcnt(0)" ::: "memory");
}
__device__ __forceinline__ int cvt_items(const CvtJob& j) { return ((j.K + 63) / 64) * ((j.N + 31) / 32); }
template <int NJ> __device__ __forceinline__ void cvt_run(const Ctx& C, const CvtJob (&jobs)[NJ]) {
    LAS float* t = (LAS float*)C.lds + C.wave * (64 * 33);
    const int gw = C.bid * NWAVES + C.wave, NGW = C.G * NWAVES;
    int base = 0;
#pragma unroll
    for (int q = 0; q < NJ; ++q) { const int ni = cvt_items(jobs[q]);
        const int first = (gw - base % NGW + NGW) % NGW;
        for (int it = first; it < ni; it += NGW) { float v[32]; cvt_wave_load(jobs[q], it, C.lane, v); cvt_wave_emit(t, jobs[q], it, C.lane, v); }
        base += ni; }
}
struct SchedPlain {
    const bf16_t* A; const bf16_t* Bt; int lda, ldb, nM, nN, G, c; int pm0 = 0, pn0 = 0;
    __device__ __forceinline__ bool next(int i, Unit& u) const { const bool ok = pg8::static_unit(nM, nN, G, c, i, u.pm, u.pn); u.pm += pm0; u.pn += pn0; u.aux = u.pn; return ok; }
    __device__ __forceinline__ const char* a_ptr(const Unit& u) const { return (const char*)(A + (size_t)u.pm * 256 * lda); }
    __device__ __forceinline__ const char* b_ptr(const Unit& u) const { return (const char*)(Bt + (size_t)u.pn * 256 * ldb); }
};

typedef f32x4 AccT[2][2][4][2];

struct EpiF32RowBias {
    static constexpr bool PERM = false;
    float* Cp; int ldc; const float* rbias;
    __device__ __forceinline__ void operator()(const AccT& acc, const Unit& u, int wr, int wc, int fr, int fq) const {
        const int row0 = u.pm * 256 + wr * 64 + fr, col0 = u.aux * 256 + wc * 32 + 4 * fq;
#pragma unroll
        for (int ai = 0; ai < 2; ++ai)
#pragma unroll
            for (int m = 0; m < 4; ++m) { const int row = row0 + ai * 128 + m * 16; const float b = rbias ? rbias[row] : 0.f; GAS float* rowp = (GAS float*)Cp + (size_t)row * ldc + col0;
#pragma unroll
                for (int bj = 0; bj < 2; ++bj)
#pragma unroll
                    for (int n = 0; n < 2; ++n) *(GAS f32x4*)(rowp + bj * 128 + n * 16) = acc[ai][bj][m][n] + b; }
    }
};

struct EpiRes {
    static constexpr bool PERM = false;
    float* res; const float* modl; int gi; const float* bias; const float* in_x = nullptr; const float* in_ctx = nullptr;
    __device__ __forceinline__ void operator()(const AccT& acc, const Unit& u, int wr, int wc, int fr, int fq) const {
        const int row0 = u.pm * 256 + wr * 64 + fr, col0 = u.pn * 256 + wc * 32 + 4 * fq;
        const int b = u.pm < 2 ? 0 : (u.pm < 66 ? 1 : 2);
        const GAS float* gate = (const GAS float*)modl + (size_t)(b * 6 + gi) * D;
        f32x4 gv[2][2], bv[2][2];
#pragma unroll
        for (int bj = 0; bj < 2; ++bj)
#pragma unroll
            for (int n = 0; n < 2; ++n) { gv[bj][n] = *(const GAS f32x4*)(gate + col0 + bj * 128 + n * 16); bv[bj][n] = bias ? *(const GAS f32x4*)((const GAS float*)bias + col0 + bj * 128 + n * 16) : (f32x4){0.f, 0.f, 0.f, 0.f}; }
#pragma unroll
        for (int ai = 0; ai < 2; ++ai)
#pragma unroll
            for (int m = 0; m < 4; ++m) { const int row = row0 + ai * 128 + m * 16; GAS float* rowp = (GAS float*)res + (size_t)row * D + col0;
                const GAS float* inp = in_x == nullptr ? (const GAS float*)rowp : (u.pm < 2 ? (const GAS float*)in_ctx + (size_t)row * D + col0 : (const GAS float*)in_x + (size_t)(row - NCTX) * D + col0);
#pragma unroll
                for (int bj = 0; bj < 2; ++bj)
#pragma unroll
                    for (int n = 0; n < 2; ++n) { GAS f32x4* p = (GAS f32x4*)(rowp + bj * 128 + n * 16); *p = *(const GAS f32x4*)(inp + bj * 128 + n * 16) + gv[bj][n] * (acc[ai][bj][m][n] + bv[bj][n]); } }
    }
};

struct EpiSwiGLU {
    static constexpr bool PERM = true;
    bf16_t* O; int ldo;
    __device__ __forceinline__ void operator()(const AccT& acc, const Unit& u, int wr, int wc, int fr, int fq) const {
        const int row0 = u.pm * 256 + wr * 64 + fr, col0 = u.aux * 128 + wc * 32 + 8 * fq;
#pragma unroll
        for (int ai = 0; ai < 2; ++ai)
#pragma unroll
            for (int m = 0; m < 4; ++m) { GAS bf16_t* rowp = (GAS bf16_t*)O + (size_t)(row0 + ai * 128 + m * 16) * ldo + col0;
                float o[8];
#pragma unroll
                for (int n = 0; n < 2; ++n)
#pragma unroll
                    for (int j = 0; j < 4; ++j) { const float g = acc[ai][0][m][n][j], up = acc[ai][1][m][n][j]; o[n * 4 + j] = siluf_(g) * up; }
                v4u w; w.x = pk2(o[0], o[1]); w.y = pk2(o[2], o[3]); w.z = pk2(o[4], o[5]); w.w = pk2(o[6], o[7]);
                *(GAS v4u*)rowp = w; }
    }
};
constexpr int FN = 16384;
constexpr int HY_NPOS = SEQ + CTXL;
__device__ __forceinline__ int pidx(int p) { return p + ((p >> 6) << 2); }
__device__ __forceinline__ f32x2 cmul(f32x2 a, f32x2 b) { return (f32x2){a.x * b.x - a.y * b.y, a.x * b.y + a.y * b.x}; }
__device__ __forceinline__ f32x2 cmulc(f32x2 a, f32x2 b) { return (f32x2){a.x * b.x + a.y * b.y, a.y * b.x - a.x * b.y}; }

#define W16C_ {1.0f, 0.92387953251f, 0.70710678119f, 0.38268343237f, 0.0f, -0.38268343237f, -0.70710678119f, -0.92387953251f}
#define W16S_ {0.0f, -0.38268343237f, -0.70710678119f, -0.92387953251f, -1.0f, -0.92387953251f, -0.70710678119f, -0.38268343237f}

template <bool INV> __device__ __forceinline__ void fft_pass16(LAS f32x2* X, const int S, const int lgS, const int tid_) {
    constexpr float wc[8] = W16C_, ws[8] = W16S_;
    int tid = tid_; asm volatile("" : "+v"(tid));
#pragma unroll 1
    for (int gi = 0; gi < 2; ++gi) {
        const int g = tid + gi * 512, blk = g >> lgS, q = g & (S - 1), base = blk * 16 * S + q;
        f32x2 e[16];
#pragma unroll
        for (int m = 0; m < 16; ++m) e[m] = X[pidx(base + m * S)];
        const float rev = -(float)q / (16.0f * (float)S); const float sn = __builtin_amdgcn_sinf(rev), cs = __builtin_amdgcn_cosf(rev);
        const f32x2 w1 = (f32x2){cs, sn}, w2 = cmul(w1, w1), w4 = cmul(w2, w2), w8 = cmul(w4, w4);
        if (!INV) {
#pragma unroll
            for (int m = 0; m < 8; ++m) { const f32x2 a = e[m], b = e[m + 8]; e[m] = a + b; e[m + 8] = cmul(a - b, cmul(w1, (f32x2){wc[m], ws[m]})); }
#pragma unroll
            for (int h = 0; h < 16; h += 8)
#pragma unroll
                for (int m = 0; m < 4; ++m) { const f32x2 a = e[h + m], b = e[h + m + 4]; e[h + m] = a + b; e[h + m + 4] = cmul(a - b, cmul(w2, (f32x2){wc[2 * m], ws[2 * m]})); }
#pragma unroll
            for (int h = 0; h < 16; h += 4)
#pragma unroll
                for (int m = 0; m < 2; ++m) { const f32x2 a = e[h + m], b = e[h + m + 2]; e[h + m] = a + b; e[h + m + 2] = cmul(a - b, cmul(w4, (f32x2){wc[4 * m], ws[4 * m]})); }
#pragma unroll
            for (int h = 0; h < 16; h += 2) { const f32x2 a = e[h], b = e[h + 1]; e[h] = a + b; e[h + 1] = cmul(a - b, w8); }
        } else {
#pragma unroll
            for (int h = 0; h < 16; h += 2) { const f32x2 a = e[h], b = cmulc(e[h + 1], w8); e[h] = a + b; e[h + 1] = a - b; }
#pragma unroll
            for (int h = 0; h < 16; h += 4)
#pragma unroll
                for (int m = 0; m < 2; ++m) { const f32x2 a = e[h + m], b = cmulc(e[h + m + 2], cmul(w4, (f32x2){wc[4 * m], ws[4 * m]})); e[h + m] = a + b; e[h + m + 2] = a - b; }
#pragma unroll
            for (int h = 0; h < 16; h += 8)
#pragma unroll
                for (int m = 0; m < 4; ++m) { const f32x2 a = e[h + m], b = cmulc(e[h + m + 4], cmul(w2, (f32x2){wc[2 * m], ws[2 * m]})); e[h + m] = a + b; e[h + m + 4] = a - b; }
#pragma unroll
            for (int m = 0; m < 8; ++m) { const f32x2 a = e[m], b = cmulc(e[m + 8], cmul(w1, (f32x2){wc[m], ws[m]})); e[m] = a + b; e[m + 8] = a - b; }
        }
#pragma unroll
        for (int m = 0; m < 16; ++m) X[pidx(base + m * S)] = e[m];
    }
}
template <bool INV> __device__ __forceinline__ void fft_pass4(LAS f32x2* X, const int tid_) {
    int tid = tid_; asm volatile("" : "+v"(tid));
#pragma unroll 2
    for (int gi = 0; gi < 8; ++gi) {
        const int base = pidx(4 * (tid + gi * 512));
        f32x2 e0 = X[base], e1 = X[base + 1], e2 = X[base + 2], e3 = X[base + 3];
        if (!INV) {
            f32x2 a = e0, b = e2; e0 = a + b; e2 = a - b;
            a = e1; b = e3; e1 = a + b; { const f32x2 d = a - b; e3 = (f32x2){d.y, -d.x}; }
            a = e0; b = e1; e0 = a + b; e1 = a - b;
            a = e2; b = e3; e2 = a + b; e3 = a - b;
        } else {
            f32x2 a = e0, b = e1; e0 = a + b; e1 = a - b;
            a = e2; b = e3; e2 = a + b; e3 = a - b;
            a = e0; b = e2; e0 = a + b; e2 = a - b;
            a = e1; b = (f32x2){-e3.y, e3.x}; e1 = a + b; e3 = a - b;
        }
        X[base] = e0; X[base + 1] = e1; X[base + 2] = e2; X[base + 3] = e3;
    }
}
__device__ __forceinline__ void fft_fwd(LAS f32x2* X, int tid) {
    fft_pass16<false>(X, 1024, 10, tid); __syncthreads(); fft_pass16<false>(X, 64, 6, tid); __syncthreads(); fft_pass16<false>(X, 4, 2, tid); __syncthreads(); fft_pass4<false>(X, tid); __syncthreads();
}
__device__ __forceinline__ void fft_inv(LAS f32x2* X, int tid) {
    fft_pass4<true>(X, tid); __syncthreads(); fft_pass16<true>(X, 4, 2, tid); __syncthreads(); fft_pass16<true>(X, 64, 6, tid); __syncthreads(); fft_pass16<true>(X, 1024, 10, tid); __syncthreads();
}

__device__ __forceinline__ float conv3(const GAS float* seq, int n, int L, float w0, float w1, float w2, float cb) {
    const float p0 = n > 0 ? seq[n - 1] : 0.f, p1 = seq[n], p2 = n < L - 1 ? seq[n + 1] : 0.f;
    return w0 * p0 + w1 * p1 + w2 * p2 + cb;
}

__device__ __forceinline__ float conv3u(const GAS float* seq, unsigned n, float w0, float w1, float w2, float cb) {
    const float p0 = n > 0u ? seq[n - 1u] : 0.f, p1 = seq[n], p2 = n < (unsigned)(SEQ - 1) ? seq[n + 1u] : 0.f;
    return w0 * p0 + w1 * p1 + w2 * p2 + cb;
}

struct Tap4 { f32x4 q; float l, r; };
__device__ __forceinline__ Tap4 tap4_load(const GAS float* seq, unsigned nb) {
    Tap4 t; t.q = *(const GAS f32x4*)(seq + nb); t.l = nb ? seq[nb - 1u] : 0.f; t.r = nb + 4u < (unsigned)SEQ ? seq[nb + 4u] : 0.f; return t;
}
__device__ __forceinline__ f32x4 conv3q(const Tap4& t, float w0, float w1, float w2, float cb) {
    return (f32x4){w0 * t.l + w1 * t.q.x + w2 * t.q.y + cb, w0 * t.q.x + w1 * t.q.y + w2 * t.q.z + cb, w0 * t.q.y + w1 * t.q.z + w2 * t.q.w + cb, w0 * t.q.z + w1 * t.q.w + w2 * t.r + cb};
}

__device__ __forceinline__ void ph_hy_filter_mlp(const Ctx& C, const float* w1, const float* b1, const float* w2, const float* b2, const float* w3, const float* b3, const float* freq, bf16_t* HB) {
    const int gw = C.bid * NWAVES + C.wave, NGW = C.G * NWAVES, j = C.lane;
    const GAS float* W1 = (const GAS float*)w1; const GAS float* W2 = (const GAS float*)w2; const GAS float* W3 = (const GAS float*)w3;
    const float f0 = freq[j], f1 = freq[64 + j], f2 = freq[128 + j], bb1 = b1[j], bb2 = b2[j], bb3 = b3[j];
    for (int p = gw; p < HY_NPOS; p += NGW) {
        const int L = p < SEQ ? SEQ : CTXL; const int pos = p < SEQ ? p : p - SEQ;
        const float fpos = (float)pos, t = fpos / (float)(L - 1);
        const float a = (float)(6.283185307179586 / (double)L) * fpos;
        float z = 0.f;
        if (j == 0) z = t;
        else if (j <= 32) { const int bi = (j - 1) & 15; const float band = 1e-4f + (float)bi * ((15.0f - 1e-4f) / 15.0f); const float ang = a * band; z = (j <= 16) ? cosf(ang) : -sinf(ang); }
        float acc = bb1;
#pragma unroll
        for (int i = 0; i < 33; ++i) acc += __shfl(z, i) * W1[i * 64 + j];
        float h = sinf(f0 * acc);
        acc = bb2;
#pragma unroll 16
        for (int i = 0; i < 64; ++i) acc += __shfl(h, i) * W2[i * 64 + j];
        h = sinf(f1 * acc);
        acc = bb3;
#pragma unroll 16
        for (int i = 0; i < 64; ++i) acc += __shfl(h, i) * W3[i * 64 + j];
        h = sinf(f2 * acc);
        const unsigned hi = f2bf(h); const unsigned lo = f2bf(h - bf2f(hi));
        GAS bf16_t* o = (GAS bf16_t*)HB + (size_t)p * 256;
        o[j] = (bf16_t)hi; o[64 + j] = (bf16_t)lo; o[128 + j] = (bf16_t)hi; o[192 + j] = 0;
    }
}
__device__ __forceinline__ void ph_hy_w4split(const Ctx& C, const float* w4, bf16_t* AW) {
    for (int i = C.bid * NTHR + C.tid; i < 64 * 4096; i += C.G * NTHR) { const int k = i >> 12, n = i & 4095; const float w = w4[i];
        const unsigned hi = f2bf(w), lo = f2bf(w - bf2f(hi)); GAS bf16_t* o = (GAS bf16_t*)AW + (size_t)n * 256;
        o[k] = (bf16_t)hi; o[64 + k] = (bf16_t)hi; o[128 + k] = (bf16_t)lo; o[192 + k] = 0; }
}
struct EpiHyFilt {
    static constexpr bool PERM = false;
    float* F;
    __device__ __forceinline__ void operator()(const AccT& acc, const Unit& u, int wr, int wc, int fr, int fq) const {
        const int row0 = u.pm * 256 + wr * 64 + fr, col0 = u.pn * 256 + wc * 32 + 4 * fq;
        const float d0 = -15.350567286626973f, d1 = -3.0701134573253946f;
#pragma unroll
        for (int ai = 0; ai < 2; ++ai)
#pragma unroll
            for (int m = 0; m < 4; ++m) { const int row = row0 + ai * 128 + m * 16, ch = row & 1023;
                const float ad = fabsf(d0 + (d1 - d0) * ((float)ch / 1023.0f));
                GAS float* rowp = (GAS float*)F + (size_t)row * HY_NPOS + col0;
#pragma unroll
                for (int bj = 0; bj < 2; ++bj)
#pragma unroll
                    for (int n = 0; n < 2; ++n) { const int c0 = col0 + bj * 128 + n * 16; f32x4 o;
#pragma unroll
                        for (int jj = 0; jj < 4; ++jj) { const int p = c0 + jj; const float t = p < SEQ ? (float)p / (float)(SEQ - 1) : (float)(p - SEQ) / (float)(CTXL - 1); o[jj] = acc[ai][bj][m][n][jj] * __expf(-t * ad); }
                        *(GAS f32x4*)(rowp + bj * 128 + n * 16) = o; } }
    }
};

#ifndef HY_STAGGER
#define HY_STAGGER 3000
#endif
#ifdef HY_STAMP
#define HSTAMP(k) do { __syncthreads(); const unsigned long long t1_ = __builtin_amdgcn_s_memrealtime(); hacc[k] += t1_ - hprev; hprev = t1_; } while (0)
#else
#define HSTAMP(k) do { } while (0)
#endif
__device__ __forceinline__ void ph_hy_conv(const Ctx& C, const float* PROJT, const float* FILT, const float* cw, const float* cbias, const float* skip, float* YT, f32x2* SCR, void* SCR_TS = nullptr) {
    LAS f32x2* X = (LAS f32x2*)C.lds;
    GAS f32x2* R1 = (GAS f32x2*)SCR + (size_t)C.bid * 3 * FN;
    const int tid = C.tid;
#ifdef HY_STAMP
    unsigned long long hacc[6] = {0, 0, 0, 0, 0, 0}; unsigned long long hprev = __builtin_amdgcn_s_memrealtime();
#endif
    for (int ch = C.bid; ch < D; ch += C.G) {
        const GAS float* px1 = (const GAS float*)PROJT + (size_t)ch * MROWS; const GAS float* px2 = (const GAS float*)PROJT + (size_t)(D + ch) * MROWS; const GAS float* pv = (const GAS float*)PROJT + (size_t)(2 * D + ch) * MROWS;
        const float a0 = cw[ch], a1 = cw[3 * D + ch], a2 = cw[6 * D + ch], ab = cbias[ch];
        const float b0 = cw[D + ch], b1 = cw[3 * D + D + ch], b2 = cw[6 * D + D + ch], bb = cbias[D + ch];
        const float v0 = cw[2 * D + ch], v1 = cw[3 * D + 2 * D + ch], v2 = cw[6 * D + 2 * D + ch], vb = cbias[2 * D + ch];
        {   LAS float* gf = (LAS float*)C.lds;
            LAS float* us = gf + 1024;
            LAS float* zs = us + 512;
            int tc = tid; asm volatile("" : "+v"(tc));
            for (int i = tc; i < 1024; i += NTHR) gf[i] = ((const GAS float*)FILT)[(size_t)((i >> 8) * D + ch) * HY_NPOS + SEQ + (i & 255)];
            const int b = tc >> 8, t = tc & 255;
            us[tc] = conv3(pv + b * CTXL, t, CTXL, v0, v1, v2, vb);
            __syncthreads();
            float y = skip[ch] * us[tc];
#pragma unroll 16
            for (int s = 0; s < CTXL; ++s) { const int k = t - s; const float g = gf[k >= 0 ? k : 256 - k]; y += g * us[b * 256 + s]; }
            zs[tc] = y * conv3(px1 + b * CTXL, t, CTXL, a0, a1, a2, ab);
            __syncthreads();
            float y2 = skip[D + ch] * zs[tc];
#pragma unroll 16
            for (int s = 0; s < CTXL; ++s) { const int k = t - s; const float g = gf[512 + (k >= 0 ? k : 256 - k)]; y2 += g * zs[b * 256 + s]; }
            ((GAS float*)YT)[(size_t)ch * MROWS + b * CTXL + t] = y2 * conv3(px2 + b * CTXL, t, CTXL, b0, b1, b2, bb);
            __syncthreads();
        }
        HSTAMP(0);
        const GAS float* lv0 = pv + NCTX; const GAS float* lv1 = pv + NCTX + SEQ;
        const GAS float* lx10 = px1 + NCTX; const GAS float* lx20 = px2 + NCTX;
        GAS float* yt0 = (GAS float*)YT + (size_t)ch * MROWS + NCTX; GAS float* yt1 = yt0 + SEQ;
        f32x2 ur[32], ks[32];
        unsigned tq = (unsigned)tid; asm volatile("" : "+v"(tq));
        float cv0 = v0, cv1 = v1, cv2 = v2, cvb = vb; asm volatile("" : "+v"(cv0), "+v"(cv1), "+v"(cv2), "+v"(cvb));
#pragma unroll
        for (int c_ = 0; c_ < 8; c_ += 2) {
#pragma unroll
            for (int j_ = 0; j_ < 2; ++j_) { const int g = c_ + j_; const unsigned nb = 4u * tq + 2048u * g; LAS f32x4* xq = (LAS f32x4*)(X + 4u * (tq + (tq >> 4)) + 2176u * g); (void)nb; (void)xq;
                const Tap4 ta = tap4_load(lv0, nb), tb = tap4_load(lv1, nb); const f32x4 ca = conv3q(ta, cv0, cv1, cv2, cvb), cb_ = conv3q(tb, cv0, cv1, cv2, cvb);
                ur[4 * g] = (f32x2){ca.x, cb_.x}; ur[4 * g + 1] = (f32x2){ca.y, cb_.y}; ur[4 * g + 2] = (f32x2){ca.z, cb_.z}; ur[4 * g + 3] = (f32x2){ca.w, cb_.w}; }
            __builtin_amdgcn_sched_barrier(0); }
        HSTAMP(1);
#pragma unroll 1
        for (int o = 0; o < 2; ++o) {
            const GAS float* hf = (const GAS float*)FILT + (size_t)((o * 2 + 0) * D + ch) * HY_NPOS; const GAS float* hb = (const GAS float*)FILT + (size_t)((o * 2 + 1) * D + ch) * HY_NPOS;
            const float sk = skip[o * D + ch];
            asm volatile("" : "+v"(tq));
#pragma unroll
            for (int c_ = 0; c_ < 8; c_ += 8) {
#pragma unroll
                for (int j_ = 0; j_ < 8; ++j_) { const int g = c_ + j_; const unsigned nb = 4u * tq + 2048u * g; LAS f32x4* xq = (LAS f32x4*)(X + 4u * (tq + (tq >> 4)) + 2176u * g); (void)nb; (void)xq;
                    const f32x4 f = *(const GAS f32x4*)(hf + nb), rq = *(const GAS f32x4*)(hb + ((unsigned)FN - 4u - nb)); const float r0 = nb ? hb[(unsigned)FN - nb] : 0.f;
                xq[0] = (f32x4){f.x + r0, 0.f, f.y + rq.w, 0.f}; xq[1] = (f32x4){f.z + rq.z, 0.f, f.w + rq.y, 0.f}; }
                __builtin_amdgcn_sched_barrier(0); }
            __syncthreads(); HSTAMP(2); fft_fwd(X, tid); HSTAMP(3);
            asm volatile("" : "+v"(tq));
#pragma unroll
            for (int c_ = 0; c_ < 8; c_ += 8) {
#pragma unroll
                for (int j_ = 0; j_ < 8; ++j_) { const int g = c_ + j_; const unsigned nb = 4u * tq + 2048u * g; LAS f32x4* xq = (LAS f32x4*)(X + 4u * (tq + (tq >> 4)) + 2176u * g); (void)nb; (void)xq;
                    const f32x4 a = xq[0], b = xq[1]; ks[4 * g] = (f32x2){a.x, a.y}; ks[4 * g + 1] = (f32x2){a.z, a.w}; ks[4 * g + 2] = (f32x2){b.x, b.y}; ks[4 * g + 3] = (f32x2){b.z, b.w};
                xq[0] = (f32x4){ur[4 * g].x, ur[4 * g].y, ur[4 * g + 1].x, ur[4 * g + 1].y}; xq[1] = (f32x4){ur[4 * g + 2].x, ur[4 * g + 2].y, ur[4 * g + 3].x, ur[4 * g + 3].y}; }
                __builtin_amdgcn_sched_barrier(0); }
            __syncthreads();
            HSTAMP(4); fft_fwd(X, tid); HSTAMP(3);
            asm volatile("" : "+v"(tq));
#pragma unroll
            for (int c_ = 0; c_ < 8; c_ += 8) {
#pragma unroll
                for (int j_ = 0; j_ < 8; ++j_) { const int g = c_ + j_; const unsigned nb = 4u * tq + 2048u * g; LAS f32x4* xq = (LAS f32x4*)(X + 4u * (tq + (tq >> 4)) + 2176u * g); (void)nb; (void)xq;
                    const f32x4 a = xq[0], b = xq[1]; const f32x2 m0 = cmul((f32x2){a.x, a.y}, ks[4 * g]), m1 = cmul((f32x2){a.z, a.w}, ks[4 * g + 1]), m2 = cmul((f32x2){b.x, b.y}, ks[4 * g + 2]), m3 = cmul((f32x2){b.z, b.w}, ks[4 * g + 3]);
                xq[0] = (f32x4){m0.x, m0.y, m1.x, m1.y}; xq[1] = (f32x4){m2.x, m2.y, m3.x, m3.y}; }
                __builtin_amdgcn_sched_barrier(0); }
            __syncthreads(); HSTAMP(4); fft_inv(X, tid); HSTAMP(3);
            asm volatile("" : "+v"(tq));
#pragma unroll
            for (int c_ = 0; c_ < 8; c_ += 8) {
#pragma unroll
                for (int j_ = 0; j_ < 8; ++j_) { const int g = c_ + j_; const unsigned nb = 4u * tq + 2048u * g; LAS f32x4* xq = (LAS f32x4*)(X + 4u * (tq + (tq >> 4)) + 2176u * g); (void)nb; (void)xq;
                    GAS f32x4* rq_ = (GAS f32x4*)(R1 + nb); rq_[0] = xq[0]; rq_[1] = xq[1]; }
                __builtin_amdgcn_sched_barrier(0); }
#pragma unroll
            for (int c_ = 0; c_ < 8; c_ += 8) {
#pragma unroll
                for (int j_ = 0; j_ < 8; ++j_) { const int g = c_ + j_; const unsigned nb = 4u * tq + 2048u * g; LAS f32x4* xq = (LAS f32x4*)(X + 4u * (tq + (tq >> 4)) + 2176u * g); (void)nb; (void)xq;
                    const f32x4 f = *(const GAS f32x4*)(hf + nb), rq = *(const GAS f32x4*)(hb + ((unsigned)FN - 4u - nb)); const float r0 = nb ? hb[(unsigned)FN - nb] : 0.f;
                const float d0 = f.x - r0, d1 = f.y - rq.w, d2 = f.z - rq.z, d3 = f.w - rq.y;
                const float v0_ = -(float)nb * (0.5f / (float)FN), v1_ = -(float)(nb + 1u) * (0.5f / (float)FN), v2_ = -(float)(nb + 2u) * (0.5f / (float)FN), v3_ = -(float)(nb + 3u) * (0.5f / (float)FN);
                xq[0] = (f32x4){d0 * __builtin_amdgcn_cosf(v0_), d0 * __builtin_amdgcn_sinf(v0_), d1 * __builtin_amdgcn_cosf(v1_), d1 * __builtin_amdgcn_sinf(v1_)};
                xq[1] = (f32x4){d2 * __builtin_amdgcn_cosf(v2_), d2 * __builtin_amdgcn_sinf(v2_), d3 * __builtin_amdgcn_cosf(v3_), d3 * __builtin_amdgcn_sinf(v3_)}; }
                __builtin_amdgcn_sched_barrier(0); }
            __syncthreads(); HSTAMP(2); fft_fwd(X, tid); HSTAMP(3);
            asm volatile("" : "+v"(tq));
#pragma unroll
            for (int c_ = 0; c_ < 8; c_ += 8) {
#pragma unroll
                for (int j_ = 0; j_ < 8; ++j_) { const int g = c_ + j_; const unsigned nb = 4u * tq + 2048u * g; LAS f32x4* xq = (LAS f32x4*)(X + 4u * (tq + (tq >> 4)) + 2176u * g); (void)nb; (void)xq;
                    const f32x4 a = xq[0], b = xq[1]; ks[4 * g] = (f32x2){a.x, a.y}; ks[4 * g + 1] = (f32x2){a.z, a.w}; ks[4 * g + 2] = (f32x2){b.x, b.y}; ks[4 * g + 3] = (f32x2){b.z, b.w};
                f32x2 t_[4];
#pragma unroll
                for (int j = 0; j < 4; ++j) { const float rv = -(float)(nb + j) * (0.5f / (float)FN); t_[j] = cmul(ur[4 * g + j], (f32x2){__builtin_amdgcn_cosf(rv), __builtin_amdgcn_sinf(rv)}); }
                xq[0] = (f32x4){t_[0].x, t_[0].y, t_[1].x, t_[1].y}; xq[1] = (f32x4){t_[2].x, t_[2].y, t_[3].x, t_[3].y}; }
                __builtin_amdgcn_sched_barrier(0); }
            __syncthreads(); HSTAMP(4); fft_fwd(X, tid); HSTAMP(3);
            asm volatile("" : "+v"(tq));
#pragma unroll
            for (int c_ = 0; c_ < 8; c_ += 8) {
#pragma unroll
                for (int j_ = 0; j_ < 8; ++j_) { const int g = c_ + j_; const unsigned nb = 4u * tq + 2048u * g; LAS f32x4* xq = (LAS f32x4*)(X + 4u * (tq + (tq >> 4)) + 2176u * g); (void)nb; (void)xq;
                    const f32x4 a = xq[0], b = xq[1]; const f32x2 m0 = cmul((f32x2){a.x, a.y}, ks[4 * g]), m1 = cmul((f32x2){a.z, a.w}, ks[4 * g + 1]), m2 = cmul((f32x2){b.x, b.y}, ks[4 * g + 2]), m3 = cmul((f32x2){b.z, b.w}, ks[4 * g + 3]);
                xq[0] = (f32x4){m0.x, m0.y, m1.x, m1.y}; xq[1] = (f32x4){m2.x, m2.y, m3.x, m3.y}; }
                __builtin_amdgcn_sched_barrier(0); }
            VM_WAIT();
#pragma unroll
            for (int c_ = 0; c_ < 8; c_ += 8) {
#pragma unroll
                for (int j_ = 0; j_ < 8; ++j_) { const int g = c_ + j_; const unsigned nb = 4u * tq + 2048u * g; LAS f32x4* xq = (LAS f32x4*)(X + 4u * (tq + (tq >> 4)) + 2176u * g); (void)nb; (void)xq;
                    const GAS f32x4* rq_ = (const GAS f32x4*)(R1 + nb); const f32x4 a = rq_[0], b = rq_[1]; ks[4 * g] = (f32x2){a.x, a.y}; ks[4 * g + 1] = (f32x2){a.z, a.w}; ks[4 * g + 2] = (f32x2){b.x, b.y}; ks[4 * g + 3] = (f32x2){b.z, b.w}; }
                __builtin_amdgcn_sched_barrier(0); }
            __syncthreads(); HSTAMP(4); fft_inv(X, tid); HSTAMP(3);
            asm volatile("" : "+v"(tq));
            const GAS float* gx0 = o ? lx20 : lx10; const GAS float* gx1 = gx0 + SEQ;
            float gw0 = o ? b0 : a0, gw1 = o ? b1 : a1, gw2 = o ? b2 : a2, gwb = o ? bb : ab; asm volatile("" : "+v"(gw0), "+v"(gw1), "+v"(gw2), "+v"(gwb));
#pragma unroll
            for (int c_ = 0; c_ < 8; c_ += 4) {
#pragma unroll
                for (int j_ = 0; j_ < 4; ++j_) { const int g = c_ + j_; const unsigned nb = 4u * tq + 2048u * g; LAS f32x4* xq = (LAS f32x4*)(X + 4u * (tq + (tq >> 4)) + 2176u * g); (void)nb; (void)xq;
                    const f32x4 a = xq[0], b = xq[1]; const f32x2 xv[4] = {(f32x2){a.x, a.y}, (f32x2){a.z, a.w}, (f32x2){b.x, b.y}, (f32x2){b.z, b.w}}; f32x2 y[4];
#pragma unroll
                for (int j = 0; j < 4; ++j) { const float rv = -(float)(nb + j) * (0.5f / (float)FN); const f32x2 r2 = cmulc(xv[j], (f32x2){__builtin_amdgcn_cosf(rv), __builtin_amdgcn_sinf(rv)}); y[j] = (ks[4 * g + j] + r2) * (0.5f / (float)FN) + ur[4 * g + j] * sk; }
                const Tap4 ta = tap4_load(gx0, nb), tb = tap4_load(gx1, nb); const f32x4 ga = conv3q(ta, gw0, gw1, gw2, gwb), gb = conv3q(tb, gw0, gw1, gw2, gwb);
                if (o == 0) {
                    ur[4 * g] = (f32x2){y[0].x * ga.x, y[0].y * gb.x}; ur[4 * g + 1] = (f32x2){y[1].x * ga.y, y[1].y * gb.y}; ur[4 * g + 2] = (f32x2){y[2].x * ga.z, y[2].y * gb.z}; ur[4 * g + 3] = (f32x2){y[3].x * ga.w, y[3].y * gb.w}; }
                else {
                    *(GAS f32x4*)(yt0 + nb) = (f32x4){y[0].x * ga.x, y[1].x * ga.y, y[2].x * ga.z, y[3].x * ga.w}; *(GAS f32x4*)(yt1 + nb) = (f32x4){y[0].y * gb.x, y[1].y * gb.y, y[2].y * gb.z, y[3].y * gb.w}; } }
                __builtin_amdgcn_sched_barrier(0); }
            __syncthreads(); HSTAMP(5);
        }
    }
#ifdef HY_STAMP
    if (C.bid == 0 && tid == 0) { unsigned long long* TSX = (unsigned long long*)SCR_TS; for (int k = 0; k < 6; ++k) TSX[k] = hacc[k]; }
#endif
}

__device__ __forceinline__ void ph_hy_transpose(const Ctx& C, const float* YT, bf16_t* YB) {
    LAS float* t = (LAS float*)C.lds;
    const int NIT = (D / 64) * (MROWS / 64);
    for (int it = C.bid; it < NIT; it += C.G) {
        const int c0 = (it % (D / 64)) * 64, t0 = (it / (D / 64)) * 64;
        {   const int tq = C.tid & 15, cc0 = C.tid >> 4;
            f32x4 v[2];
#pragma unroll
            for (int q = 0; q < 2; ++q) v[q] = *(const GAS f32x4*)((const GAS float*)YT + (size_t)(c0 + cc0 + 32 * q) * MROWS + t0 + 4 * tq);
#pragma unroll
            for (int q = 0; q < 2; ++q) { LAS float* d = t + (cc0 + 32 * q) * 65 + 4 * tq; d[0] = v[q].x; d[1] = v[q].y; d[2] = v[q].z; d[3] = v[q].w; } }
        __syncthreads();
        {   const int cq = C.tid & 15, tt0 = C.tid >> 4;
#pragma unroll
            for (int q = 0; q < 2; ++q) { const int tt = tt0 + 32 * q; v2u w; w.x = pk2(t[(4 * cq + 0) * 65 + tt], t[(4 * cq + 1) * 65 + tt]); w.y = pk2(t[(4 * cq + 2) * 65 + tt], t[(4 * cq + 3) * 65 + tt]);
                *(GAS v2u*)((GAS bf16_t*)YB + (size_t)(t0 + tt) * D + c0 + 4 * cq) = w; } }
        __syncthreads();
    }
}
constexpr int RW_H = 16, RW_N = 64;
constexpr int NSTEP = CTXL + SEQ;

__device__ __forceinline__ void ph_rw_mix(const Ctx& C, const ResSrc& src, const float* rstd, const float* g, const float* modl, const float* mu, bf16_t* X6) {
    const int gw = C.bid * NWAVES + C.wave, NGW = C.G * NWAVES, lane = C.lane;
    f32x4 gv[4], muv[6][4];
#pragma unroll
    for (int j = 0; j < 4; ++j) { gv[j] = ((const GAS f32x4*)g + lane)[64 * j];
#pragma unroll
        for (int m = 0; m < 6; ++m) muv[m][j] = ((const GAS f32x4*)(mu + (size_t)m * D) + lane)[64 * j]; }
    for (int r = gw; r < MROWS; r += NGW) {
        int nb[4]; bool ok[4];
        if (r < NCTX) { const int t = r & 255; nb[0] = nb[1] = r - 1; ok[0] = ok[1] = t > 0; nb[2] = nb[3] = r + 1; ok[2] = ok[3] = t < 255; }
        else { const int l = (r - NCTX) & (SEQ - 1), gy = l >> 6, gx = l & 63; nb[0] = r - 1; ok[0] = gx > 0; nb[1] = r + 1; ok[1] = gx < 63; nb[2] = r - 64; ok[2] = gy > 0; nb[3] = r + 64; ok[3] = gy < 255; }
        const int b = row_bidx(r);
        const float so = rstd[r];
        const GAS f32x4* own = (const GAS f32x4*)res_row(src, r) + lane;
        const GAS f32x4* sh4 = (const GAS f32x4*)(modl + (size_t)(b * 6 + 0) * D) + lane; const GAS f32x4* sc4 = (const GAS f32x4*)(modl + (size_t)(b * 6 + 1) * D) + lane;
        f32x4 ov[4], nv[4], shv[4], scv[4]; float sn[4];
#pragma unroll
        for (int j = 0; j < 4; ++j) { ov[j] = own[64 * j]; shv[j] = sh4[64 * j]; scv[j] = sc4[64 * j];
            const int nr = ok[j] ? nb[j] : r; sn[j] = rstd[nr]; nv[j] = ((const GAS f32x4*)res_row(src, nr) + lane)[64 * j]; }
#pragma unroll
        for (int j = 0; j < 4; ++j) {
            const f32x4 gg = gv[j] * (scv[j] + 1.0f), sh = shv[j];
            const f32x4 ho = ov[j] * so * gg + sh;
            const f32x4 hn = ok[j] ? (nv[j] * sn[j] * gg + sh) : (f32x4){0.f, 0.f, 0.f, 0.f};
            const f32x4 xx = hn - ho;
#pragma unroll
            for (int m = 0; m < 6; ++m) { const f32x4 x = ho + xx * muv[m][j];
                v2u w; w.x = pk2(x.x, x.y); w.y = pk2(x.z, x.w); ((GAS v2u*)(X6 + ((size_t)m * MROWS + r) * D) + lane)[64 * j] = w; }
        }
    }
}

struct SchedRw1 {
    const bf16_t* X6; const bf16_t* Wrkv; const bf16_t* Ldn; int nN, G, c;
    __device__ __forceinline__ bool next(int i, Unit& u) const { const bool ok = pg8::static_unit(PMT, nN, G, c, i, u.pm, u.pn); u.aux = 0; return ok; }
    __device__ __forceinline__ const char* a_ptr(const Unit& u) const { const int am = u.pn < 4 ? 0 : u.pn < 8 ? 2 : u.pn < 12 ? 3 : u.pn == 12 ? 1 : u.pn == 13 ? 4 : u.pn == 14 ? 5 : 3;
        return (const char*)(X6 + ((size_t)am * MROWS + (size_t)u.pm * 256) * D); }
    __device__ __forceinline__ const char* b_ptr(const Unit& u) const { return u.pn < 12 ? (const char*)(Wrkv + (size_t)u.pn * 256 * D) : (const char*)(Ldn + (size_t)(u.pn - 12) * 256 * D); }
};
__device__ __forceinline__ float act_sel(float x, int act) { const float e = __expf(act == 1 ? 2.0f * x : -x); const float t = 1.0f - 2.0f / (e + 1.0f), s = 1.0f / (1.0f + e); return act == 1 ? t : (act == 2 ? s : x); }
struct EpiRw1 {
    static constexpr bool PERM = true;
    bf16_t* Rb; bf16_t* Kb; bf16_t* Vb; bf16_t* LD;
    __device__ __forceinline__ void operator()(const AccT& acc, const Unit& u, int wr, int wc, int fr, int fq) const {
        const int row0 = u.pm * 256 + wr * 64 + fr;
        const int grp = u.pn >> 2;
        const size_t doff = (size_t)(grp == 0) * (size_t)Rb + (size_t)(grp == 1) * (size_t)Kb + (size_t)(grp == 2) * (size_t)Vb + (size_t)(grp == 3) * (size_t)LD;
        bf16_t* dst = (bf16_t*)doff;
        const int colt = (u.pn & 3) * 256; const int act = (u.pn == 12) ? 1 : ((u.pn == 14) ? 2 : 0);
        const int col0 = colt + wc * 32 + 8 * fq;
        if (act == 0) {
#pragma unroll
            for (int ai = 0; ai < 2; ++ai)
#pragma unroll
                for (int m = 0; m < 4; ++m) { GAS bf16_t* rowp = (GAS bf16_t*)dst + (size_t)(row0 + ai * 128 + m * 16) * D + col0;
#pragma unroll
                    for (int bj = 0; bj < 2; ++bj) { const f32x4 p = acc[ai][bj][m][0], q = acc[ai][bj][m][1];
                        v4u w; w.x = pk2(p[0], p[1]); w.y = pk2(p[2], p[3]); w.z = pk2(q[0], q[1]); w.w = pk2(q[2], q[3]);
                        *(GAS v4u*)(rowp + bj * 128) = w; } }
        } else {
#pragma unroll
            for (int ai = 0; ai < 2; ++ai)
#pragma unroll
                for (int m = 0; m < 4; ++m) { GAS bf16_t* rowp = (GAS bf16_t*)dst + (size_t)(row0 + ai * 128 + m * 16) * D + col0;
#pragma unroll
                    for (int bj = 0; bj < 2; ++bj) { const f32x4 p = acc[ai][bj][m][0], q = acc[ai][bj][m][1];
                        v4u w; w.x = pk2(act_sel(p[0], act), act_sel(p[1], act)); w.y = pk2(act_sel(p[2], act), act_sel(p[3], act)); w.z = pk2(act_sel(q[0], act), act_sel(q[1], act)); w.w = pk2(act_sel(q[2], act), act_sel(q[3], act));
                        *(GAS v4u*)(rowp + bj * 128) = w; } }
        }
    }
};

struct SchedRw2 {
    const bf16_t* LD; const bf16_t* Lup; int nN, G, c;
    __device__ __forceinline__ bool next(int i, Unit& u) const { const bool ok = pg8::static_unit(PMT, nN, G, c, i, u.pm, u.pn); u.aux = 0; return ok; }
    __device__ __forceinline__ const char* a_ptr(const Unit& u) const { const int grp = u.pn < 8 ? 0 : u.pn < 16 ? 1 : u.pn < 20 ? 2 : 3; return (const char*)(LD + (size_t)u.pm * 256 * D + grp * 256); }
    __device__ __forceinline__ const char* b_ptr(const Unit& u) const { return (const char*)(Lup + (size_t)u.pn * 256 * 256); }
};
struct EpiRw2 {
    static constexpr bool PERM = false;
    bf16_t* DEC; bf16_t* ASIG; bf16_t* Gb; bf16_t* Vb; const bf16_t* VF; const float* w0; const float* a0; const float* v0;
    __device__ __forceinline__ void operator()(const AccT& acc, const Unit& u, int wr, int wc, int fr, int fq) const {
        const int row0 = u.pm * 256 + wr * 64 + fr;
        const int pn = u.pn, colt = (pn & 3) * 256 + wc * 32 + 4 * fq;
        const GAS float* cbp = pn < 8 ? (const GAS float*)w0 + (pn >> 2) * D : (pn < 16 ? (const GAS float*)a0 + ((pn - 8) >> 2) * D : (const GAS float*)v0);
        const float cbs = (pn >= 16 && pn < 20) ? 0.f : 1.f;
        const int mode = pn < 8 ? 0 : (pn < 16 ? 1 : (pn < 20 ? 2 : 3));
        const size_t dsel = (size_t)((pn < 8 ? pn : pn - 8) >> 2) * MROWS;
#pragma unroll
        for (int ai = 0; ai < 2; ++ai)
#pragma unroll
            for (int m = 0; m < 4; ++m) { const size_t row = (size_t)(row0 + ai * 128 + m * 16);
#pragma unroll
                for (int bj = 0; bj < 2; ++bj)
#pragma unroll
                    for (int n = 0; n < 2; ++n) { const int col = colt + bj * 128 + n * 16;
                        const f32x4 x = acc[ai][bj][m][n] + *(const GAS f32x4*)(cbp + col) * cbs;
                        if (mode == 0) { f32x4 o;
#pragma unroll
                            for (int j = 0; j < 4; ++j) { const float z = -x[j]; const float sp = z > 20.f ? z : __logf(1.0f + __expf(z)); o[j] = -__expf(-sp - 0.5f); }
                            { v2u w; w.x = pk2(o[0], o[1]); w.y = pk2(o[2], o[3]); *(GAS v2u*)((GAS bf16_t*)DEC + (dsel + row) * D + col) = w; } }
                        else if (mode == 1) { v2u w; w.x = pk2(sigmoidf_(x[0]), sigmoidf_(x[1])); w.y = pk2(sigmoidf_(x[2]), sigmoidf_(x[3]));
                            *(GAS v2u*)((GAS bf16_t*)ASIG + (dsel + row) * D + col) = w; }
                        else if (mode == 2) { v2u w; w.x = pk2(x[0], x[1]); w.y = pk2(x[2], x[3]); *(GAS v2u*)((GAS bf16_t*)Gb + row * D + col) = w; }
                        else { GAS v2u* vp = (GAS v2u*)((GAS bf16_t*)Vb + row * D + col); const v2u vv = *vp; const v2u ff = *(const GAS v2u*)((const GAS bf16_t*)VF + row * D + col);
                            const float o0 = bflo(vv.x) + (bflo(ff.x) - bflo(vv.x)) * sigmoidf_(x[0]), o1 = bfhi(vv.x) + (bfhi(ff.x) - bfhi(vv.x)) * sigmoidf_(x[1]);
                            const float o2 = bflo(vv.y) + (bflo(ff.y) - bflo(vv.y)) * sigmoidf_(x[2]), o3 = bfhi(vv.y) + (bfhi(ff.y) - bfhi(vv.y)) * sigmoidf_(x[3]);
                            v2u w; w.x = pk2(o0, o1); w.y = pk2(o2, o3); *vp = w; } }
                asm volatile("" ::: "memory"); }
    }
};

__device__ __forceinline__ int rw_step_row(int d, int b, int s) {
    if (s < CTXL) return b * CTXL + (d == 0 ? s : CTXL - 1 - s);
    const int l = s - CTXL; return NCTX + b * SEQ + (d == 0 ? l : SEQ - 1 - l);
}
__device__ __forceinline__ float dpp_xor1(float v) { return __builtin_bit_cast(float, __builtin_amdgcn_update_dpp(0, __builtin_bit_cast(int, v), 0xB1, 0xf, 0xf, false)); }
__device__ __forceinline__ float dpp_xor2(float v) { return __builtin_bit_cast(float, __builtin_amdgcn_update_dpp(0, __builtin_bit_cast(int, v), 0x4E, 0xf, 0xf, false)); }
__device__ __forceinline__ float dpp_hmirror(float v) { return __builtin_bit_cast(float, __builtin_amdgcn_update_dpp(0, __builtin_bit_cast(int, v), 0x141, 0xf, 0xf, false)); }
__device__ __forceinline__ float sum8(float v) { v += dpp_xor1(v); v += dpp_xor2(v); v += dpp_hmirror(v); return v; }

__device__ __forceinline__ void ph_rw_scan_seq(const Ctx& C, const bf16_t* Rb, const bf16_t* Kb, const bf16_t* Vb, const float* DEC, const bf16_t* ASIG, const float* k_k, const float* k_a, const float* r_k, float* Y, float* BON) {
    constexpr int T = 32;
    LAS float* sw = (LAS float*)C.lds;
    LAS float* sa = sw + T * 64; LAS float* sb = sa + T * 64; LAS float* sk = sb + T * 64; LAS float* sr = sk + T * 64; LAS float* sv = sr + T * 64; LAS float* sy = sv + T * 64;
    for (int chain = C.bid; chain < 64; chain += C.G) {
        const int d = chain >> 5, b = (chain >> 4) & 1, h = chain & 15;
        const int v = C.tid >> 3, seg = C.tid & 7;
        float S[8];
#pragma unroll
        for (int j = 0; j < 8; ++j) S[j] = 0.f;
        const int hc = h * 64 + C.lane;
        const float kkw = k_k[hc], kaw = k_a[hc], rkw = r_k[hc];
        for (int s0 = 0; s0 < NSTEP; s0 += T) {
            for (int tt = C.wave; tt < T; tt += NWAVES) {
                const int row = rw_step_row(d, b, s0 + tt); const size_t o = (size_t)row * D + hc;
                const float kx = bf2f(((const GAS bf16_t*)Kb)[o]), rx = bf2f(((const GAS bf16_t*)Rb)[o]), vx = bf2f(((const GAS bf16_t*)Vb)[o]);
                const float lw = ((const GAS float*)DEC)[(size_t)d * MROWS * D + o], as = bf2f(((const GAS bf16_t*)ASIG)[(size_t)d * MROWS * D + o]);
                const float kk = kx * kkw; const float nrm = sqrtf(wave_sum(kk * kk)); const float kkn = kk / fmaxf(nrm, 1e-12f);
                const float kd = kx * (1.0f + (as - 1.0f) * kaw);
                const float bon = wave_sum(rx * kd * rkw);
                if (C.lane == 0) BON[((size_t)d * MROWS + row) * RW_H + h] = bon;
                const int li = tt * 64 + C.lane;
                sw[li] = __expf(lw); sa[li] = -kkn; sb[li] = kkn * as; sk[li] = kd; sr[li] = rx; sv[li] = vx;
            }
            __syncthreads();
#pragma unroll 2
            for (int tt = 0; tt < T; ++tt) {
                const LAS f32x4* pw = (const LAS f32x4*)(sw + tt * 64 + seg * 8); const LAS f32x4* pa = (const LAS f32x4*)(sa + tt * 64 + seg * 8); const LAS f32x4* pb = (const LAS f32x4*)(sb + tt * 64 + seg * 8);
                const LAS f32x4* pk = (const LAS f32x4*)(sk + tt * 64 + seg * 8); const LAS f32x4* pr = (const LAS f32x4*)(sr + tt * 64 + seg * 8);
                const f32x4 a0 = pa[0], a1 = pa[1], w0 = pw[0], w1 = pw[1], b0 = pb[0], b1 = pb[1], k0 = pk[0], k1 = pk[1], r0 = pr[0], r1 = pr[1];
                const float vv = sv[tt * 64 + v];
                float dot = (S[0] * a0.x + S[1] * a0.y) + (S[2] * a0.z + S[3] * a0.w) + (S[4] * a1.x + S[5] * a1.y) + (S[6] * a1.z + S[7] * a1.w);
                dot = sum8(dot);
                S[0] = S[0] * w0.x + dot * b0.x + vv * k0.x; S[1] = S[1] * w0.y + dot * b0.y + vv * k0.y; S[2] = S[2] * w0.z + dot * b0.z + vv * k0.z; S[3] = S[3] * w0.w + dot * b0.w + vv * k0.w;
                S[4] = S[4] * w1.x + dot * b1.x + vv * k1.x; S[5] = S[5] * w1.y + dot * b1.y + vv * k1.y; S[6] = S[6] * w1.z + dot * b1.z + vv * k1.z; S[7] = S[7] * w1.w + dot * b1.w + vv * k1.w;
                float y = (S[0] * r0.x + S[1] * r0.y) + (S[2] * r0.z + S[3] * r0.w) + (S[4] * r1.x + S[5] * r1.y) + (S[6] * r1.z + S[7] * r1.w);
                y = sum8(y);
                if (seg == 0) sy[tt * 64 + v] = y;
            }
            __syncthreads();
            for (int i = C.tid; i < T * 64; i += NTHR) { const int tt = i >> 6, c = i & 63; const int row = rw_step_row(d, b, s0 + tt); ((GAS float*)Y)[((size_t)d * MROWS + row) * D + h * 64 + c] = sy[i]; }
            __syncthreads();
        }
    }
}

__device__ __forceinline__ void ph_rw_prep(const Ctx& C, const bf16_t* Rb, bf16_t* Kb, float* DEC, bf16_t* ASIG, bf16_t* KD, const float* k_k, const float* k_a, const float* r_k, float* BON) {
    const int gw = C.bid * NWAVES + C.wave, NGW = C.G * NWAVES, lane = C.lane;
    for (int r = gw; r < MROWS; r += NGW) {
#pragma unroll
        for (int j = 0; j < 4; ++j) {
            const size_t o4 = (size_t)r * (D / 4) + lane + 64 * j;
            const v2u kw = ((const GAS v2u*)Kb)[o4], rw = ((const GAS v2u*)Rb)[o4];
            const f32x4 kf = (f32x4){bflo(kw.x), bfhi(kw.x), bflo(kw.y), bfhi(kw.y)}, rf = (f32x4){bflo(rw.x), bfhi(rw.x), bflo(rw.y), bfhi(rw.y)};
            const f32x4 kkw = ((const GAS f32x4*)k_k)[lane + 64 * j], kaw = ((const GAS f32x4*)k_a)[lane + 64 * j], rkw = ((const GAS f32x4*)r_k)[lane + 64 * j];
            const f32x4 kk = kf * kkw;
            float ss = (kk.x * kk.x + kk.y * kk.y) + (kk.z * kk.z + kk.w * kk.w);
            ss += __shfl_xor(ss, 1); ss += __shfl_xor(ss, 2); ss += __shfl_xor(ss, 4); ss += __shfl_xor(ss, 8);
            const float inv = 1.0f / fmaxf(sqrtf(ss), 1e-12f);
            const f32x4 kkn = kk * inv;
            { v2u w; w.x = pk2(-kkn.x, -kkn.y); w.y = pk2(-kkn.z, -kkn.w); ((GAS v2u*)Kb)[o4] = w; }
            const int hd = 4 * j + (lane >> 4);
#pragma unroll
            for (int d = 0; d < 2; ++d) {
                const size_t od = (size_t)d * MROWS * (D / 4) + o4;
                const v2u aw = ((const GAS v2u*)ASIG)[od]; const f32x4 af = (f32x4){bflo(aw.x), bfhi(aw.x), bflo(aw.y), bfhi(aw.y)};
                const f32x4 lw = ((const GAS f32x4*)DEC)[od];
                const f32x4 kd = kf * ((af - 1.0f) * kaw + 1.0f), bb = kkn * af;
                float bon = (rf.x * kd.x * rkw.x + rf.y * kd.y * rkw.y) + (rf.z * kd.z * rkw.z + rf.w * kd.w * rkw.w);
                bon += __shfl_xor(bon, 1); bon += __shfl_xor(bon, 2); bon += __shfl_xor(bon, 4); bon += __shfl_xor(bon, 8);
                if ((lane & 15) == 0) BON[((size_t)d * MROWS + r) * RW_H + hd] = bon;
                ((GAS f32x4*)DEC)[od] = (f32x4){__expf(lw.x), __expf(lw.y), __expf(lw.z), __expf(lw.w)};
                { v2u w; w.x = pk2(bb.x, bb.y); w.y = pk2(bb.z, bb.w); ((GAS v2u*)ASIG)[od] = w; }
                { v2u w; w.x = pk2(kd.x, kd.y); w.y = pk2(kd.z, kd.w); ((GAS v2u*)KD)[od] = w; }
            }
        }
    }
}

__device__ __forceinline__ float dpp_rmirror(float v) { return __builtin_bit_cast(float, __builtin_amdgcn_update_dpp(0, __builtin_bit_cast(int, v), 0x140, 0xf, 0xf, false)); }
__device__ __forceinline__ float sum16(float v) { v += dpp_xor1(v); v += dpp_xor2(v); v += dpp_hmirror(v); v += dpp_rmirror(v); return v; }
__device__ __forceinline__ float wave_sum_dpp(float v) {
    v = sum16(v);
    return (__builtin_amdgcn_readlane(__builtin_bit_cast(int, v), 0) , (__builtin_bit_cast(float, __builtin_amdgcn_readlane(__builtin_bit_cast(int, v), 0)) + __builtin_bit_cast(float, __builtin_amdgcn_readlane(__builtin_bit_cast(int, v), 16)))
          + (__builtin_bit_cast(float, __builtin_amdgcn_readlane(__builtin_bit_cast(int, v), 32)) + __builtin_bit_cast(float, __builtin_amdgcn_readlane(__builtin_bit_cast(int, v), 48))));
}
#define SCAN_BAR() do { asm volatile("s_waitcnt lgkmcnt(0)" ::: "memory"); __builtin_amdgcn_s_barrier(); asm volatile("" ::: "memory"); } while (0)
__device__ __forceinline__ void ph_rw_scan_v2(const Ctx& C, const bf16_t* Rb, const bf16_t* Ab, const bf16_t* Vb, const float* Wd, const bf16_t* Bd, const bf16_t* KDd, float* Y) {
    constexpr int T = 32, NCH = NSTEP / T, BUF = 5 * T * 64 + T * 16;
    LAS float* base = (LAS float*)C.lds;
    LAS float* syb = base + 2 * BUF;
    for (int item = C.bid; item < 256; item += C.G) {
        const int chain = item >> 2, rq = item & 3, d = chain >> 5, b = (chain >> 4) & 1, h = chain & 15;
        const bool producer = C.wave >= 4;
        const int vl = (C.tid & 255) >> 4, seg = C.tid & 15;
        const int pw = C.wave - 4, pl2 = (C.lane & 31) * 2, ph = C.lane >> 5;
        float S0 = 0.f, S1 = 0.f, S2 = 0.f, S3 = 0.f;
        f32x2 wx[4]; unsigned ax[4], bx[4], kx[4], rx[4], vx[4];
        auto pload = [&](int cc) {
#pragma unroll
            for (int q = 0; q < 4; ++q) { const int row = rw_step_row(d, b, cc * T + pw * 8 + 2 * q + ph); const size_t o = (size_t)row * D + h * 64 + pl2, od = (size_t)d * MROWS * D + o;
                wx[q] = *(const GAS f32x2*)((const GAS float*)Wd + od); ax[q] = *(const GAS unsigned*)((const GAS bf16_t*)Ab + o); bx[q] = *(const GAS unsigned*)((const GAS bf16_t*)Bd + od);
                kx[q] = *(const GAS unsigned*)((const GAS bf16_t*)KDd + od); rx[q] = *(const GAS unsigned*)((const GAS bf16_t*)Rb + o);
                vx[q] = *(const GAS unsigned*)((const GAS bf16_t*)Vb + (size_t)row * D + h * 64 + rq * 16 + (pl2 & 15)); }
        };
        auto pemit = [&](int cc) {
            LAS float* bw = base + (cc & 1) * BUF; LAS float* ba = bw + T * 64; LAS float* bb = ba + T * 64; LAS float* bk = bb + T * 64; LAS float* br = bk + T * 64; LAS float* bv = br + T * 64;
#pragma unroll
            for (int q = 0; q < 4; ++q) { const int tt = pw * 8 + 2 * q + ph; const int li = tt * 64 + pl2;
                *(LAS f32x2*)(bw + li) = wx[q]; *(LAS f32x2*)(ba + li) = (f32x2){bflo(ax[q]), bfhi(ax[q])}; *(LAS f32x2*)(bb + li) = (f32x2){bflo(bx[q]), bfhi(bx[q])};
                *(LAS f32x2*)(bk + li) = (f32x2){bflo(kx[q]), bfhi(kx[q])}; *(LAS f32x2*)(br + li) = (f32x2){bflo(rx[q]), bfhi(rx[q])};
                if ((C.lane & 31) < 8) *(LAS f32x2*)(bv + tt * 16 + pl2) = (f32x2){bflo(vx[q]), bfhi(vx[q])}; }
        };
        auto flush = [&](int cc) {
            const LAS float* sy = syb + (cc & 1) * T * 16; const int i0 = C.tid - 256;
#pragma unroll
            for (int q = 0; q < 2; ++q) { const int i = i0 + 256 * q, tt = i >> 4, c = i & 15; const int row = rw_step_row(d, b, cc * T + tt); ((GAS float*)Y)[((size_t)d * MROWS + row) * D + h * 64 + rq * 16 + c] = sy[i]; }
        };
        if (producer) { pload(0); pemit(0); pload(1); }
        SCAN_BAR();
        for (int cc = 0; cc < NCH; ++cc) {
            if (producer) { if (cc + 1 < NCH) { pemit(cc + 1); if (cc + 2 < NCH) pload(cc + 2); } if (cc >= 1) flush(cc - 1); }
            else {
                const LAS float* bw = base + (cc & 1) * BUF; const LAS float* ba = bw + T * 64; const LAS float* bb = ba + T * 64; const LAS float* bk = bb + T * 64; const LAS float* br = bk + T * 64; const LAS float* bv = br + T * 64;
                LAS float* sy = syb + (cc & 1) * T * 16;
                f32x4 a4 = *(const LAS f32x4*)(ba + seg * 4), w4 = *(const LAS f32x4*)(bw + seg * 4), b4 = *(const LAS f32x4*)(bb + seg * 4), k4 = *(const LAS f32x4*)(bk + seg * 4), r4 = *(const LAS f32x4*)(br + seg * 4);
                float vv = bv[vl];
#pragma unroll 8
                for (int tt = 0; tt < T; ++tt) {
                    const int tn = (tt + 1 < T) ? tt + 1 : tt;
                    const f32x4 a4n = *(const LAS f32x4*)(ba + tn * 64 + seg * 4), w4n = *(const LAS f32x4*)(bw + tn * 64 + seg * 4), b4n = *(const LAS f32x4*)(bb + tn * 64 + seg * 4), k4n = *(const LAS f32x4*)(bk + tn * 64 + seg * 4), r4n = *(const LAS f32x4*)(br + tn * 64 + seg * 4);
                    const float vvn = bv[tn * 16 + vl];
                    float dot = (S0 * a4.x + S1 * a4.y) + (S2 * a4.z + S3 * a4.w);
                    dot = sum16(dot);
                    S0 = S0 * w4.x + (dot * b4.x + vv * k4.x); S1 = S1 * w4.y + (dot * b4.y + vv * k4.y); S2 = S2 * w4.z + (dot * b4.z + vv * k4.z); S3 = S3 * w4.w + (dot * b4.w + vv * k4.w);
                    float y = (S0 * r4.x + S1 * r4.y) + (S2 * r4.z + S3 * r4.w);
                    y = sum16(y);
                    sy[tt * 16 + vl] = y;
                    a4 = a4n; w4 = w4n; b4 = b4n; k4 = k4n; r4 = r4n; vv = vvn;
                }
            }
            SCAN_BAR();
        }
        if (producer) flush(NCH - 1);
        SCAN_BAR();
    }
}

__device__ __forceinline__ void ph_rw_post(const Ctx& C, const float* Y, const float* BON, const bf16_t* Vb, const bf16_t* Gb, const float* lnw, const float* lnb, bf16_t* YB) {
    const int gw = C.bid * NWAVES + C.wave, NGW = C.G * NWAVES, lane = C.lane;
    for (int r = gw; r < MROWS; r += NGW) {
        const GAS f32x4* y0 = (const GAS f32x4*)(Y + (size_t)r * D) + lane; const GAS f32x4* y1 = (const GAS f32x4*)(Y + ((size_t)MROWS + r) * D) + lane;
#pragma unroll
        for (int j = 0; j < 4; ++j) {
            const f32x4 y = y0[64 * j] + y1[64 * j];
            float s = (y.x + y.y) + (y.z + y.w);
            s += __shfl_xor(s, 1); s += __shfl_xor(s, 2); s += __shfl_xor(s, 4); s += __shfl_xor(s, 8);
            const float mean = s * (1.0f / 64.0f); const f32x4 dd = y - mean;
            float q = (dd.x * dd.x + dd.y * dd.y) + (dd.z * dd.z + dd.w * dd.w);
            q += __shfl_xor(q, 1); q += __shfl_xor(q, 2); q += __shfl_xor(q, 4); q += __shfl_xor(q, 8);
            const float rs = 1.0f / sqrtf(q * (1.0f / 64.0f) + 64e-5f);
            const int hd = 4 * j + (lane >> 4);
            const float bon = BON[(size_t)r * RW_H + hd] + BON[((size_t)MROWS + r) * RW_H + hd];
            const f32x4 lw = ((const GAS f32x4*)lnw + lane)[64 * j], lb = ((const GAS f32x4*)lnb + lane)[64 * j];
            const v2u vv = ((const GAS v2u*)(Vb + (size_t)r * D) + lane)[64 * j], gg = ((const GAS v2u*)(Gb + (size_t)r * D) + lane)[64 * j];
            const f32x4 vf = (f32x4){bflo(vv.x), bfhi(vv.x), bflo(vv.y), bfhi(vv.y)}, gf = (f32x4){bflo(gg.x), bfhi(gg.x), bflo(gg.y), bfhi(gg.y)};
            const f32x4 o = (dd * rs * lw + lb + vf * bon) * gf;
            v2u w; w.x = pk2(o.x, o.y); w.y = pk2(o.z, o.w); ((GAS v2u*)(YB + (size_t)r * D) + lane)[64 * j] = w;
        }
    }
}
__device__ __forceinline__ int slot32(int t) { return ((t & 12) << 1) | ((t >> 4) << 2) | (t & 3); }
constexpr int RC = 32, RNCH = NSTEP / RC;
constexpr int RW_NCHUNKHEAD = 64 * RNCH;
constexpr int RW_NTCH = 16 + 1024;
__device__ __forceinline__ int rwc_rowbase(int d, int b, int c) {
    if (c < 8) return b * CTXL + 32 * (d == 0 ? c : 7 - c);
    const int j = c - 8; return NCTX + b * SEQ + 32 * (d == 0 ? j : 511 - j);
}
__device__ __forceinline__ int rwc_tokchunk(int d, int b, int c) {
    if (c < 8) return b * 8 + (d == 0 ? c : 7 - c);
    const int j = c - 8; return 16 + b * 512 + (d == 0 ? j : 511 - j);
}
__device__ __forceinline__ int kslot64(int k) { return (k & 32) | slot32(k & 31); }

struct RwcImg { bf16_t* WP; bf16_t* RT; bf16_t* TA; bf16_t* ARB; bf16_t* ARK; bf16_t* BT; bf16_t* KT; float* SC; bf16_t* VT; };

template <int DIR>
__device__ __forceinline__ void rwc_prep_one(LAS unsigned char* wl, int lane, int b, int h, int c, const bf16_t* Rb, const bf16_t* Kb, const bf16_t* Vb, const bf16_t* DECb, const bf16_t* ASIGb,
                                             const float* k_k, const float* k_a, const float* r_k, float* BON, const RwcImg& I) {
    constexpr int ZS = 68;
    LAS bf16_t* Zi = (LAS bf16_t*)wl; LAS bf16_t* Wi = Zi + 64 * ZS;
    const int rowbase = rwc_rowbase(DIR, b, c), ci = ((DIR * 2 + b) * 16 + h) * RNCH + c, hk = h * 64 + lane;
    const size_t dofs = (size_t)DIR * MROWS * D;
    const float kkw = k_k[hk], kaw = k_a[hk], rkw = r_k[hk];
    const GAS bf16_t* dp = (const GAS bf16_t*)DECb + dofs + (size_t)rowbase * D; const GAS bf16_t* kp = (const GAS bf16_t*)Kb + (size_t)rowbase * D; const GAS bf16_t* rp = (const GAS bf16_t*)Rb + (size_t)rowbase * D;
    const GAS bf16_t* ap = (const GAS bf16_t*)ASIGb + dofs + (size_t)rowbase * D; const GAS bf16_t* vp_ = (const GAS bf16_t*)Vb + (size_t)rowbase * D;
    GAS float* bonp = (GAS float*)BON + ((size_t)DIR * MROWS + rowbase) * RW_H + h;
    GAS bf16_t* rtp = (GAS bf16_t*)I.RT + (size_t)ci * 2048; GAS bf16_t* wpp = (GAS bf16_t*)I.WP + (size_t)ci * 2048; GAS bf16_t* tap = (GAS bf16_t*)I.TA + (size_t)ci * 1024;
    GAS bf16_t* arbp = (GAS bf16_t*)I.ARB + (size_t)ci * 1024; GAS bf16_t* arkp = (GAS bf16_t*)I.ARK + (size_t)ci * 1024;
    const int ks = kslot64(lane);
    float e1v[32]; float run = 0.f;
#pragma unroll
    for (int t = 0; t < 32; ++t) { run += bf2f(dp[t * D + hk]); e1v[t] = run; }
    const float total = run;
    const float cref = DIR ? (total - e1v[15]) : e1v[15];
    const float cC = total;
    if (DIR) {
#pragma unroll
        for (int t = 31; t >= 1; --t) e1v[t] = __expf(total - e1v[t - 1] - cref);
        e1v[0] = __expf(total - cref);
    } else {
#pragma unroll
        for (int t = 0; t < 32; ++t) e1v[t] = __expf(e1v[t] - cref);
    }
    const float ebound = __expf((DIR ? 0.f : 0.f) - cref);
    float xr[32]; unsigned btp[16], ktp[16];
    float btv = 0.f, ktv = 0.f;
    unsigned kq[16], rq[16], aq[16], kn[16], rn[16], an[16];
#pragma unroll
    for (int j = 0; j < 16; ++j) { kq[j] = kp[j * D + hk]; rq[j] = rp[j * D + hk]; aq[j] = ap[j * D + hk]; }
#pragma unroll
    for (int t = 0; t < 32; ++t) {
        if ((t & 15) == 0) { asm volatile("" ::: "memory");
            if (t + 16 < 32) {
#pragma unroll
                for (int j = 0; j < 16; ++j) { const int tn = (t + 16 + j) & 31; kn[j] = kp[tn * D + hk]; rn[j] = rp[tn * D + hk]; an[j] = ap[tn * D + hk]; } }
            asm volatile("" ::: "memory"); }
        const float kx = bf2f(kq[t & 15]), rx = bf2f(rq[t & 15]), as = bf2f(aq[t & 15]);
        const float kk = kx * kkw; const float kkn = kk * __builtin_amdgcn_rcpf(fmaxf(__builtin_amdgcn_sqrtf(wave_sum_dpp(kk * kk)), 1e-12f));
        const float kd = kx * (1.0f + (as - 1.0f) * kaw);
        const float bon = wave_sum_dpp(rx * kd * rkw);
        if (lane == 0) bonp[t * RW_H] = bon;
        const float e1 = e1v[t], e0 = DIR ? (t < 31 ? e1v[t < 31 ? t + 1 : 31] : ebound) : (t > 0 ? e1v[t > 0 ? t - 1 : 0] : ebound), e2 = __builtin_amdgcn_rcpf(e1);
        const float at = -kkn * e0, rt = rx * e1, bt = kkn * as * e2, kt = kd * e2;
        xr[t] = at;
        const unsigned par = pk2(at, rt), pbk = pk2(bt, kt);
        Zi[t * ZS + lane] = (bf16_t)par; Zi[(32 + t) * ZS + lane] = (bf16_t)(par >> 16); Wi[t * ZS + lane] = (bf16_t)pbk; Wi[(32 + t) * ZS + lane] = (bf16_t)(pbk >> 16);
        rtp[t * 64 + ks] = (bf16_t)(par >> 16);
        if (t & 1) { btp[slot32(t - 1) >> 1] = pk2(btv, bt); ktp[slot32(t - 1) >> 1] = pk2(ktv, kt); } else { btv = bt; ktv = kt; }
        if ((t & 15) == 15) {
#pragma unroll
            for (int j = 0; j < 16; ++j) { kq[j] = kn[j]; rq[j] = rn[j]; aq[j] = an[j]; } }
    }
    {   GAS v4u* pb = (GAS v4u*)((GAS bf16_t*)I.BT + (size_t)ci * 2048); GAS v4u* pk = (GAS v4u*)((GAS bf16_t*)I.KT + (size_t)ci * 2048);
#pragma unroll
        for (int q = 0; q < 4; ++q) { pb[lane * 4 + q] = (v4u){btp[4 * q], btp[4 * q + 1], btp[4 * q + 2], btp[4 * q + 3]}; pk[lane * 4 + q] = (v4u){ktp[4 * q], ktp[4 * q + 1], ktp[4 * q + 2], ktp[4 * q + 3]}; } }
    {   GAS float* sc = (GAS float*)I.SC + (size_t)ci * 192; sc[lane] = __expf(cref); sc[64 + lane] = __expf(cC - cref); sc[128 + lane] = __expf(cC); }
    if (DIR == 0) {
        unsigned vp[16]; unsigned vprev = 0u;
#pragma unroll
        for (int t = 0; t < 32; ++t) { const unsigned vv = vp_[t * D + hk]; if (t & 1) vp[slot32(t - 1) >> 1] = vprev | (vv << 16); else vprev = vv; }
        GAS v4u* pv = (GAS v4u*)((GAS bf16_t*)I.VT + ((size_t)h * RW_NTCH + rwc_tokchunk(0, b, c)) * 2048);
#pragma unroll
        for (int q = 0; q < 4; ++q) pv[lane * 4 + q] = (v4u){vp[4 * q], vp[4 * q + 1], vp[4 * q + 2], vp[4 * q + 3]};
    }
    asm volatile("s_waitcnt lgkmcnt(0)" ::: "memory");
    const int fr = lane & 15, fq = lane >> 4;
    f32x4 acc[4][4];
#pragma unroll
    for (int i = 0; i < 4; ++i)
#pragma unroll
        for (int j = 0; j < 4; ++j) acc[i][j] = (f32x4){0.f, 0.f, 0.f, 0.f};
#pragma unroll
    for (int sg = 0; sg < 2; ++sg) { bf16x8 af[4], bfr[4];
#pragma unroll
        for (int i = 0; i < 4; ++i) { const LAS v2u* pa = (const LAS v2u*)(Zi + (16 * i + fr) * ZS + 32 * sg + 8 * fq); const LAS v2u* pb = (const LAS v2u*)(Wi + (16 * i + fr) * ZS + 32 * sg + 8 * fq);
            const v2u a0 = pa[0], a1 = pa[1], b0 = pb[0], b1 = pb[1]; af[i] = __builtin_bit_cast(bf16x8, (v4u){a0.x, a0.y, a1.x, a1.y}); bfr[i] = __builtin_bit_cast(bf16x8, (v4u){b0.x, b0.y, b1.x, b1.y}); }
#pragma unroll
        for (int i = 0; i < 4; ++i)
#pragma unroll
            for (int j = 0; j < 4; ++j) acc[i][j] = __builtin_amdgcn_mfma_f32_16x16x32_bf16(af[i], bfr[j], acc[i][j], 0, 0, 0); }
    asm volatile("s_waitcnt lgkmcnt(0)" ::: "memory");
    LAS float* Aab = (LAS float*)wl; LAS float* Aak = Aab + 32 * 33;
    const int gcol0 = 4 * fq * 32 + slot32(fr), gcol1 = 4 * fq * 32 + slot32(16 + fr);
#pragma unroll
    for (int i = 0; i < 4; ++i)
#pragma unroll
        for (int j = 0; j < 4; ++j)
#pragma unroll
            for (int r = 0; r < 4; ++r) { const int tt = 16 * (i & 1) + 4 * fq + r, ts = 16 * (j & 1) + fr;
                const bool keep = (i < 2) ? (DIR ? ts > tt : ts < tt) : (DIR ? ts >= tt : ts <= tt);
                const float v = keep ? acc[i][j][r] : 0.f;
                if (i < 2) { if (j < 2) Aab[tt * 33 + ts] = v; else Aak[tt * 33 + ts] = v; }
                else { GAS bf16_t* dst = (j < 2) ? arbp : arkp; dst[(16 * (i & 1) + r) * 32 + ((j & 1) ? gcol1 : gcol0)] = (bf16_t)pk2(v, v); } }
    asm volatile("s_waitcnt lgkmcnt(0)" ::: "memory");
    LAS float* X1 = Aak + 32 * 33;
#pragma unroll
    for (int t = 0; t < 32; ++t) X1[t * 64 + lane] = xr[t];
    asm volatile("s_waitcnt lgkmcnt(0)" ::: "memory");
    const int l31 = lane & 31;
#ifdef RWC_NO_T
    for (int st = 1; st < 0; ++st) { const int tt = 0;
#else
#pragma unroll 1
    for (int st = 1; st < 32; ++st) { const int tt = DIR ? 31 - st : st;
#endif
        float s1a = X1[tt * 64 + lane], s2a = Aak[tt * 33 + l31], s1b = 0.f, s2b = 0.f;
        const LAS float* arow = Aab + tt * 33;
        const int nb = (st + 7) >> 3;
#pragma unroll 1
        for (int bq = 0; bq < nb; ++bq) { const int s0 = bq * 8;
            float av[8], x1v[8], x2v[8];
#pragma unroll
            for (int j = 0; j < 8; ++j) { const int ti = DIR ? 31 - (s0 + j) : s0 + j; av[j] = arow[ti]; x1v[j] = X1[ti * 64 + lane]; x2v[j] = Aak[ti * 33 + l31]; }
#pragma unroll
            for (int j = 0; j < 8; j += 2) { s1a += av[j] * x1v[j]; s2a += av[j] * x2v[j]; s1b += av[j + 1] * x1v[j + 1]; s2b += av[j + 1] * x2v[j + 1]; } }
        asm volatile("s_waitcnt lgkmcnt(0)" ::: "memory");
        X1[tt * 64 + lane] = s1a + s1b; if (lane < 32) Aak[tt * 33 + l31] = s2a + s2b;
        asm volatile("s_waitcnt lgkmcnt(0)" ::: "memory"); }
    const int ts32 = slot32(l31);
#pragma unroll 4
    for (int t = 0; t < 32; ++t) { const unsigned pw = pk2(X1[t * 64 + lane], Aak[t * 33 + l31]); wpp[t * 64 + ks] = (bf16_t)pw; if (lane < 32) tap[t * 32 + ts32] = (bf16_t)(pw >> 16); }
    asm volatile("s_waitcnt lgkmcnt(0)" ::: "memory");
}

__device__ __forceinline__ void ph_rwc_prep(const Ctx& C, const bf16_t* Rb, const bf16_t* Kb, const bf16_t* Vb, const bf16_t* DECb, const bf16_t* ASIGb, const float* k_k, const float* k_a, const float* r_k, float* BON, const RwcImg& I) {
    LAS unsigned char* wl = C.lds + C.wave * 17408;
    const int gw = C.bid * NWAVES + C.wave, NGW = C.G * NWAVES;
    for (int it = gw; it < RW_NCHUNKHEAD; it += NGW) {
        const int c = it % RNCH, ch = it / RNCH, h = ch & 15, b = (ch >> 4) & 1, d = ch >> 5;
        if (d == 0) rwc_prep_one<0>(wl, C.lane, b, h, c, Rb, Kb, Vb, DECb, ASIGb, k_k, k_a, r_k, BON, I);
        else rwc_prep_one<1>(wl, C.lane, b, h, c, Rb, Kb, Vb, DECb, ASIGb, k_k, k_a, r_k, BON, I);
    }
}

__device__ __forceinline__ void ph_rwc_scan(const Ctx& C, const RwcImg& I, float* Y) {
    constexpr int S64 = 72, S32 = 40;
    constexpr int O_WP = 0, O_RT = O_WP + 32 * S64, O_BT = O_RT + 32 * S64, O_KT = O_BT + 64 * S32, O_TA = O_KT + 64 * S32, O_ARB = O_TA + 32 * S32, O_ARK = O_ARB + 32 * S32, O_VT = O_ARK + 32 * S32, O_END = O_VT + 32 * S32;
    constexpr int BUFB = O_END * 2 + 768;
    LAS v4u* SF = (LAS v4u*)(C.lds + 3 * BUFB);
    LAS v4u* UF = SF + 2 * 2 * 2 * 64;
    LAS float* ystage = (LAS float*)(UF + 2 * 2 * 64);
    const int tid = C.tid, lane = C.lane, wave = C.wave, fr = lane & 15, fq = lane >> 4;
    for (int item = C.bid; item < 128; item += C.G) {
        const int chain = item >> 1, vh = item & 1, d = chain >> 5, b = (chain >> 4) & 1, h = chain & 15;
        const size_t ci0 = (size_t)chain * RNCH;
        f32x4 ST[4];
#pragma unroll
        for (int i = 0; i < 4; ++i) ST[i] = (f32x4){0.f, 0.f, 0.f, 0.f};
        const int lt = tid & 255, yw = wave & 1;
        const bool is_state = wave < 2, is_y = (wave == 2 || wave == 3), is_ld = wave >= 4;
        v4u gA[7], gB[7], gC[7], gD[7], gE[7], gF[7];
#define RWC_LOAD(cc, g) do { const size_t ci = ci0 + (cc); const int tc = rwc_tokchunk(d, b, (cc)); const int l7 = lt & 127; \
            g[0] = ((const GAS v4u*)((const GAS bf16_t*)I.WP + ci * 2048))[lt]; g[1] = ((const GAS v4u*)((const GAS bf16_t*)I.RT + ci * 2048))[lt]; g[2] = ((const GAS v4u*)((const GAS bf16_t*)I.BT + ci * 2048))[lt]; g[3] = ((const GAS v4u*)((const GAS bf16_t*)I.KT + ci * 2048))[lt]; \
            g[4] = ((const GAS v4u*)((size_t)(lt < 128) * (size_t)((const GAS bf16_t*)I.VT + ((size_t)h * RW_NTCH + tc) * 2048 + vh * 1024) + (size_t)(lt >= 128) * (size_t)((const GAS bf16_t*)I.TA + ci * 1024)))[l7]; \
            g[5] = ((const GAS v4u*)((const GAS bf16_t*)((size_t)(lt < 128) * (size_t)I.ARB + (size_t)(lt >= 128) * (size_t)I.ARK) + ci * 1024))[l7]; \
            g[6] = ((const GAS v4u*)((const GAS float*)I.SC + ci * 192))[lt < 48 ? lt : 0]; } while (0)
#define RWC_STORE(boff, g) do { LAS bf16_t* B = (LAS bf16_t*)(C.lds + (boff)); const int r8 = lt >> 3, c8 = (lt & 7) * 8, r4 = lt >> 2, c4 = (lt & 3) * 8, r4b = (lt & 127) >> 2; \
            *(LAS v4u*)(B + O_WP + r8 * S64 + c8) = g[0]; *(LAS v4u*)(B + O_RT + r8 * S64 + c8) = g[1]; *(LAS v4u*)(B + O_BT + r4 * S32 + c4) = g[2]; *(LAS v4u*)(B + O_KT + r4 * S32 + c4) = g[3]; \
            *(LAS v4u*)(B + (lt < 128 ? O_VT : O_TA) + r4b * S32 + c4) = g[4]; *(LAS v4u*)(B + (lt < 128 ? O_ARB : O_ARK) + r4b * S32 + c4) = g[5]; \
            if (lt < 48) *(LAS v4u*)((LAS float*)(B + O_END) + lt * 4) = g[6]; } while (0)
        auto slice = [&](int cc, int boff) {
            const LAS bf16_t* B = (const LAS bf16_t*)(C.lds + boff); const LAS float* sc = (const LAS float*)(B + O_END);
            f32x4 ec[2][2], e2[4], pc[4]; bf16x8 fW[2][2], fT[2], fB[4], fK[4];
#pragma unroll
            for (int sg = 0; sg < 2; ++sg) { ec[sg][0] = *(const LAS f32x4*)(sc + 32 * sg + 4 * fq); ec[sg][1] = *(const LAS f32x4*)(sc + 32 * sg + 16 + 4 * fq); }
            const bf16x8 vfrag = *(const LAS bf16x8*)(B + O_VT + (16 * wave + fr) * S32 + 8 * fq);
#pragma unroll
            for (int ti = 0; ti < 2; ++ti) { fW[ti][0] = *(const LAS bf16x8*)(B + O_WP + (16 * ti + fr) * S64 + 8 * fq); fW[ti][1] = *(const LAS bf16x8*)(B + O_WP + (16 * ti + fr) * S64 + 32 + 8 * fq); fT[ti] = *(const LAS bf16x8*)(B + O_TA + (16 * ti + fr) * S32 + 8 * fq); }
#pragma unroll
            for (int i = 0; i < 4; ++i) { fB[i] = *(const LAS bf16x8*)(B + O_BT + (16 * i + fr) * S32 + 8 * fq); fK[i] = *(const LAS bf16x8*)(B + O_KT + (16 * i + fr) * S32 + 8 * fq);
                e2[i] = *(const LAS f32x4*)(sc + 64 + 16 * i + 4 * fq); pc[i] = *(const LAS f32x4*)(sc + 128 + 16 * i + 4 * fq); }
            __builtin_amdgcn_sched_barrier(0);
            bf16x8 sfrag[2];
#pragma unroll
            for (int sg = 0; sg < 2; ++sg) { const f32x4 s0 = ST[2 * sg] * ec[sg][0], s1 = ST[2 * sg + 1] * ec[sg][1];
                v4u w; w.x = pk2(s0[0], s0[1]); w.y = pk2(s0[2], s0[3]); w.z = pk2(s1[0], s1[1]); w.w = pk2(s1[2], s1[3]); sfrag[sg] = __builtin_bit_cast(bf16x8, w);
                SF[(((cc & 1) * 2 + wave) * 2 + sg) * 64 + lane] = w; }
            f32x4 U[2];
#pragma unroll
            for (int ti = 0; ti < 2; ++ti) { f32x4 u = (f32x4){0.f, 0.f, 0.f, 0.f};
                u = __builtin_amdgcn_mfma_f32_16x16x32_bf16(fT[ti], vfrag, u, 0, 0, 0);
                u = __builtin_amdgcn_mfma_f32_16x16x32_bf16(fW[ti][0], sfrag[0], u, 0, 0, 0);
                U[ti] = __builtin_amdgcn_mfma_f32_16x16x32_bf16(fW[ti][1], sfrag[1], u, 0, 0, 0); }
            bf16x8 ufrag; { v4u w; w.x = pk2(U[0][0], U[0][1]); w.y = pk2(U[0][2], U[0][3]); w.z = pk2(U[1][0], U[1][1]); w.w = pk2(U[1][2], U[1][3]); ufrag = __builtin_bit_cast(bf16x8, w); UF[((cc & 1) * 2 + wave) * 64 + lane] = w; }
#pragma unroll
            for (int i = 0; i < 4; ++i) { f32x4 n = (f32x4){0.f, 0.f, 0.f, 0.f};
                n = __builtin_amdgcn_mfma_f32_16x16x32_bf16(fK[i], vfrag, n, 0, 0, 0);
                n = __builtin_amdgcn_mfma_f32_16x16x32_bf16(fB[i], ufrag, n, 0, 0, 0);
                ST[i] = ST[i] * pc[i] + n * e2[i]; }
        };
        auto youts = [&](int cc, int boff) {
            const LAS bf16_t* B = (const LAS bf16_t*)(C.lds + boff);
            const bf16x8 vfrag = *(const LAS bf16x8*)(B + O_VT + (16 * yw + fr) * S32 + 8 * fq);
            const bf16x8 s0 = __builtin_bit_cast(bf16x8, SF[(((cc & 1) * 2 + yw) * 2 + 0) * 64 + lane]), s1 = __builtin_bit_cast(bf16x8, SF[(((cc & 1) * 2 + yw) * 2 + 1) * 64 + lane]);
            const bf16x8 ufrag = __builtin_bit_cast(bf16x8, UF[((cc & 1) * 2 + yw) * 64 + lane]);
            bf16x8 fR[2][2], fRB[2], fRK[2];
#pragma unroll
            for (int ti = 0; ti < 2; ++ti) { fR[ti][0] = *(const LAS bf16x8*)(B + O_RT + (16 * ti + fr) * S64 + 8 * fq); fR[ti][1] = *(const LAS bf16x8*)(B + O_RT + (16 * ti + fr) * S64 + 32 + 8 * fq);
                fRB[ti] = *(const LAS bf16x8*)(B + O_ARB + (16 * ti + fr) * S32 + 8 * fq); fRK[ti] = *(const LAS bf16x8*)(B + O_ARK + (16 * ti + fr) * S32 + 8 * fq); }
            __builtin_amdgcn_sched_barrier(0);
#pragma unroll
            for (int ti = 0; ti < 2; ++ti) { f32x4 y = (f32x4){0.f, 0.f, 0.f, 0.f};
                y = __builtin_amdgcn_mfma_f32_16x16x32_bf16(fRK[ti], vfrag, y, 0, 0, 0);
                y = __builtin_amdgcn_mfma_f32_16x16x32_bf16(fR[ti][0], s0, y, 0, 0, 0);
                y = __builtin_amdgcn_mfma_f32_16x16x32_bf16(fR[ti][1], s1, y, 0, 0, 0);
                y = __builtin_amdgcn_mfma_f32_16x16x32_bf16(fRB[ti], ufrag, y, 0, 0, 0);
#pragma unroll
                for (int r = 0; r < 4; ++r) ystage[(cc & 1) * 1024 + (16 * ti + 4 * fq + r) * 32 + 16 * yw + fr] = y[r]; }
        };
        f32x4 yfA = (f32x4){0.f, 0.f, 0.f, 0.f}, yfB = yfA;
#define RWC_YFLUSH(cc, yf) do { yf = *(const LAS f32x4*)(ystage + ((cc) & 1) * 1024 + (lt >> 3) * 32 + (lt & 7) * 4); \
            *(GAS f32x4*)((GAS float*)Y + ((size_t)d * MROWS + rwc_rowbase(d, b, (cc)) + (lt >> 3)) * D + h * 64 + 32 * vh + (lt & 7) * 4) = yf; } while (0)
        if (is_state) {
            SCAN_BAR();
            int bcur = 0;
#pragma unroll 1
            for (int cc = 0; cc < RNCH; ++cc) { slice(cc, bcur); SCAN_BAR(); bcur = (bcur == 2 * BUFB) ? 0 : bcur + BUFB; }
            SCAN_BAR(); SCAN_BAR();
        } else if (is_y) {
            SCAN_BAR();
            int bprev = 2 * BUFB;
#pragma unroll 1
            for (int cc = 0; cc < RNCH; ++cc) { if (cc >= 1) youts(cc - 1, bprev); SCAN_BAR(); bprev = (bprev == 2 * BUFB) ? 0 : bprev + BUFB; }
            youts(RNCH - 1, bprev); SCAN_BAR(); SCAN_BAR();
        } else {
            RWC_LOAD(0, gA); RWC_STORE(0, gA); RWC_LOAD(1, gB); RWC_LOAD(2, gC); RWC_LOAD(3, gD); RWC_LOAD(4, gE); RWC_LOAD(5, gF); RWC_LOAD(6, gA);
            SCAN_BAR();
            int bnext = BUFB;
#define RWC_LSTEP(cc, g, yf, yfo) do { if ((cc) + 1 < RNCH) { RWC_STORE(bnext, g); if ((cc) + 7 < RNCH) RWC_LOAD((cc) + 7, g); } asm volatile("" :: "v"(yfo)); if ((cc) >= 2) RWC_YFLUSH((cc) - 2, yf); \
                SCAN_BAR(); bnext = (bnext == 2 * BUFB) ? 0 : bnext + BUFB; } while (0)
            static_assert(RNCH % 6 == 4, "loop shape");
#pragma unroll 1
            for (int cc = 0; cc + 5 < RNCH; cc += 6) { RWC_LSTEP(cc, gB, yfA, yfB); RWC_LSTEP(cc + 1, gC, yfB, yfA); RWC_LSTEP(cc + 2, gD, yfA, yfB); RWC_LSTEP(cc + 3, gE, yfB, yfA); RWC_LSTEP(cc + 4, gF, yfA, yfB); RWC_LSTEP(cc + 5, gA, yfB, yfA); }
            RWC_LSTEP(RNCH - 4, gB, yfA, yfB); RWC_LSTEP(RNCH - 3, gC, yfB, yfA); RWC_LSTEP(RNCH - 2, gD, yfA, yfB); RWC_LSTEP(RNCH - 1, gE, yfB, yfA);
#undef RWC_LSTEP
            RWC_YFLUSH(RNCH - 2, yfA); SCAN_BAR();
            RWC_YFLUSH(RNCH - 1, yfB); SCAN_BAR();
        }
#undef RWC_YFLUSH
#undef RWC_LOAD
#undef RWC_STORE
    }
}
constexpr int HG_H = 8, HG_DK = 128;
__device__ __forceinline__ void ph_hg_lb(const Ctx& C, const float* hg_lb, int layer, float* LB) {
    for (int i = C.bid * NTHR + C.tid; i < 2 * D; i += C.G * NTHR) {
        float x[DEPTH], mx = -3.0e38f;
#pragma unroll
        for (int l = 0; l < DEPTH; ++l) { x[l] = hg_lb[(size_t)l * 2 * D + i]; mx = fmaxf(mx, x[l]); }
        float den = 0.f, num = 0.f;
#pragma unroll
        for (int l = 0; l < DEPTH; ++l) { const float e = __expf(x[l] - mx); den += e; if (l >= 1 && l <= layer) num += e; }
        LB[i] = num / den;
    }
}
struct EpiHg {
    static constexpr bool PERM = false;
    bf16_t* QVG; float* FG; const float* LB;
    __device__ __forceinline__ void operator()(const AccT& acc, const Unit& u, int wr, int wc, int fr, int fq) const {
        const int row0 = u.pm * 256 + wr * 64 + fr, grp = u.pn >> 2, colt = (u.pn & 3) * 256 + wc * 32 + 4 * fq;
        const int isf = (grp == 1 || grp == 2) ? 1 : 0, d = grp == 2 ? 1 : 0, bsel = grp == 0 ? 0 : (grp == 3 ? 1 : 2), act = grp != 3;
#pragma unroll
        for (int ai = 0; ai < 2; ++ai)
#pragma unroll
            for (int m = 0; m < 4; ++m) { const size_t row = (size_t)(row0 + ai * 128 + m * 16);
#pragma unroll
                for (int bj = 0; bj < 2; ++bj)
#pragma unroll
                    for (int n = 0; n < 2; ++n) { const int col = colt + bj * 128 + n * 16; const f32x4 x = acc[ai][bj][m][n];
                        if (isf) { const f32x4 lb = *(const GAS f32x4*)((const GAS float*)LB + d * D + col); f32x4 o;
#pragma unroll
                            for (int j = 0; j < 4; ++j) o[j] = lb[j] + (1.0f - lb[j]) * sigmoidf_(x[j]);
                            *(GAS f32x4*)((GAS float*)FG + ((size_t)d * MROWS + row) * D + col) = o; }
                        else { v2u w; if (act) { w.x = pk2(siluf_(x[0]), siluf_(x[1])); w.y = pk2(siluf_(x[2]), siluf_(x[3])); } else { w.x = pk2(x[0], x[1]); w.y = pk2(x[2], x[3]); }
                            *(GAS v2u*)((GAS bf16_t*)QVG + ((size_t)bsel * MROWS + row) * D + col) = w; } }
                asm volatile("" ::: "memory"); }
    }
};
__device__ __forceinline__ void ph_hg_scan_seq(const Ctx& C, const bf16_t* QVG, const float* FG, float* O) {
    constexpr int T = 32;
    LAS float* sf = (LAS float*)C.lds;
    LAS float* sk = sf + T * 128; LAS float* sq = sk + T * 128; LAS float* sv = sq + T * 128; LAS float* so = sv + T * 64;
    const bf16_t* Qb = QVG; const bf16_t* Vb = QVG + (size_t)MROWS * D;
    for (int item = C.bid; item < 64; item += C.G) {
        const int chain = item >> 1, vh = item & 1, d = chain >> 4, b = (chain >> 3) & 1, h = chain & 7;
        const int v = C.tid >> 3, seg = C.tid & 7;
        float S[16];
#pragma unroll
        for (int j = 0; j < 16; ++j) S[j] = 0.f;
        for (int s0 = 0; s0 < NSTEP; s0 += T) {
            for (int i = C.tid; i < T * 128; i += NTHR) { const int tt = i >> 7, c = i & 127; const int row = rw_step_row(d, b, s0 + tt); const size_t o = (size_t)row * D + h * 128 + c;
                const float f = ((const GAS float*)FG)[(size_t)d * MROWS * D + o]; sf[i] = f; sk[i] = 1.0f - f; sq[i] = bf2f(((const GAS bf16_t*)Qb)[o]);
                if ((c >> 6) == vh) sv[tt * 64 + (c & 63)] = bf2f(((const GAS bf16_t*)Vb)[o]); }
            __syncthreads();
#pragma unroll 2
            for (int tt = 0; tt < T; ++tt) {
                const LAS f32x4* pf = (const LAS f32x4*)(sf + tt * 128 + seg * 16); const LAS f32x4* pk = (const LAS f32x4*)(sk + tt * 128 + seg * 16); const LAS f32x4* pq = (const LAS f32x4*)(sq + tt * 128 + seg * 16);
                const float vv = sv[tt * 64 + v]; float y = 0.f;
#pragma unroll
                for (int jj = 0; jj < 4; ++jj) { const f32x4 f = pf[jj], k = pk[jj], q = pq[jj];
#pragma unroll
                    for (int i = 0; i < 4; ++i) { S[4 * jj + i] = S[4 * jj + i] * f[i] + k[i] * vv; y += S[4 * jj + i] * q[i]; } }
                y = sum8(y);
                if (seg == 0) so[tt * 64 + v] = y;
            }
            __syncthreads();
            for (int i = C.tid; i < T * 64; i += NTHR) { const int tt = i >> 6, c = i & 63; const int row = rw_step_row(d, b, s0 + tt); ((GAS float*)O)[((size_t)d * MROWS + row) * D + h * 128 + vh * 64 + c] = so[i]; }
            __syncthreads();
        }
    }
}
__device__ __forceinline__ void ph_hg_scan_v2(const Ctx& C, const bf16_t* QVG, const float* FG, float* O) {
    constexpr int T = 32, NCH = NSTEP / T, BUF = 2 * T * 128 + T * 16;
    LAS float* base = (LAS float*)C.lds;
    LAS float* syb = base + 2 * BUF;
    const bf16_t* Qb = QVG; const bf16_t* Vb = QVG + (size_t)MROWS * D;
    for (int item = C.bid; item < 256; item += C.G) {
        const int chain = item >> 3, ve = item & 7, d = chain >> 4, b = (chain >> 3) & 1, h = chain & 7;
        const bool producer = C.wave >= 4;
        const int vl = (C.tid & 255) >> 4, seg = C.tid & 15, pw = C.wave - 4;
        float S[8];
#pragma unroll
        for (int j = 0; j < 8; ++j) S[j] = 0.f;
        float f0[8], f1[8]; unsigned q0[8], q1[8], vx[8];
        auto pload = [&](int cc) {
#pragma unroll
            for (int q = 0; q < 8; ++q) { const int row = rw_step_row(d, b, cc * T + pw * 8 + q); const size_t o = (size_t)row * D + h * 128 + C.lane;
                f0[q] = ((const GAS float*)FG)[(size_t)d * MROWS * D + o]; f1[q] = ((const GAS float*)FG)[(size_t)d * MROWS * D + o + 64];
                q0[q] = ((const GAS bf16_t*)Qb)[o]; q1[q] = ((const GAS bf16_t*)Qb)[o + 64];
                vx[q] = ((const GAS bf16_t*)Vb)[(size_t)row * D + h * 128 + ve * 16 + (C.lane & 15)]; }
        };
        auto pemit = [&](int cc) {
            LAS float* bf = base + (cc & 1) * BUF; LAS float* bq = bf + T * 128; LAS float* bv = bq + T * 128;
#pragma unroll
            for (int q = 0; q < 8; ++q) { const int tt = pw * 8 + q; bf[tt * 128 + C.lane] = f0[q]; bf[tt * 128 + 64 + C.lane] = f1[q]; bq[tt * 128 + C.lane] = bf2f(q0[q]); bq[tt * 128 + 64 + C.lane] = bf2f(q1[q]); if (C.lane < 16) bv[tt * 16 + C.lane] = bf2f(vx[q]); }
        };
        auto flush = [&](int cc) {
            const LAS float* sy = syb + (cc & 1) * T * 16; const int i0 = C.tid - 256;
#pragma unroll
            for (int q = 0; q < 2; ++q) { const int i = i0 + 256 * q, tt = i >> 4, c = i & 15; const int row = rw_step_row(d, b, cc * T + tt); ((GAS float*)O)[((size_t)d * MROWS + row) * D + h * 128 + ve * 16 + c] = sy[i]; }
        };
        if (producer) { pload(0); pemit(0); pload(1); }
        SCAN_BAR();
        for (int cc = 0; cc < NCH; ++cc) {
            if (producer) { if (cc + 1 < NCH) { pemit(cc + 1); if (cc + 2 < NCH) pload(cc + 2); } if (cc >= 1) flush(cc - 1); }
            else {
                const LAS float* bf = base + (cc & 1) * BUF; const LAS float* bq = bf + T * 128; const LAS float* bv = bq + T * 128;
                LAS float* sy = syb + (cc & 1) * T * 16;
                f32x4 fa = *(const LAS f32x4*)(bf + seg * 8), fb = *(const LAS f32x4*)(bf + seg * 8 + 4), qa = *(const LAS f32x4*)(bq + seg * 8), qb = *(const LAS f32x4*)(bq + seg * 8 + 4);
                float vv = bv[vl];
#pragma unroll 8
                for (int tt = 0; tt < T; ++tt) {
                    const int tn = (tt + 1 < T) ? tt + 1 : tt;
                    const f32x4 fan = *(const LAS f32x4*)(bf + tn * 128 + seg * 8), fbn = *(const LAS f32x4*)(bf + tn * 128 + seg * 8 + 4), qan = *(const LAS f32x4*)(bq + tn * 128 + seg * 8), qbn = *(const LAS f32x4*)(bq + tn * 128 + seg * 8 + 4);
                    const float vvn = bv[tn * 16 + vl];
#pragma unroll
                    for (int i = 0; i < 4; ++i) { S[i] = S[i] * fa[i] + (1.0f - fa[i]) * vv; S[4 + i] = S[4 + i] * fb[i] + (1.0f - fb[i]) * vv; }
                    float y = ((S[0] * qa.x + S[1] * qa.y) + (S[2] * qa.z + S[3] * qa.w)) + ((S[4] * qb.x + S[5] * qb.y) + (S[6] * qb.z + S[7] * qb.w));
                    y = sum16(y);
                    sy[tt * 16 + vl] = y;
                    fa = fan; fb = fbn; qa = qan; qb = qbn; vv = vvn;
                }
            }
            SCAN_BAR();
        }
        if (producer) flush(NCH - 1);
        SCAN_BAR();
    }
}
__device__ __forceinline__ void ph_hg_scan_chunk(const Ctx& C, const bf16_t* QVG, const float* FG, float* O, const int only_d0 = 0) {
    constexpr int CH = 32, NCH = NSTEP / CH, RS = 136, TS = 40;
    constexpr int IMG = 3 * CH * RS + 128 * TS + 64 * TS;
    constexpr int SETB = IMG * 2 + 2048 + 512;
    LAS float* gt = (LAS float*)(C.lds + 2 * SETB);
    LAS float* ostage = gt + 8 * 128;
    const bf16_t* Qb = QVG; const bf16_t* Vb = QVG + (size_t)MROWS * D;
    const int tid = C.tid, lane = C.lane, wave = C.wave, fr = lane & 15, fq = lane >> 4;
    for (int item = C.bid; item < 64; item += C.G) {
        const int chain = item >> 1, vh = item & 1, d = chain >> 4, b = (chain >> 3) & 1, h = chain & 7;
        if (only_d0 && d != 0) continue;
        const int kp = tid & 63, k0 = 2 * kp, ptg = tid >> 6;
        const int pv = tid & 31, pvg = tid >> 5;
        f32x4 ST[8];
#pragma unroll
        for (int i = 0; i < 8; ++i) ST[i] = (f32x4){0.f, 0.f, 0.f, 0.f};
        f32x2 fxA[4], fxB[4]; unsigned qxA[4], qxB[4]; unsigned vxA[2], vxB[2];
#define HG_PLOAD(cc, fx, qx, vx) do { _Pragma("unroll") for (int i = 0; i < 4; ++i) { const int row = rw_step_row(d, b, (cc) * CH + ptg * 4 + i); const size_t o = (size_t)row * D + h * 128; \
            fx[i] = *(const GAS f32x2*)((const GAS float*)FG + (size_t)d * MROWS * D + o + k0); qx[i] = *(const GAS unsigned*)((const GAS bf16_t*)Qb + o + k0); } \
            _Pragma("unroll") for (int i = 0; i < 2; ++i) { const int row = rw_step_row(d, b, (cc) * CH + pvg * 2 + i); vx[i] = *(const GAS unsigned*)((const GAS bf16_t*)Vb + (size_t)row * D + h * 128 + vh * 64 + 2 * pv); } } while (0)
#define HG_PREP(cc, fx, qx, vx) do { \
            LAS bf16_t* QH = (LAS bf16_t*)(C.lds + ((cc) & 1) * SETB); LAS bf16_t* QT = QH + CH * RS; LAS bf16_t* KN = QT + CH * RS; LAS bf16_t* KT = KN + CH * RS; LAS bf16_t* VT = KT + 128 * TS; LAS float* ac = (LAS float*)(VT + 64 * TS) + 512; \
            f32x2 g[4], cs = (f32x2){0.f, 0.f}; \
            _Pragma("unroll") for (int i = 0; i < 4; ++i) { cs.x += __logf(fx[i].x); cs.y += __logf(fx[i].y); g[i] = cs; } \
            *(LAS f32x2*)(gt + ptg * 128 + k0) = cs; \
            { *(LAS unsigned*)(VT + (2 * pv) * TS + slot32(pvg * 2)) = (vx[0] & 0xffffu) | (vx[1] << 16); *(LAS unsigned*)(VT + (2 * pv + 1) * TS + slot32(pvg * 2)) = (vx[0] >> 16) | (vx[1] & 0xffff0000u); } \
            SCAN_BAR(); \
            { f32x2 off = (f32x2){0.f, 0.f}, gref = off, gc = off; \
              _Pragma("unroll") for (int q = 0; q < 8; ++q) { const f32x2 t = *(const LAS f32x2*)(gt + q * 128 + k0); if (q < ptg) off += t; if (q < 4) gref += t; gc += t; } \
              const f32x2 egref = (f32x2){__expf(gref.x), __expf(gref.y)}, egc = (f32x2){__expf(gc.x - gref.x), __expf(gc.y - gref.y)}; unsigned kt0[2], kt1[2]; float ka[4], kb[4]; \
              const int qhp = (k0 & ~31) + slot32(k0 & 31); \
              _Pragma("unroll") for (int i = 0; i < 4; ++i) { const int t = ptg * 4 + i; const f32x2 G = off + g[i]; \
                  const float e1x = __expf(G.x - gref.x), e1y = __expf(G.y - gref.y), e2x = __builtin_amdgcn_rcpf(e1x), e2y = __builtin_amdgcn_rcpf(e1y); \
                  const float qx_ = bflo(qx[i]), qy_ = bfhi(qx[i]), kx_ = 1.0f - fx[i].x, ky_ = 1.0f - fx[i].y; \
                  *(LAS unsigned*)(QT + t * RS + k0) = pk2(qx_ * e1x, qy_ * e1y); *(LAS unsigned*)(QH + t * RS + qhp) = pk2(qx_ * e1x * egref.x, qy_ * e1y * egref.y); *(LAS unsigned*)(KN + t * RS + k0) = pk2(kx_ * e2x, ky_ * e2y); \
                  ka[i] = kx_ * e2x * egc.x; kb[i] = ky_ * e2y * egc.y; } \
              { v2u w; w.x = pk2(ka[0], ka[1]); w.y = pk2(ka[2], ka[3]); *(LAS v2u*)(KT + k0 * TS + slot32(ptg * 4)) = w; w.x = pk2(kb[0], kb[1]); w.y = pk2(kb[2], kb[3]); *(LAS v2u*)(KT + (k0 + 1) * TS + slot32(ptg * 4)) = w; } \
              if (ptg == 7) { *(LAS f32x2*)(ac + k0) = egref * egc; } } \
            SCAN_BAR(); } while (0)
        HG_PLOAD(0, fxA, qxA, vxA); HG_PLOAD(1, fxB, qxB, vxB);
        HG_PREP(0, fxA, qxA, vxA); HG_PLOAD(2, fxA, qxA, vxA);
        auto helper = [&](int cc) {
            const LAS bf16_t* QH = (const LAS bf16_t*)(C.lds + (cc & 1) * SETB); const LAS bf16_t* QT = QH + CH * RS; const LAS bf16_t* KN = QT + CH * RS; LAS v4u* PF = (LAS v4u*)(KN + CH * RS + 128 * TS + 64 * TS);
            const int ti = wave - 4;
            f32x4 p0 = (f32x4){0.f, 0.f, 0.f, 0.f}, p1 = p0;
#pragma unroll
            for (int sg = 0; sg < 4; ++sg) { const bf16x8 bq = *(const LAS bf16x8*)(QT + (16 * ti + fr) * RS + 32 * sg + 8 * fq);
                const bf16x8 a0 = *(const LAS bf16x8*)(KN + fr * RS + 32 * sg + 8 * fq); p0 = __builtin_amdgcn_mfma_f32_16x16x32_bf16(a0, bq, p0, 0, 0, 0);
                if (ti == 1) { const bf16x8 a1 = *(const LAS bf16x8*)(KN + (16 + fr) * RS + 32 * sg + 8 * fq); p1 = __builtin_amdgcn_mfma_f32_16x16x32_bf16(a1, bq, p1, 0, 0, 0); } }
            v4u w; float m[4];
            if (ti == 0) {
#pragma unroll
                for (int r = 0; r < 4; ++r) m[r] = (4 * fq + r <= fr) ? p0[r] : 0.f;
                w.x = pk2(m[0], m[1]); w.y = pk2(m[2], m[3]); w.z = 0u; w.w = 0u; }
            else {
#pragma unroll
                for (int r = 0; r < 4; ++r) m[r] = (4 * fq + r <= fr) ? p1[r] : 0.f;
                w.x = pk2(p0[0], p0[1]); w.y = pk2(p0[2], p0[3]); w.z = pk2(m[0], m[1]); w.w = pk2(m[2], m[3]); }
            PF[ti * 64 + lane] = w;
        };
        auto slice = [&](int cc) {
            const LAS bf16_t* QH = (const LAS bf16_t*)(C.lds + (cc & 1) * SETB); const LAS bf16_t* KT = QH + 3 * CH * RS; const LAS bf16_t* VT = KT + 128 * TS; const LAS v4u* PF = (const LAS v4u*)(VT + 64 * TS); const LAS float* ac = (const LAS float*)PF + 512;
            const bf16x8 vfrag = *(const LAS bf16x8*)(VT + (16 * wave + fr) * TS + 8 * fq);
            bf16x8 sfrag[4];
#pragma unroll
            for (int sg = 0; sg < 4; ++sg) { v4u w; w.x = pk2(ST[2 * sg][0], ST[2 * sg][1]); w.y = pk2(ST[2 * sg][2], ST[2 * sg][3]); w.z = pk2(ST[2 * sg + 1][0], ST[2 * sg + 1][1]); w.w = pk2(ST[2 * sg + 1][2], ST[2 * sg + 1][3]); sfrag[sg] = __builtin_bit_cast(bf16x8, w); }
#pragma unroll
            for (int ti = 0; ti < 2; ++ti) { f32x4 o = (f32x4){0.f, 0.f, 0.f, 0.f};
#pragma unroll
                for (int sg = 0; sg < 4; ++sg) { const bf16x8 a = *(const LAS bf16x8*)(QH + (16 * ti + fr) * RS + 32 * sg + 8 * fq); o = __builtin_amdgcn_mfma_f32_16x16x32_bf16(a, sfrag[sg], o, 0, 0, 0); }
                const bf16x8 pa = __builtin_bit_cast(bf16x8, PF[ti * 64 + lane]);
                o = __builtin_amdgcn_mfma_f32_16x16x32_bf16(pa, vfrag, o, 0, 0, 0);
#pragma unroll
                for (int r = 0; r < 4; ++r) ostage[(cc & 1) * 2048 + (16 * ti + 4 * fq + r) * 64 + 16 * wave + fr] = o[r]; }
#pragma unroll
            for (int i = 0; i < 8; ++i) { const f32x4 av = *(const LAS f32x4*)(ac + 16 * i + 4 * fq); const bf16x8 a = *(const LAS bf16x8*)(KT + (16 * i + fr) * TS + 8 * fq);
                ST[i] = __builtin_amdgcn_mfma_f32_16x16x32_bf16(a, vfrag, ST[i] * av, 0, 0, 0); }
        };
        auto oflush = [&](int cc) {
            const int ft = tid - 384;
#pragma unroll
            for (int q = 0; q < 4; ++q) { const int idx = ft + 128 * q, t = idx >> 4, c4 = idx & 15; const int row = rw_step_row(d, b, cc * CH + t);
                *(GAS f32x4*)((GAS float*)O + ((size_t)d * MROWS + row) * D + h * 128 + vh * 64 + 4 * c4) = *(const LAS f32x4*)(ostage + (cc & 1) * 2048 + t * 64 + 4 * c4); }
        };
        if (wave == 4 || wave == 5) helper(0);
        SCAN_BAR();
        for (int cc = 0; cc < NCH; cc += 2) {
            if (cc + 1 < NCH) { HG_PREP(cc + 1, fxB, qxB, vxB); if (cc + 3 < NCH) HG_PLOAD(cc + 3, fxB, qxB, vxB); }
            if (wave < 4) slice(cc); else if ((wave == 4 || wave == 5) && cc + 1 < NCH) helper(cc + 1); else if (wave >= 6 && cc >= 1) oflush(cc - 1);
            SCAN_BAR();
            if (cc + 1 < NCH) {
                if (cc + 2 < NCH) { HG_PREP(cc + 2, fxA, qxA, vxA); if (cc + 4 < NCH) HG_PLOAD(cc + 4, fxA, qxA, vxA); }
                if (wave < 4) slice(cc + 1); else if ((wave == 4 || wave == 5) && cc + 2 < NCH) helper(cc + 2); else if (wave >= 6) oflush(cc);
                SCAN_BAR();
            }
        }
        if (wave >= 6) oflush(NCH - 1);
        SCAN_BAR();
#undef HG_PLOAD
#undef HG_PREP
    }
}
__device__ __forceinline__ void ph_hg_post(const Ctx& C, const float* O, const bf16_t* GS, const float* gn, bf16_t* YB) {
    const int gw = C.bid * NWAVES + C.wave, NGW = C.G * NWAVES, lane = C.lane;
    for (int r = gw; r < MROWS; r += NGW) {
        const GAS f32x4* o0 = (const GAS f32x4*)(O + (size_t)r * D) + lane; const GAS f32x4* o1 = (const GAS f32x4*)(O + ((size_t)MROWS + r) * D) + lane;
#pragma unroll
        for (int j = 0; j < 4; ++j) {
            const f32x4 y = o0[64 * j] + o1[64 * j];
            float q = (y.x * y.x + y.y * y.y) + (y.z * y.z + y.w * y.w);
            q += __shfl_xor(q, 1); q += __shfl_xor(q, 2); q += __shfl_xor(q, 4); q += __shfl_xor(q, 8); q += __shfl_xor(q, 16);
            const float rs = 1.0f / sqrtf(q * (1.0f / 128.0f) + NORM_EPS);
            const f32x4 gw4 = ((const GAS f32x4*)gn)[(lane & 31)];
            const v2u gg = ((const GAS v2u*)(GS + (size_t)r * D) + lane)[64 * j];
            const f32x4 gf = (f32x4){bflo(gg.x), bfhi(gg.x), bflo(gg.y), bfhi(gg.y)};
            const f32x4 o = y * rs * gw4 * gf;
            v2u w; w.x = pk2(o.x, o.y); w.y = pk2(o.z, o.w); ((GAS v2u*)(YB + (size_t)r * D) + lane)[64 * j] = w;
        }
    }
}

__device__ __forceinline__ void ph_diff(const Ctx& C, const float* A, const float* B, size_t n, unsigned* res) {
    float md = 0.f, ma = 0.f;
    for (size_t i = (size_t)C.bid * NTHR + C.tid; i < n; i += (size_t)C.G * NTHR) { const float a = A[i], b = B[i]; md = fmaxf(md, fabsf(a - b)); ma = fmaxf(ma, fabsf(a)); }
#pragma unroll
    for (int o = 1; o < 64; o <<= 1) { md = fmaxf(md, __shfl_xor(md, o)); ma = fmaxf(ma, __shfl_xor(ma, o)); }
    if (C.lane == 0) { atomicMax(res, __builtin_bit_cast(unsigned, md)); atomicMax(res + 1, __builtin_bit_cast(unsigned, ma)); }
}
constexpr int HGC_NITEM = 32 * RNCH;
struct HgImg { bf16_t* QT; v4u* PF; bf16_t* KT; float* SC; bf16_t* VT; };
__device__ __forceinline__ int kslot128(int k) { return (k & 96) | slot32(k & 31); }

template <int DIR>
__device__ __forceinline__ void hgc_prep_one(LAS unsigned char* wl, int lane, int b, int h, int c, const bf16_t* Qb, const bf16_t* Vb, const float* FGd, const HgImg& I) {
    constexpr int LS = 136; LAS bf16_t* QL = (LAS bf16_t*)wl; LAS bf16_t* KL = QL + 32 * LS;
    const int rowbase = rwc_rowbase(DIR, b, c), ci = ((DIR * 2 + b) * 8 + h) * RNCH + c, k0 = 2 * lane;
    const GAS float* fp = (const GAS float*)FGd + (size_t)rowbase * D + h * 128 + k0;
    const GAS bf16_t* qp = (const GAS bf16_t*)Qb + (size_t)rowbase * D + h * 128 + k0;
    GAS bf16_t* qtp = (GAS bf16_t*)I.QT + (size_t)ci * 4096 + kslot128(k0);
    f32x2 fv[32], P[32]; unsigned qv[32];
#pragma unroll
    for (int t = 0; t < 32; ++t) { fv[t] = *(const GAS f32x2*)(fp + t * D); qv[t] = *(const GAS unsigned*)(qp + t * D); }
    f32x2 run = (f32x2){0.f, 0.f};
#pragma unroll
    for (int t = 0; t < 32; ++t) { run.x += __logf(fv[t].x); run.y += __logf(fv[t].y); P[t] = run; }
    const f32x2 total = run, gref = DIR ? (total - P[15]) : P[15];
    unsigned kta[16], ktb[16]; f32x2 kprev = (f32x2){0.f, 0.f};
#pragma unroll
    for (int t = 0; t < 32; ++t) {
        const f32x2 pm1 = t ? P[t ? t - 1 : 0] : (f32x2){0.f, 0.f}; const f32x2 cum = DIR ? (total - pm1) : P[t];
        const float e1x = __expf(cum.x - gref.x), e1y = __expf(cum.y - gref.y), e2x = __builtin_amdgcn_rcpf(e1x), e2y = __builtin_amdgcn_rcpf(e1y);
        const float kx = (1.0f - fv[t].x) * e2x, ky = (1.0f - fv[t].y) * e2y;
        const unsigned qpk = pk2(bflo(qv[t]) * e1x, bfhi(qv[t]) * e1y), kpk = pk2(kx, ky);
        *(GAS unsigned*)(qtp + t * 128) = qpk;
        *(LAS unsigned*)(QL + t * LS + k0) = qpk; *(LAS unsigned*)(KL + t * LS + k0) = kpk;
        if (t & 1) { kta[slot32(t - 1) >> 1] = pk2(kprev.x, kx); ktb[slot32(t - 1) >> 1] = pk2(kprev.y, ky); } else kprev = (f32x2){kx, ky};
    }
    {   GAS v4u* pk = (GAS v4u*)((GAS bf16_t*)I.KT + (size_t)ci * 4096 + (size_t)k0 * 32);
#pragma unroll
        for (int q = 0; q < 4; ++q) { pk[q] = (v4u){kta[4 * q], kta[4 * q + 1], kta[4 * q + 2], kta[4 * q + 3]}; pk[4 + q] = (v4u){ktb[4 * q], ktb[4 * q + 1], ktb[4 * q + 2], ktb[4 * q + 3]}; } }
    {   GAS float* sc = (GAS float*)I.SC + (size_t)ci * 384;
        *(GAS f32x2*)(sc + k0) = (f32x2){__expf(gref.x), __expf(gref.y)}; *(GAS f32x2*)(sc + 128 + k0) = (f32x2){__expf(total.x - gref.x), __expf(total.y - gref.y)}; *(GAS f32x2*)(sc + 256 + k0) = (f32x2){__expf(total.x), __expf(total.y)}; }
    {
        asm volatile("s_waitcnt lgkmcnt(0)" ::: "memory");
        const int fr = lane & 15, fq = lane >> 4;
#pragma unroll
        for (int ti = 0; ti < 2; ++ti) { f32x4 p0 = (f32x4){0.f, 0.f, 0.f, 0.f}, p1 = p0;
#pragma unroll
            for (int sg = 0; sg < 4; ++sg) { const bf16x8 bq = *(const LAS bf16x8*)(QL + (16 * ti + fr) * LS + 32 * sg + 8 * fq);
                p0 = __builtin_amdgcn_mfma_f32_16x16x32_bf16(*(const LAS bf16x8*)(KL + fr * LS + 32 * sg + 8 * fq), bq, p0, 0, 0, 0);
                p1 = __builtin_amdgcn_mfma_f32_16x16x32_bf16(*(const LAS bf16x8*)(KL + (16 + fr) * LS + 32 * sg + 8 * fq), bq, p1, 0, 0, 0); }
            float m0[4], m1[4];
#pragma unroll
            for (int r = 0; r < 4; ++r) { const int ts0 = 4 * fq + r, ts1 = 16 + 4 * fq + r, tt = 16 * ti + fr; m0[r] = (DIR ? ts0 >= tt : ts0 <= tt) ? p0[r] : 0.f; m1[r] = (DIR ? ts1 >= tt : ts1 <= tt) ? p1[r] : 0.f; }
            v4u w; w.x = pk2(m0[0], m0[1]); w.y = pk2(m0[2], m0[3]); w.z = pk2(m1[0], m1[1]); w.w = pk2(m1[2], m1[3]);
            ((GAS v4u*)I.PF)[(size_t)ci * 128 + ti * 64 + lane] = w; }
        asm volatile("s_waitcnt lgkmcnt(0)" ::: "memory");
    }
    if (DIR == 0) {
        const GAS bf16_t* vp = (const GAS bf16_t*)Vb + (size_t)rowbase * D + h * 128 + k0;
        unsigned va[16], vb[16], vprev = 0u;
#pragma unroll
        for (int t = 0; t < 32; ++t) { const unsigned vv = *(const GAS unsigned*)(vp + t * D); if (t & 1) { va[slot32(t - 1) >> 1] = (vprev & 0xffffu) | (vv << 16); vb[slot32(t - 1) >> 1] = (vprev >> 16) | (vv & 0xffff0000u); } else vprev = vv; }
        GAS v4u* pv = (GAS v4u*)((GAS bf16_t*)I.VT + ((size_t)(b * 8 + h) * RNCH + c) * 4096 + (size_t)k0 * 32);
#pragma unroll
        for (int q = 0; q < 4; ++q) { pv[q] = (v4u){va[4 * q], va[4 * q + 1], va[4 * q + 2], va[4 * q + 3]}; pv[4 + q] = (v4u){vb[4 * q], vb[4 * q + 1], vb[4 * q + 2], vb[4 * q + 3]}; }
    }
}
__device__ __forceinline__ int hgc_vtslot(int d, int c) { if (c < 8) return d == 0 ? c : 7 - c; return 8 + (d == 0 ? c - 8 : 511 - (c - 8)); }

__device__ __forceinline__ void ph_hgc_prep(const Ctx& C, const bf16_t* QVG, const float* FG, const HgImg& I) {
    const bf16_t* Qb = QVG; const bf16_t* Vb = QVG + (size_t)MROWS * D;
    const int gw = C.bid * NWAVES + C.wave, NGW = C.G * NWAVES;
    LAS unsigned char* wl = C.lds + C.wave * 17408;
    for (int it = gw; it < HGC_NITEM; it += NGW) {
        const int c = it % RNCH, ch = it / RNCH, h = ch & 7, b = (ch >> 3) & 1, d = ch >> 4;
        if (d == 0) hgc_prep_one<0>(wl, C.lane, b, h, c, Qb, Vb, FG, I);
        else hgc_prep_one<1>(wl, C.lane, b, h, c, Qb, Vb, FG + (size_t)MROWS * D, I);
    }
}

__device__ __forceinline__ void ph_hgc_scan(const Ctx& C, const HgImg& I, float* O) {
    constexpr int RS = 136, TS = 40;
    constexpr int O_QT = 0, O_KT = 32 * RS, O_VT = O_KT + 128 * TS, O_END = O_VT + 64 * TS;
    constexpr int BUFB = O_END * 2 + 1536 + 2048;
    LAS float* ostage = (LAS float*)(C.lds + 2 * BUFB);
    const int tid = C.tid, lane = C.lane, wave = C.wave, fr = lane & 15, fq = lane >> 4;
    for (int item = C.bid; item < 64; item += C.G) {
        const int chain = item >> 1, vh = item & 1, d = chain >> 4, b = (chain >> 3) & 1, h = chain & 7;
        const size_t ci0 = (size_t)chain * RNCH;
        if (wave < 4) {
            f32x4 ST[8];
#pragma unroll
            for (int i = 0; i < 8; ++i) ST[i] = (f32x4){0.f, 0.f, 0.f, 0.f};
            SCAN_BAR();
#pragma unroll 1
            for (int cc = 0; cc < RNCH; ++cc) {
                const LAS bf16_t* B = (const LAS bf16_t*)(C.lds + (cc & 1) * BUFB); const LAS float* sc = (const LAS float*)(B + O_END); const LAS v4u* PF = (const LAS v4u*)(sc + 384);
                bf16x8 fQ[2][4], fKT[8]; f32x4 eg[8];
                const bf16x8 vfrag = *(const LAS bf16x8*)(B + O_VT + (16 * wave + fr) * TS + 8 * fq);
                const bf16x8 pf0 = __builtin_bit_cast(bf16x8, PF[lane]), pf1 = __builtin_bit_cast(bf16x8, PF[64 + lane]);
#pragma unroll
                for (int ti = 0; ti < 2; ++ti)
#pragma unroll
                    for (int sg = 0; sg < 4; ++sg) fQ[ti][sg] = *(const LAS bf16x8*)(B + O_QT + (16 * ti + fr) * RS + 32 * sg + 8 * fq);
#pragma unroll
                for (int i = 0; i < 8; ++i) { fKT[i] = *(const LAS bf16x8*)(B + O_KT + (16 * i + fr) * TS + 8 * fq); eg[i] = *(const LAS f32x4*)(sc + 16 * i + 4 * fq); }
                __builtin_amdgcn_sched_barrier(0);
                bf16x8 sfrag[4];
#pragma unroll
                for (int sg = 0; sg < 4; ++sg) { const f32x4 s0 = ST[2 * sg] * eg[2 * sg], s1 = ST[2 * sg + 1] * eg[2 * sg + 1]; v4u w; w.x = pk2(s0[0], s0[1]); w.y = pk2(s0[2], s0[3]); w.z = pk2(s1[0], s1[1]); w.w = pk2(s1[2], s1[3]); sfrag[sg] = __builtin_bit_cast(bf16x8, w); }
#pragma unroll
                for (int ti = 0; ti < 2; ++ti) { f32x4 o = (f32x4){0.f, 0.f, 0.f, 0.f};
                    o = __builtin_amdgcn_mfma_f32_16x16x32_bf16(ti ? pf1 : pf0, vfrag, o, 0, 0, 0);
#pragma unroll
                    for (int sg = 0; sg < 4; ++sg) o = __builtin_amdgcn_mfma_f32_16x16x32_bf16(fQ[ti][sg], sfrag[sg], o, 0, 0, 0);
#pragma unroll
                    for (int r = 0; r < 4; ++r) ostage[(cc & 1) * 2048 + (16 * ti + 4 * fq + r) * 64 + 16 * wave + fr] = o[r]; }
#pragma unroll
                for (int i = 0; i < 8; ++i) { const f32x4 ec = *(const LAS f32x4*)(sc + 128 + 16 * i + 4 * fq), ea = *(const LAS f32x4*)(sc + 256 + 16 * i + 4 * fq); f32x4 n = (f32x4){0.f, 0.f, 0.f, 0.f}; n = __builtin_amdgcn_mfma_f32_16x16x32_bf16(fKT[i], vfrag, n, 0, 0, 0); ST[i] = ST[i] * ea + n * ec; }
                SCAN_BAR();
            }
            SCAN_BAR();
        } else {
            const int lt = tid - 256;
            v4u gA[7], gB[7], gC[7], gD[7], gE[7], gF[7];
#define HGC_LOAD(cc, g) do { const size_t ci = ci0 + (cc); const GAS v4u* pq = (const GAS v4u*)((const GAS bf16_t*)I.QT + ci * 4096); const GAS v4u* pk = (const GAS v4u*)((const GAS bf16_t*)I.KT + ci * 4096); \
            g[0] = pq[lt]; g[1] = pq[lt + 256]; g[2] = pk[lt]; g[3] = pk[lt + 256]; \
            g[4] = ((const GAS v4u*)((const GAS bf16_t*)I.VT + ((size_t)(b * 8 + h) * RNCH + hgc_vtslot(d, (cc))) * 4096 + vh * 2048))[lt]; \
            g[5] = ((const GAS v4u*)((const GAS float*)I.SC + ci * 384))[lt < 96 ? lt : 0]; g[6] = ((const GAS v4u*)I.PF)[ci * 128 + (lt & 127)]; } while (0)
#define HGC_STORE(cc, g) do { LAS bf16_t* B = (LAS bf16_t*)(C.lds + ((cc) & 1) * BUFB); const int r16 = lt >> 4, c16 = (lt & 15) * 8, r4 = lt >> 2, c4 = (lt & 3) * 8; \
            *(LAS v4u*)(B + O_QT + r16 * RS + c16) = g[0]; *(LAS v4u*)(B + O_QT + (r16 + 16) * RS + c16) = g[1]; \
            *(LAS v4u*)(B + O_KT + r4 * TS + c4) = g[2]; *(LAS v4u*)(B + O_KT + (r4 + 64) * TS + c4) = g[3]; *(LAS v4u*)(B + O_VT + r4 * TS + c4) = g[4]; \
            if (lt < 96) *(LAS v4u*)((LAS float*)(B + O_END) + lt * 4) = g[5]; if (lt < 128) *((LAS v4u*)((LAS float*)(B + O_END) + 384) + lt) = g[6]; } while (0)
            f32x4 ofA[2], ofB[2];
#pragma unroll
            for (int q = 0; q < 2; ++q) { ofA[q] = (f32x4){0.f, 0.f, 0.f, 0.f}; ofB[q] = ofA[q]; }
#define HGC_OFLUSH(cc, of) do { const int rowbase = rwc_rowbase(d, b, (cc)); _Pragma("unroll") for (int q = 0; q < 2; ++q) { const int idx = lt + 256 * q, tau = idx >> 4, c4 = idx & 15; \
                of[q] = *(const LAS f32x4*)(ostage + ((cc) & 1) * 2048 + tau * 64 + 4 * c4); \
                *(GAS f32x4*)((GAS float*)O + ((size_t)d * MROWS + rowbase + tau) * D + h * 128 + vh * 64 + 4 * c4) = of[q]; } } while (0)
            HGC_LOAD(0, gA); HGC_STORE(0, gA); HGC_LOAD(1, gB); HGC_LOAD(2, gC); HGC_LOAD(3, gD); HGC_LOAD(4, gE); HGC_LOAD(5, gF); HGC_LOAD(6, gA);
            SCAN_BAR();
#define HGC_LSTEP(cc, g, of, ofo) do { if ((cc) + 1 < RNCH) { HGC_STORE((cc) + 1, g); if ((cc) + 7 < RNCH) HGC_LOAD((cc) + 7, g); } \
                asm volatile("" :: "v"(ofo[0]), "v"(ofo[1])); if ((cc) >= 1) HGC_OFLUSH((cc) - 1, of); SCAN_BAR(); } while (0)
            static_assert(RNCH % 6 == 4, "loop shape");
#pragma unroll 1
            for (int cc = 0; cc + 5 < RNCH; cc += 6) { HGC_LSTEP(cc, gB, ofA, ofB); HGC_LSTEP(cc + 1, gC, ofB, ofA); HGC_LSTEP(cc + 2, gD, ofA, ofB); HGC_LSTEP(cc + 3, gE, ofB, ofA); HGC_LSTEP(cc + 4, gF, ofA, ofB); HGC_LSTEP(cc + 5, gA, ofB, ofA); }
            HGC_LSTEP(RNCH - 4, gB, ofA, ofB); HGC_LSTEP(RNCH - 3, gC, ofB, ofA); HGC_LSTEP(RNCH - 2, gD, ofA, ofB); HGC_LSTEP(RNCH - 1, gE, ofB, ofA);
            HGC_OFLUSH(RNCH - 1, ofA);
            SCAN_BAR();
#undef HGC_LSTEP
#undef HGC_OFLUSH
#undef HGC_LOAD
#undef HGC_STORE
        }
    }
}
constexpr int MOE_MAXROWS = 68608;
constexpr int MOE_MAXT = MOE_MAXROWS / 256;

__device__ __forceinline__ void ph_moe_route(const Ctx& C, const float* res, const float* g, const float* modl, const float* router, bf16_t* H2, int* TOKE, float* TOKG, int* BCNT, unsigned* tc = nullptr) {
    LAS float* rt = (LAS float*)C.lds;
    LAS int* cnt = (LAS int*)(rt + D * NEXP);
    for (int i = C.tid; i < D * NEXP; i += NTHR) rt[i] = router[i];
    if (C.tid < NEXP) cnt[C.tid] = 0;
    __syncthreads();
    const int lane = C.lane; const bool split = tc != nullptr; const RowIt it = row_part(C, split);
    for (int r = it.r0; r < it.r1; r += it.step) {
        f32x4 v[4]; load_row(res + (size_t)r * D, lane, v); const float s = row_rstd(v);
        const int b = row_bidx(r);
        const GAS f32x4* g4 = (const GAS f32x4*)g + lane; const GAS f32x4* sh4 = (const GAS f32x4*)(modl + (size_t)(b * 6 + 3) * D) + lane; const GAS f32x4* sc4 = (const GAS f32x4*)(modl + (size_t)(b * 6 + 4) * D) + lane;
        GAS v2u* o = (GAS v2u*)(H2 + (size_t)r * D) + lane;
        float lg[NEXP];
#pragma unroll
        for (int e = 0; e < NEXP; ++e) lg[e] = 0.f;
#pragma unroll
        for (int j = 0; j < 4; ++j) { const f32x4 h = v[j] * s * g4[64 * j] * (sc4[64 * j] + 1.0f) + sh4[64 * j];
            v2u w; w.x = pk2(h.x, h.y); w.y = pk2(h.z, h.w); o[64 * j] = w;
#pragma unroll
            for (int i = 0; i < 4; ++i) { const LAS f32x4* rr = (const LAS f32x4*)(rt + (size_t)(256 * j + 4 * lane + i) * NEXP); const f32x4 r0 = rr[0], r1 = rr[1]; const float hv = h[i];
                lg[0] += hv * r0.x; lg[1] += hv * r0.y; lg[2] += hv * r0.z; lg[3] += hv * r0.w; lg[4] += hv * r1.x; lg[5] += hv * r1.y; lg[6] += hv * r1.z; lg[7] += hv * r1.w; } }
#pragma unroll
        for (int e = 0; e < NEXP; ++e) lg[e] = wave_sum(lg[e]);
        int i0 = 0; float l0 = lg[0];
#pragma unroll
        for (int e = 1; e < NEXP; ++e) if (lg[e] > l0) { l0 = lg[e]; i0 = e; }
        int i1 = -1; float l1 = -3.0e38f;
#pragma unroll
        for (int e = 0; e < NEXP; ++e) if (e != i0 && lg[e] > l1) { l1 = lg[e]; i1 = e; }
        const float g0 = 1.0f / (1.0f + __expf(l1 - l0));
        if (lane == 0) { TOKE[2 * r] = i0; TOKE[2 * r + 1] = i1; TOKG[2 * r] = g0; TOKG[2 * r + 1] = 1.0f - g0; __hip_atomic_fetch_add(&cnt[i0], 1, __ATOMIC_RELAXED, __HIP_MEMORY_SCOPE_WORKGROUP); __hip_atomic_fetch_add(&cnt[i1], 1, __ATOMIC_RELAXED, __HIP_MEMORY_SCOPE_WORKGROUP); }
    }
    __syncthreads();
    if (C.tid < NEXP) BCNT[C.bid * NEXP + C.tid] = cnt[C.tid];
    __syncthreads();
}
__device__ __forceinline__ void ph_moe_scatter(const Ctx& C, const bf16_t* H2, const int* TOKE, const int* BCNT, int* DEST, int* TILE, bf16_t* ABUF, bool split = false) {
    LAS int* cur = (LAS int*)C.lds;
    if (C.tid < NEXP) { int tot = 0, mine = 0; for (int b = 0; b < C.G; ++b) { const int c = BCNT[b * NEXP + C.tid]; tot += c; mine += (b < C.bid) ? c : 0; } cur[16 + C.tid] = tot; cur[24 + C.tid] = mine; }
    __syncthreads();
    if (C.tid == 0) { int st = 0; for (int e = 0; e < NEXP; ++e) { const int nt = (cur[16 + e] + 255) >> 8; cur[8 + e] = st; cur[e] = st * 256 + cur[24 + e]; if (C.bid == 0) for (int q = 0; q < nt; ++q) TILE[st + q] = e; st += nt; } if (C.bid == 0) TILE[MOE_MAXT] = st; }
    __syncthreads();
    const int lane = C.lane; const RowIt it = row_part(C, split);
    for (int r = it.r0; r < it.r1; r += it.step) {
        int p0 = 0, p1 = 0;
        if (lane == 0) { p0 = __hip_atomic_fetch_add(&cur[TOKE[2 * r]], 1, __ATOMIC_RELAXED, __HIP_MEMORY_SCOPE_WORKGROUP); p1 = __hip_atomic_fetch_add(&cur[TOKE[2 * r + 1]], 1, __ATOMIC_RELAXED, __HIP_MEMORY_SCOPE_WORKGROUP); DEST[2 * r] = p0; DEST[2 * r + 1] = p1; }
        p0 = __shfl(p0, 0); p1 = __shfl(p1, 0);
        const GAS v4u* src = (const GAS v4u*)(H2 + (size_t)r * D) + lane; const v4u a = src[0], b = src[64];
        GAS v4u* d0 = (GAS v4u*)(ABUF + (size_t)p0 * D) + lane; GAS v4u* d1 = (GAS v4u*)(ABUF + (size_t)p1 * D) + lane;
        d0[0] = a; d0[64] = b; d1[0] = a; d1[64] = b;
    }
}
struct SchedMoe {
    const bf16_t* A; const bf16_t* Bt; const int* TILE; int lda, ldb, npl  , G, c; int mode = 0;
    __device__ __forceinline__ bool next(int i, Unit& u) const { const int nt = TILE[MOE_MAXT]; const long tot = (long)nt * npl, mainu = (tot / G) * G;
        const long L = mode == 2 ? mainu + c : (long)i * G + c; if (L >= (mode == 1 ? mainu : tot) || (mode == 2 && i > 0)) return false;
        u.pm = (int)(L / npl); u.aux = (int)(L % npl); u.pn = TILE[u.pm] * npl + u.aux; return true; }
    __device__ __forceinline__ const char* a_ptr(const Unit& u) const { return (const char*)(A + (size_t)u.pm * 256 * lda); }
    __device__ __forceinline__ const char* b_ptr(const Unit& u) const { return (const char*)(Bt + (size_t)u.pn * 256 * ldb); }
};
__device__ __forceinline__ void ph_moe_combine(const Ctx& C, float* res, const float* modl, const float* OUT, const int* DEST, const float* TOKG, const float* fin_g = nullptr, float* out = nullptr,
                                               const float* nx_g = nullptr, const float* nx_modl = nullptr, bf16_t* nx_hb = nullptr, unsigned* tc = nullptr, int b0 = 0, int pm_main = 0x7fffffff, int pm_end = 0) {
    if (C.bid < b0) return;
    const int gw = (C.bid - b0) * NWAVES + C.wave, NGW = (C.G - b0) * NWAVES, lane = C.lane;
    const bool fin = out != nullptr;
    auto one_row = [&](int r, int d0, int d1) {
        const float g0 = TOKG[2 * r], g1 = TOKG[2 * r + 1]; const int b = row_bidx(r);
        const GAS f32x4* o0 = (const GAS f32x4*)(OUT + (size_t)d0 * D) + lane; const GAS f32x4* o1 = (const GAS f32x4*)(OUT + (size_t)d1 * D) + lane;
        const GAS f32x4* gt = (const GAS f32x4*)(modl + (size_t)(b * 6 + 5) * D) + lane; GAS f32x4* rp = (GAS f32x4*)(res + (size_t)r * D) + lane;
        f32x4 v[4];
#pragma unroll
        for (int j = 0; j < 4; ++j) v[j] = rp[64 * j] + gt[64 * j] * (o0[64 * j] * g0 + o1[64 * j] * g1);
        if (!fin) {
#pragma unroll
            for (int j = 0; j < 4; ++j) rp[64 * j] = v[j];
            if (nx_hb != nullptr) {
                const float s = row_rstd(v);
                const GAS f32x4* g4 = (const GAS f32x4*)nx_g + lane; const GAS f32x4* sh4 = (const GAS f32x4*)(nx_modl + (size_t)(b * 6 + 0) * D) + lane; const GAS f32x4* sc4 = (const GAS f32x4*)(nx_modl + (size_t)(b * 6 + 1) * D) + lane;
                GAS v2u* o = (GAS v2u*)(nx_hb + (size_t)r * D) + lane;
#pragma unroll
                for (int j = 0; j < 4; ++j) { const f32x4 h = v[j] * s * g4[64 * j] * (sc4[64 * j] + 1.0f) + sh4[64 * j]; v2u w; w.x = pk2(h.x, h.y); w.y = pk2(h.z, h.w); o[64 * j] = w; }
            }
        } else {
            const float s = row_rstd(v);
            const GAS f32x4* g4 = (const GAS f32x4*)fin_g + lane; GAS f32x4* o = (GAS f32x4*)(out + (size_t)(r - NCTX) * D) + lane;
#pragma unroll
            for (int j = 0; j < 4; ++j) o[64 * j] = v[j] * s * g4[64 * j];
        }
    };
    unsigned defer = 0u; int k = 0;
    for (int r = gw + (fin ? NCTX : 0); r < MROWS; r += NGW, ++k) {
        const int d0 = DEST[2 * r], d1 = DEST[2 * r + 1];
        if ((d0 >> 8) >= pm_main || (d1 >> 8) >= pm_main) { defer |= 1u << k; continue; }
        one_row(r, d0, d1);
    }
    if (tc != nullptr && pm_main < pm_end) {
        __syncthreads();
        if (C.tid == 0) { for (int t = pm_main; t < pm_end; ++t) { unsigned sp = 0; while (__hip_atomic_load(tc + t, __ATOMIC_RELAXED, __HIP_MEMORY_SCOPE_AGENT) < (unsigned)(D / 256)) { __builtin_amdgcn_s_sleep(2); if (++sp > (1u << 22)) break; } }
            __builtin_amdgcn_fence(__ATOMIC_ACQUIRE, "agent"); asm volatile("s_waitcnt vmcnt(0)" ::: "memory"); }
        __syncthreads();
        k = 0;
        for (int r = gw + (fin ? NCTX : 0); r < MROWS; r += NGW, ++k) if ((defer >> k) & 1u) { const int d0 = DEST[2 * r], d1 = DEST[2 * r + 1]; one_row(r, d0, d1); }
    }
}
constexpr size_t HY_H = 0;
constexpr size_t HY_PROJT = al256(HY_H + SZ_ACT_BF);
constexpr size_t HY_HB = al256(HY_PROJT + (size_t)3 * D * MROWS * 4);
constexpr size_t HY_FILT = al256(HY_HB + (size_t)HY_NPOS * 256 * 2);
constexpr size_t HY_YT = al256(HY_FILT + (size_t)4096 * HY_NPOS * 4);
constexpr size_t HY_YB = al256(HY_YT + (size_t)D * MROWS * 4);
constexpr size_t HY_SCR = al256(HY_YB + SZ_ACT_BF);
constexpr size_t HY_END = HY_SCR + (size_t)256 * 3 * FN * 8;
static_assert(HY_END <= ARENA_BYTES, "hyena arena");
constexpr size_t HYW_WIN = (size_t)8 << 20, HYW_WO = ((size_t)8 << 20) + (size_t)3 * D * D * 2;

__device__ __forceinline__ void hy_cvt(const Ctx& C, const Args& args, unsigned char* ws) {
    bf16_t* WinT = (bf16_t*)(ws + WS_WREG + HYW_WIN); bf16_t* WoT = (bf16_t*)(ws + WS_WREG + HYW_WO);
    const CvtJob jobs[2] = { {args.in[I_HY_WIN], WinT, D, 3 * D, 3 * D, D, 0, 0, 3 * D, 0}, {args.in[I_HY_WO], WoT, D, D, D, D, 0, 0, D, 0} };
    cvt_run(C, jobs);
}
__device__ __forceinline__ SchedPlain res_sched(const Ctx& C, const bf16_t* A, const bf16_t* Bt, int ld, int part) {
    if (part == 1) return SchedPlain{A, Bt, ld, ld, PMT - NCTX / 256, D / 256, C.G, C.bid, NCTX / 256};
    if (part == 2) return SchedPlain{A, Bt, ld, ld, NCTX / 256, D / 256, TAILB, C.bid, 0};
    return SchedPlain{A, Bt, ld, ld, PMT, D / 256, C.G, C.bid, 0};
}
__device__ __forceinline__ unsigned* tail_tc(unsigned char* ws, int inst) { return (unsigned*)(ws + WS_CTL) + CW_TC + 8 * inst; }
__device__ __forceinline__ void tail_done(const Ctx& C, unsigned* tc) { int pm, pn; (void)pg8::static_unit(NCTX / 256, D / 256, TAILB, C.bid, 0, pm, pn); tile_signal(C, tc + pm); tile_wait_block(C, tc, NCTX / 256, D / 256); }
enum { TI_RW0 = 0, TI_FF0, TI_HY, TI_HG, TI_FF2 };
__device__ __forceinline__ void rw_phase_wo(const Ctx& C, const Args& args, unsigned char* ws, int layer, int slot, int part = -1);
__device__ __forceinline__ void ff_phase_g2(const Ctx& C, unsigned char* ws, int layer, int part = -1);
__device__ __forceinline__ void hg_phase_wo(const Ctx& C, unsigned char* ws, int layer, int part = -1);
__device__ __forceinline__ void hy_phase_a(const Ctx& C, const Args& args, unsigned char* ws, int layer) {
    const bool split = tail_split(C); unsigned* tc = tail_tc(ws, TI_FF0);
    if (split && C.bid < TAILB) { ff_phase_g2(C, ws, layer - 1, 2); tail_done(C, tc); }
    ph_hy_w4split(C, args.in[I_HY_FW4], (bf16_t*)(ws + WS_ZREG + Z_AW));
    ph_hy_filter_mlp(C, args.in[I_HY_FW1], args.in[I_HY_FB1], args.in[I_HY_FW2], args.in[I_HY_FB2], args.in[I_HY_FW3], args.in[I_HY_FB3], args.in[I_HY_FREQ], (bf16_t*)(ws + WS_ARENA + HY_HB));
    ph_norm_mod_bf16(C, (const float*)(ws + WS_RES), args.in[I_NORMG] + (size_t)(layer * 2 + 0) * D, (const float*)(ws + WS_MOD) + (size_t)layer * 18 * D, 0, 1, (bf16_t*)(ws + WS_ARENA + HY_H), split ? tc : nullptr);
}
__device__ __forceinline__ void hy_phase_b(const Ctx& C, const Args& args, unsigned char* ws) {
    constexpr int NCU_ = 3 * D / 256 * (NCTX / 256);
    const bool split = C.G >= 4 * NCU_;
    const EpiF32RowBias EP{(float*)(ws + WS_ARENA + HY_PROJT), MROWS, args.in[I_HY_BIN]};
    {   SchedPlain S{(const bf16_t*)(ws + WS_WREG + HYW_WIN), (const bf16_t*)(ws + WS_ARENA + HY_H), D, D, 3 * D / 256, split ? PMT - NCTX / 256 : PMT, C.G, C.bid, 0, split ? NCTX / 256 : 0};
        pg8::gemm_phase(C.lds, D, D, D, S, EP); }
    if (split && C.bid < NCU_) {
        SchedPlain S{(const bf16_t*)(ws + WS_WREG + HYW_WIN), (const bf16_t*)(ws + WS_ARENA + HY_H), D, D, 3 * D / 256, NCTX / 256, NCU_, C.bid, 0, 0};
        pg8::gemm_phase(C.lds, D, D, D, S, EP);
    } else {
        const int g0 = split ? NCU_ : 0;
        SchedPlain S{(const bf16_t*)(ws + WS_ZREG + Z_AW), (const bf16_t*)(ws + WS_ARENA + HY_HB), 256, 256, 4096 / 256, HY_NPOS / 256, C.G - g0, C.bid - g0};
        EpiHyFilt E{(float*)(ws + WS_ARENA + HY_FILT)};
        pg8::gemm_phase(C.lds, 256, 256, 256, S, E); }
}
__device__ __forceinline__ void hy_phase_wo(const Ctx& C, const Args& args, unsigned char* ws, int layer, int part = -1) {
    if (part < 0) part = tail_split(C) ? 1 : 0;
    SchedPlain S = res_sched(C, (const bf16_t*)(ws + WS_ARENA + HY_YB), (const bf16_t*)(ws + WS_WREG + HYW_WO), D, part);
    EpiRes E{(float*)(ws + WS_RES), (const float*)(ws + WS_MOD) + (size_t)layer * 18 * D, 2, args.in[I_HY_BO]};
    pg8::gemm_phase(C.lds, D, D, D, S, E);
}

__device__ __forceinline__ void ff_cvt(const Ctx& C, const Args& args, unsigned char* ws, int layer);
__device__ __forceinline__ void hg_cvt(const Ctx& C, const Args& args, unsigned char* ws, int slot);
__device__ __forceinline__ void mo_cvt(const Ctx& C, const Args& args, unsigned char* ws, int layer);
constexpr size_t RW_X6 = 0;
constexpr size_t RW_RKV = al256(RW_X6 + 6 * SZ_ACT_BF);
constexpr size_t RW_LD = al256(RW_RKV + 3 * SZ_ACT_BF);
constexpr size_t RW_DEC = al256(RW_LD + SZ_ACT_BF);
constexpr size_t RW_ASIG = RW_DEC + 2 * SZ_ACT_BF;
constexpr size_t RW_Y = RW_DEC;
constexpr size_t RW_YB = RW_LD;
constexpr size_t RW_G = al256(RW_ASIG + 2 * SZ_ACT_BF);
constexpr size_t RW_BON = al256(RW_G + SZ_ACT_BF);
constexpr size_t RW_IMG_BT = al256(RW_BON + (size_t)2 * MROWS * RW_H * 4);
constexpr size_t RW_IMG_KT = RW_IMG_BT + (size_t)RW_NCHUNKHEAD * 4096;
constexpr size_t RW_IMG_SC = RW_IMG_KT + (size_t)RW_NCHUNKHEAD * 4096;
constexpr size_t RW_IMG_VT = RW_IMG_SC + (size_t)RW_NCHUNKHEAD * 768;
constexpr size_t RW_END = RW_IMG_VT + (size_t)16 * RW_NTCH * 4096;
static_assert((size_t)RW_NCHUNKHEAD * 4096 == 2 * SZ_ACT_BF && 2 * SZ_ACT_F32 == 4 * SZ_ACT_BF && RW_END <= ARENA_BYTES, "rwkv arena");
constexpr size_t RWW_RKV = 0, RWW_WO = (size_t)3 * D * D * 2;

__device__ __forceinline__ bf16_t* rw_vbuf(unsigned char* ws, int slot) { return slot == 0 ? (bf16_t*)(ws + WS_VFIRST) : (bf16_t*)(ws + WS_ARENA + RW_RKV + 2 * SZ_ACT_BF); }
__device__ __forceinline__ RwcImg rw_img(unsigned char* ws) {
    RwcImg I; unsigned char* a = ws + WS_ARENA;
    I.WP = (bf16_t*)(a + RW_X6); I.RT = (bf16_t*)(a + RW_X6 + 2 * SZ_ACT_BF); I.TA = (bf16_t*)(a + RW_X6 + 4 * SZ_ACT_BF); I.ARB = (bf16_t*)(a + RW_X6 + 5 * SZ_ACT_BF); I.ARK = (bf16_t*)(a + RW_LD);
    I.BT = (bf16_t*)(a + RW_IMG_BT); I.KT = (bf16_t*)(a + RW_IMG_KT); I.SC = (float*)(a + RW_IMG_SC); I.VT = (bf16_t*)(a + RW_IMG_VT); return I;
}

__device__ __forceinline__ void rw_cvt(const Ctx& C, const Args& args, unsigned char* ws, int slot) {
    bf16_t* Wrkv = (bf16_t*)(ws + WS_WREG + RWW_RKV); bf16_t* WoT = (bf16_t*)(ws + WS_WREG + RWW_WO);
    bf16_t* Ldn = (bf16_t*)(ws + WS_ZREG + slot * Z_SLOT + Z_LDN); bf16_t* Lup = (bf16_t*)(ws + WS_ZREG + slot * Z_SLOT + Z_LUP);
    const float* wrkv = args.in[I_RW_WRKV] + (size_t)slot * 3 * D * D;
    const float* w1 = args.in[I_RW_W1] + (size_t)slot * 2 * D * 64; const float* a1 = args.in[I_RW_A1] + (size_t)slot * 2 * D * 64;
    const float* w2 = args.in[I_RW_W2] + (size_t)slot * 2 * 64 * D; const float* a2 = args.in[I_RW_A2] + (size_t)slot * 2 * 64 * D;
    const CvtJob jobs[14] = {
        {wrkv, Wrkv, D, D, D, D, 0, 0, D, 0}, {wrkv + (size_t)D * D, Wrkv, D, D, D, D, D, 0, D, 0}, {wrkv + (size_t)2 * D * D, Wrkv, D, D, D, D, 2 * D, 0, D, 0},
        {args.in[I_RW_WO] + (size_t)slot * D * D, WoT, D, D, D, D, 0, 0, D, 0},
        {w1, Ldn, D, 64, 64, D, 0, 0, 64, 0}, {w1 + (size_t)D * 64, Ldn, D, 64, 64, D, 64, 0, 64, 0},
        {a1, Ldn, D, 64, 64, D, 256, 0, 64, 0}, {a1 + (size_t)D * 64, Ldn, D, 64, 64, D, 256 + 64, 0, 64, 0},
        {args.in[I_RW_G1] + (size_t)slot * D * 160, Ldn, D, 160, 160, D, 512, 0, 160, 0},
        {w2, Lup, 64, D, D, 256, 0, 0, D, 0}, {w2 + (size_t)64 * D, Lup, 64, D, D, 256, D, 64, D, 0},
        {a2, Lup, 64, D, D, 256, 2 * D, 0, D, 0}, {a2 + (size_t)64 * D, Lup, 64, D, D, 256, 3 * D, 64, D, 0},
        {args.in[I_RW_G2] + (size_t)slot * 160 * D, Lup, 160, D, D, 256, 4 * D, 0, D, 0} };
    cvt_run(C, jobs);
    if (slot > 0) { const CvtJob jv[2] = { {args.in[I_RW_V1] + (size_t)(slot - 1) * D * 32, Ldn, D, 32, 32, D, 768, 0, 32, 0}, {args.in[I_RW_V2] + (size_t)(slot - 1) * 32 * D, Lup, 32, D, D, 256, 5 * D, 0, D, 0} }; cvt_run(C, jv); }
}
__device__ __forceinline__ void rw_phase_a(const Ctx& C, const Args& args, unsigned char* ws, int layer, int slot) {
    const bool split = layer > 0 && tail_split(C); unsigned* tc = tail_tc(ws, TI_FF2);
    if (split && C.bid < TAILB) { ff_phase_g2(C, ws, layer - 1, 2); tail_done(C, tc); }
    const ResSrc src{(const float*)(ws + WS_RES), layer == 0 ? args.in[I_X] : nullptr, layer == 0 ? args.in[I_CTX] : nullptr};
    ph_rstd(C, src, (float*)(ws + WS_RSTD), split ? tc : nullptr);
}
__device__ __forceinline__ void rw_phase_mix(const Ctx& C, const Args& args, unsigned char* ws, int layer, int slot) {
    const ResSrc src{(const float*)(ws + WS_RES), layer == 0 ? args.in[I_X] : nullptr, layer == 0 ? args.in[I_CTX] : nullptr};
    ph_rw_mix(C, src, (const float*)(ws + WS_RSTD), args.in[I_NORMG] + (size_t)(layer * 2) * D, (const float*)(ws + WS_MOD) + (size_t)layer * 18 * D, args.in[I_RW_MU] + (size_t)slot * 6 * D, (bf16_t*)(ws + WS_ARENA + RW_X6));
}
__device__ __forceinline__ void rw_phase_g1(const Ctx& C, const Args& args, unsigned char* ws, int layer, int slot) {
    SchedRw1 S{(const bf16_t*)(ws + WS_ARENA + RW_X6), (const bf16_t*)(ws + WS_WREG + RWW_RKV), (const bf16_t*)(ws + WS_ZREG + slot * Z_SLOT + Z_LDN), slot > 0 ? 16 : 15, C.G, C.bid};
    EpiRw1 E{(bf16_t*)(ws + WS_ARENA + RW_RKV), (bf16_t*)(ws + WS_ARENA + RW_RKV + SZ_ACT_BF), rw_vbuf(ws, slot), (bf16_t*)(ws + WS_ARENA + RW_LD)};
    pg8::gemm_phase(C.lds, D, D, D, S, E);
}
__device__ __forceinline__ void rw_phase_g2(const Ctx& C, const Args& args, unsigned char* ws, int layer, int slot) {
    SchedRw2 S{(const bf16_t*)(ws + WS_ARENA + RW_LD), (const bf16_t*)(ws + WS_ZREG + slot * Z_SLOT + Z_LUP), slot > 0 ? 24 : 20, C.G, C.bid};
    EpiRw2 E{(bf16_t*)(ws + WS_ARENA + RW_DEC), (bf16_t*)(ws + WS_ARENA + RW_ASIG), (bf16_t*)(ws + WS_ARENA + RW_G), rw_vbuf(ws, slot), (const bf16_t*)(ws + WS_VFIRST),
             args.in[I_RW_W0] + (size_t)slot * 2 * D, args.in[I_RW_A0] + (size_t)slot * 2 * D, args.in[I_RW_V0] + (size_t)(slot > 0 ? slot - 1 : 0) * D};
    pg8::gemm_phase(C.lds, 256, D, 256, S, E);
}
__device__ __forceinline__ void rw_phase_prep(const Ctx& C, const Args& args, unsigned char* ws, int layer, int slot) {
    const RwcImg I = rw_img(ws);
    ph_rwc_prep(C, (const bf16_t*)(ws + WS_ARENA + RW_RKV), (const bf16_t*)(ws + WS_ARENA + RW_RKV + SZ_ACT_BF), rw_vbuf(ws, slot), (const bf16_t*)(ws + WS_ARENA + RW_DEC), (const bf16_t*)(ws + WS_ARENA + RW_ASIG),
                args.in[I_RW_KK] + (size_t)slot * D, args.in[I_RW_KA] + (size_t)slot * D, args.in[I_RW_RK] + (size_t)slot * D, (float*)(ws + WS_ARENA + RW_BON), I);
}
__device__ __forceinline__ void rw_phase_scan(const Ctx& C, const Args& args, unsigned char* ws, int layer, int slot) {
    const RwcImg I = rw_img(ws);
    ph_rwc_scan(C, I, (float*)(ws + WS_ARENA + RW_Y));
    if (layer == 0 && C.G > 128 && C.bid >= 128) { Ctx C2 = C; C2.bid = C.bid - 128; C2.G = C.G - 128; hy_cvt(C2, args, ws); ff_cvt(C2, args, ws, 0); hg_cvt(C2, args, ws, 0); mo_cvt(C2, args, ws, 1); }
    else if (layer == 0 && C.G <= 128) { hy_cvt(C, args, ws); ff_cvt(C, args, ws, 0); hg_cvt(C, args, ws, 0); mo_cvt(C, args, ws, 1); }
    if (layer == 3 && C.G > 128 && C.bid >= 128) { Ctx C2 = C; C2.bid = C.bid - 128; C2.G = C.G - 128; mo_cvt(C2, args, ws, 3); }
    else if (layer == 3 && C.G <= 128) mo_cvt(C, args, ws, 3);
}
__device__ __forceinline__ void rw_phase_post(const Ctx& C, const Args& args, unsigned char* ws, int layer, int slot) {
    ph_rw_post(C, (const float*)(ws + WS_ARENA + RW_Y), (const float*)(ws + WS_ARENA + RW_BON), rw_vbuf(ws, slot), (const bf16_t*)(ws + WS_ARENA + RW_G), args.in[I_RW_LNW] + (size_t)slot * D, args.in[I_RW_LNB] + (size_t)slot * D, (bf16_t*)(ws + WS_ARENA + RW_YB));
}
__device__ __forceinline__ void rw_phase_wo(const Ctx& C, const Args& args, unsigned char* ws, int layer, int slot, int part) {
    if (part < 0) part = (layer == DEPTH - 1 || tail_split(C)) ? 1 : 0;
    SchedPlain S = res_sched(C, (const bf16_t*)(ws + WS_ARENA + RW_YB), (const bf16_t*)(ws + WS_WREG + RWW_WO), D, part);
    EpiRes E{(float*)(ws + WS_RES), (const float*)(ws + WS_MOD) + (size_t)layer * 18 * D, 2, nullptr, layer == 0 ? args.in[I_X] : nullptr, layer == 0 ? args.in[I_CTX] : nullptr};
    pg8::gemm_phase(C.lds, D, D, D, S, E);
}
constexpr size_t FF_H2 = 0, FF_ACT = al256(SZ_ACT_BF);
constexpr size_t WREG_FFN = (size_t)16 << 20, WREG_MOE = (size_t)34 << 20;
constexpr size_t FFW_13 = WREG_FFN, FFW_2 = WREG_FFN + (size_t)2 * FFN * D * 2;
__device__ __forceinline__ void ff_cvt(const Ctx& C, const Args& args, unsigned char* ws, int layer) {
    const float* w13 = args.in[I_FFN_W13] + (size_t)(layer / 2) * D * 2 * FFN; const float* w2 = args.in[I_FFN_W2] + (size_t)(layer / 2) * FFN * D;
    bf16_t* W13T = (bf16_t*)(ws + WS_WREG + FFW_13); bf16_t* W2T = (bf16_t*)(ws + WS_WREG + FFW_2);
    const CvtJob jobs[3] = { {w13, W13T, D, FFN, 2 * FFN, D, 0, 0, 128, 256}, {w13 + FFN, W13T, D, FFN, 2 * FFN, D, 128, 0, 128, 256}, {w2, W2T, FFN, D, D, FFN, 0, 0, D, 0} };
    cvt_run(C, jobs);
}
__device__ __forceinline__ void ff_phase_a(const Ctx& C, const Args& args, unsigned char* ws, int layer) {
    const bool split = tail_split(C); unsigned* tc = tail_tc(ws, layer == 0 ? TI_RW0 : TI_HG);
    if (split && C.bid < TAILB) { if (layer == 0) rw_phase_wo(C, args, ws, 0, 0, 2); else hg_phase_wo(C, ws, layer, 2); tail_done(C, tc); }
    ph_norm_mod_bf16(C, (const float*)(ws + WS_RES), args.in[I_NORMG] + (size_t)(layer * 2 + 1) * D, (const float*)(ws + WS_MOD) + (size_t)layer * 18 * D, 3, 4, (bf16_t*)(ws + WS_ARENA + FF_H2), split ? tc : nullptr);
}
__device__ __forceinline__ void ff_phase_g1(const Ctx& C, unsigned char* ws) {
    SchedPlain S{(const bf16_t*)(ws + WS_ARENA + FF_H2), (const bf16_t*)(ws + WS_WREG + FFW_13), D, D, PMT, 2 * FFN / 256, C.G, C.bid};
    EpiSwiGLU E{(bf16_t*)(ws + WS_ARENA + FF_ACT), FFN};
    pg8::gemm_phase(C.lds, D, D, D, S, E);
}
__device__ __forceinline__ void ff_phase_g2(const Ctx& C, unsigned char* ws, int layer, int part) {
    if (part < 0) part = tail_split(C) ? 1 : 0;
    SchedPlain S = res_sched(C, (const bf16_t*)(ws + WS_ARENA + FF_ACT), (const bf16_t*)(ws + WS_WREG + FFW_2), FFN, part);
    EpiRes E{(float*)(ws + WS_RES), (const float*)(ws + WS_MOD) + (size_t)layer * 18 * D, 5, nullptr};
    pg8::gemm_phase(C.lds, FFN, FFN, FFN, S, E);
}
constexpr size_t MO_H2 = 0;
constexpr size_t MO_ABUF = al256(MO_H2 + SZ_ACT_BF);
constexpr size_t MO_ACT = al256(MO_ABUF + (size_t)MOE_MAXROWS * D * 2);
constexpr size_t MO_OUT = al256(MO_ACT + (size_t)MOE_MAXROWS * EDIM * 2);
constexpr size_t MO_TOKE = al256(MO_OUT + (size_t)MOE_MAXROWS * D * 4);
constexpr size_t MO_TOKG = al256(MO_TOKE + (size_t)MROWS * 8);
constexpr size_t MO_DEST = al256(MO_TOKG + (size_t)MROWS * 8);
constexpr size_t MO_BCNT = al256(MO_DEST + (size_t)MROWS * 8);
constexpr size_t MO_TILE = al256(MO_BCNT + (size_t)1024 * NEXP * 4);
constexpr size_t MO_END = MO_TILE + 4096;
static_assert(MO_END <= ARENA_BYTES, "moe arena");
constexpr size_t MOW_13 = WREG_MOE, MOW_2 = WREG_MOE + (size_t)NEXP * 2 * EDIM * D * 2;
static_assert(MOW_2 + (size_t)NEXP * D * EDIM * 2 <= WREG_BYTES, "moe weights");
__device__ __forceinline__ void mo_cvt(const Ctx& C, const Args& args, unsigned char* ws, int layer) {
    const float* w13 = args.in[I_MOE_W13] + (size_t)(layer / 2) * NEXP * D * 2 * EDIM; const float* w2 = args.in[I_MOE_W2] + (size_t)(layer / 2) * NEXP * EDIM * D;
    bf16_t* W13T = (bf16_t*)(ws + WS_WREG + MOW_13); bf16_t* W2T = (bf16_t*)(ws + WS_WREG + MOW_2);
#pragma unroll 1
    for (int e = 0; e < NEXP; ++e) {
        const CvtJob jobs[3] = { {w13 + (size_t)e * D * 2 * EDIM, W13T + (size_t)e * 2 * EDIM * D, D, EDIM, 2 * EDIM, D, 0, 0, 128, 256}, {w13 + (size_t)e * D * 2 * EDIM + EDIM, W13T + (size_t)e * 2 * EDIM * D, D, EDIM, 2 * EDIM, D, 128, 0, 128, 256},
                                 {w2 + (size_t)e * EDIM * D, W2T + (size_t)e * D * EDIM, EDIM, D, D, EDIM, 0, 0, D, 0} };
        cvt_run(C, jobs); }
}
__device__ __forceinline__ void mo_phase_a(const Ctx& C, const Args& args, unsigned char* ws, int layer) {
    const bool split = layer == 1 && tail_split(C); unsigned* tc = tail_tc(ws, TI_HY);
    if (split && C.bid < TAILB) { hy_phase_wo(C, args, ws, layer, 2); tail_done(C, tc); }
    ph_moe_route(C, (const float*)(ws + WS_RES), args.in[I_NORMG] + (size_t)(layer * 2 + 1) * D, (const float*)(ws + WS_MOD) + (size_t)layer * 18 * D, args.in[I_MOE_ROUTER] + (size_t)(layer / 2) * D * NEXP,
                 (bf16_t*)(ws + WS_ARENA + MO_H2), (int*)(ws + WS_ARENA + MO_TOKE), (float*)(ws + WS_ARENA + MO_TOKG), (int*)(ws + WS_ARENA + MO_BCNT), split ? tc : nullptr);
}
__device__ __forceinline__ void mo_phase_b(const Ctx& C, unsigned char* ws, int layer) {
    ph_moe_scatter(C, (const bf16_t*)(ws + WS_ARENA + MO_H2), (const int*)(ws + WS_ARENA + MO_TOKE), (const int*)(ws + WS_ARENA + MO_BCNT), (int*)(ws + WS_ARENA + MO_DEST), (int*)(ws + WS_ARENA + MO_TILE), (bf16_t*)(ws + WS_ARENA + MO_ABUF),
                   layer == 1 && tail_split(C));
}
__device__ __forceinline__ void mo_phase_g1(const Ctx& C, unsigned char* ws) {
    SchedMoe S{(const bf16_t*)(ws + WS_ARENA + MO_ABUF), (const bf16_t*)(ws + WS_WREG + MOW_13), (const int*)(ws + WS_ARENA + MO_TILE), D, D, 2 * EDIM / 256, C.G, C.bid};
    EpiSwiGLU E{(bf16_t*)(ws + WS_ARENA + MO_ACT), EDIM};
    pg8::gemm_phase(C.lds, D, D, D, S, E);
}
constexpr int MO_TAILMAX = 64;
__device__ __forceinline__ int mo_ntail(const Ctx& C, unsigned char* ws) { const int tot = ((const int*)(ws + WS_ARENA + MO_TILE))[MOE_MAXT] * (D / 256); const int nt = tot % C.G; return (tail_split(C) && nt <= MO_TAILMAX && C.G % (D / 256) == 0) ? nt : 0; }
__device__ __forceinline__ void mo_phase_g2(const Ctx& C, unsigned char* ws, int mode = -1) {
    if (mode < 0) mode = mo_ntail(C, ws) > 0 ? 1 : 0;
    SchedMoe S{(const bf16_t*)(ws + WS_ARENA + MO_ACT), (const bf16_t*)(ws + WS_WREG + MOW_2), (const int*)(ws + WS_ARENA + MO_TILE), EDIM, EDIM, D / 256, C.G, C.bid, mode};
    EpiF32RowBias E{(float*)(ws + WS_ARENA + MO_OUT), D, nullptr};
    pg8::gemm_phase(C.lds, EDIM, EDIM, EDIM, S, E);
}
__device__ __forceinline__ void mo_phase_c(const Ctx& C, const Args& args, unsigned char* ws, int layer) {
    const bool last = layer == DEPTH - 1;
    const bool nx = layer == 1;
    const int ntail = mo_ntail(C, ws); unsigned* tc = (unsigned*)(ws + WS_CTL) + CW_TC + 64 + (layer / 2) * 512; int pm_main = 0x7fffffff; const int pm_end = ((const int*)(ws + WS_ARENA + MO_TILE))[MOE_MAXT];
    if (ntail > 0) { const int tot = ((const int*)(ws + WS_ARENA + MO_TILE))[MOE_MAXT] * (D / 256); const int mainu = (tot / C.G) * C.G; pm_main = mainu / (D / 256);
        if (C.bid < ntail) { mo_phase_g2(C, ws, 2); tile_signal(C, tc + (mainu + C.bid) / (D / 256)); } }
    ph_moe_combine(C, (float*)(ws + WS_RES), (const float*)(ws + WS_MOD) + (size_t)layer * 18 * D, (const float*)(ws + WS_ARENA + MO_OUT), (const int*)(ws + WS_ARENA + MO_DEST), (const float*)(ws + WS_ARENA + MO_TOKG),
                   last ? args.in[I_FINALG] : nullptr, last ? args.out : nullptr,
                   nx ? args.in[I_NORMG] + (size_t)((layer + 1) * 2) * D : nullptr, nx ? (const float*)(ws + WS_MOD) + (size_t)(layer + 1) * 18 * D : nullptr, nx ? (bf16_t*)(ws + WS_ARENA) : nullptr, ntail > 0 ? tc : nullptr, ntail, pm_main, pm_end);
}

constexpr size_t HG_HB = 0;
constexpr size_t HG_QVG = al256(HG_HB + SZ_ACT_BF);
constexpr size_t HG_FG = al256(HG_QVG + 3 * SZ_ACT_BF);
constexpr size_t HG_O = al256(HG_FG + 2 * SZ_ACT_F32);
constexpr size_t HG_YB = al256(HG_O + 2 * SZ_ACT_F32);
constexpr size_t HG_LB_OLD = al256(HG_YB + SZ_ACT_BF);
constexpr size_t HG_IMG_QT = al256(HG_LB_OLD + 2 * D * 4);
constexpr size_t HG_IMG_PF = HG_IMG_QT + (size_t)HGC_NITEM * 8192;
constexpr size_t HG_IMG_KT = HG_IMG_PF + (size_t)HGC_NITEM * 2048;
constexpr size_t HG_IMG_SC = HG_IMG_KT + (size_t)HGC_NITEM * 8192;
constexpr size_t HG_IMG_VT = HG_IMG_SC + (size_t)HGC_NITEM * 1536;
constexpr size_t HG_END = HG_IMG_VT + (size_t)16 * RNCH * 8192;
static_assert(HG_END <= ARENA_BYTES, "hgrn arena");
__device__ __forceinline__ HgImg hg_img(unsigned char* ws) { HgImg I; unsigned char* a = ws + WS_ARENA; I.QT = (bf16_t*)(a + HG_IMG_QT); I.PF = (v4u*)(a + HG_IMG_PF); I.KT = (bf16_t*)(a + HG_IMG_KT); I.SC = (float*)(a + HG_IMG_SC); I.VT = (bf16_t*)(a + HG_IMG_VT); return I; }
constexpr size_t HGW_WIN = (size_t)202 << 20, HGW_WO = ((size_t)202 << 20) + (size_t)5 * D * D * 2;
__device__ __forceinline__ void hg_cvt(const Ctx& C, const Args& args, unsigned char* ws, int slot) {
    const CvtJob jobs[2] = { {args.in[I_HG_WIN] + (size_t)slot * D * 5 * D, (bf16_t*)(ws + WS_WREG + HGW_WIN), D, 5 * D, 5 * D, D, 0, 0, 5 * D, 0}, {args.in[I_HG_WO] + (size_t)slot * D * D, (bf16_t*)(ws + WS_WREG + HGW_WO), D, D, D, D, 0, 0, D, 0} };
    cvt_run(C, jobs);
}
constexpr size_t WS_HGLB = WS_CTL + 49152;
__device__ __forceinline__ void hg_phase_init(const Ctx& C, const Args& args, unsigned char* ws) { ph_hg_lb(C, args.in[I_HG_LB], 2, (float*)(ws + WS_HGLB)); }
__device__ __forceinline__ void hg_phase_g1(const Ctx& C, unsigned char* ws) {
    SchedPlain S{(const bf16_t*)(ws + WS_ARENA + HG_HB), (const bf16_t*)(ws + WS_WREG + HGW_WIN), D, D, PMT, 5 * D / 256, C.G, C.bid};
    EpiHg E{(bf16_t*)(ws + WS_ARENA + HG_QVG), (float*)(ws + WS_ARENA + HG_FG), (const float*)(ws + WS_HGLB)};
    pg8::gemm_phase(C.lds, D, D, D, S, E);
}
__device__ __forceinline__ void hg_phase_scan(const Ctx& C, const Args& args, unsigned char* ws) {
#ifdef HG_SCAN_OLD
    ph_hg_scan_chunk(C, (const bf16_t*)(ws + WS_ARENA + HG_QVG), (const float*)(ws + WS_ARENA + HG_FG), (float*)(ws + WS_ARENA + HG_O));
#else
    { const HgImg I = hg_img(ws); ph_hgc_scan(C, I, (float*)(ws + WS_ARENA + HG_O)); }
#endif
    if (C.G > 64 && C.bid >= 64) { Ctx C2 = C; C2.bid = C.bid - 64; C2.G = C.G - 64; rw_cvt(C2, args, ws, 1); ff_cvt(C2, args, ws, 2); }
    else if (C.G <= 64) { rw_cvt(C, args, ws, 1); ff_cvt(C, args, ws, 2); }
}
__device__ __forceinline__ void hg_phase_prep(const Ctx& C, unsigned char* ws) { const HgImg I = hg_img(ws); ph_hgc_prep(C, (const bf16_t*)(ws + WS_ARENA + HG_QVG), (const float*)(ws + WS_ARENA + HG_FG), I); }
__device__ __forceinline__ void hg_phase_post(const Ctx& C, const Args& args, unsigned char* ws, int slot) {
    ph_hg_post(C, (const float*)(ws + WS_ARENA + HG_O), (const bf16_t*)(ws + WS_ARENA + HG_QVG + 2 * SZ_ACT_BF), args.in[I_HG_GN] + (size_t)slot * 128, (bf16_t*)(ws + WS_ARENA + HG_YB));
}
__device__ __forceinline__ void hg_phase_wo(const Ctx& C, unsigned char* ws, int layer, int part) {
    if (part < 0) part = tail_split(C) ? 1 : 0;
    SchedPlain S = res_sched(C, (const bf16_t*)(ws + WS_ARENA + HG_YB), (const bf16_t*)(ws + WS_WREG + HGW_WO), D, part);
    EpiRes E{(float*)(ws + WS_RES), (const float*)(ws + WS_MOD) + (size_t)layer * 18 * D, 2, nullptr};
    pg8::gemm_phase(C.lds, D, D, D, S, E);
}

__device__ __forceinline__ void ph_rw_diag(const Ctx& C, unsigned char* ws) {
    unsigned* res = (unsigned*)(ws + WS_CTL) + 8200;
    const size_t gt = (size_t)C.bid * NTHR + C.tid, gs = (size_t)C.G * NTHR;
    const RwcImg I = rw_img(ws);
    const bf16_t* ptr[7] = {I.WP, I.TA, I.ARB, I.BT, I.RT, I.ARK, I.KT};
    const size_t cnt[7] = {(size_t)RW_NCHUNKHEAD * 2048, (size_t)RW_NCHUNKHEAD * 1024, (size_t)RW_NCHUNKHEAD * 1024, (size_t)RW_NCHUNKHEAD * 2048, (size_t)RW_NCHUNKHEAD * 2048, (size_t)RW_NCHUNKHEAD * 1024, (size_t)RW_NCHUNKHEAD * 2048};
#pragma unroll
    for (int q = 0; q < 7; ++q) { float mx = 0.f; const GAS bf16_t* p = (const GAS bf16_t*)ptr[q];
        for (size_t i = gt; i < cnt[q]; i += gs) { const unsigned b = p[i]; const float v = fabsf(bf2f(b)); mx = ((b & 0x7f80u) == 0x7f80u) ? 3.0e38f : fmaxf(mx, v); }
        atomicMax(res + q, __builtin_bit_cast(unsigned, mx)); }
}
enum PhaseId { PH_INIT = 0, PH_RW0_A, PH_RW0_MIX, PH_RW0_G1, PH_RW0_G2, PH_RW0_PREP, PH_RW0_SCAN, PH_RW0_POST, PH_RW0_WO, PH_FF0_A, PH_FF0_G1, PH_FF0_G2,
               PH_HY_A, PH_HY_B, PH_HY_CONV, PH_HY_TR, PH_HY_WO, PH_MO1_A, PH_MO1_B, PH_MO1_G1, PH_MO1_G2, PH_MO1_C,
               PH_HG_A, PH_HG_G1, PH_HG_PREP, PH_HG_SCAN, PH_HG_POST, PH_HG_WO, PH_FF2_A, PH_FF2_G1, PH_FF2_G2,
               PH_RW3_A, PH_RW3_MIX, PH_RW3_G1, PH_RW3_G2, PH_RW3_PREP, PH_RW3_SCAN, PH_RW3_POST, PH_RW3_WO, PH_MO3_A, PH_MO3_B, PH_MO3_G1, PH_MO3_G2, PH_MO3_C, PH_FINAL, N_PHASES };
#define RW_PROGRAM(P, layer, slot) \
    if (IN(P##_A)) { rw_phase_a(C, args, ws, layer, slot); SEAM(P##_A); } \
    if (IN(P##_MIX)) { rw_phase_mix(C, args, ws, layer, slot); SEAM(P##_MIX); } \
    if (IN(P##_G1)) { rw_phase_g1(C, args, ws, layer, slot); SEAM(P##_G1); } \
    if (IN(P##_G2)) { rw_phase_g2(C, args, ws, layer, slot); SEAM(P##_G2); } \
    if (IN(P##_PREP)) { rw_phase_prep(C, args, ws, layer, slot); SEAM(P##_PREP); } \
    if (IN(P##_SCAN)) { rw_phase_scan(C, args, ws, layer, slot); SEAM(P##_SCAN); } \
    if (IN(P##_POST)) { rw_phase_post(C, args, ws, layer, slot); SEAM(P##_POST); } \
    if (IN(P##_WO)) { rw_phase_wo(C, args, ws, layer, slot); SEAM(P##_WO); }
#define HY_PROGRAM \
    if (IN(PH_HY_A)) { hy_phase_a(C, args, ws, 1); SEAM(PH_HY_A); } \
    if (IN(PH_HY_B)) { hy_phase_b(C, args, ws); SEAM(PH_HY_B); } \
    if (IN(PH_HY_CONV)) { ph_hy_conv(C, (const float*)(ws + WS_ARENA + HY_PROJT), (const float*)(ws + WS_ARENA + HY_FILT), args.in[I_HY_CW], args.in[I_HY_CB], args.in[I_HY_SKIP], (float*)(ws + WS_ARENA + HY_YT), (f32x2*)(ws + WS_ARENA + HY_SCR), (void*)(ws + WS_CTL + 32768 + 800)); SEAM(PH_HY_CONV); } \
    if (IN(PH_HY_TR)) { ph_hy_transpose(C, (const float*)(ws + WS_ARENA + HY_YT), (bf16_t*)(ws + WS_ARENA + HY_YB)); SEAM(PH_HY_TR); } \
    if (IN(PH_HY_WO)) { hy_phase_wo(C, args, ws, 1); SEAM(PH_HY_WO); }
#define FF_PROGRAM(P, layer) \
    if (IN(P##_A)) { ff_phase_a(C, args, ws, layer); SEAM(P##_A); } \
    if (IN(P##_G1)) { ff_phase_g1(C, ws); SEAM(P##_G1); } \
    if (IN(P##_G2)) { ff_phase_g2(C, ws, layer); SEAM(P##_G2); }
#define MO_PROGRAM(P, layer) \
    if (IN(P##_A)) { mo_phase_a(C, args, ws, layer); SEAM(P##_A); } \
    if (IN(P##_B)) { mo_phase_b(C, ws, layer); SEAM(P##_B); } \
    if (IN(P##_G1)) { mo_phase_g1(C, ws); SEAM(P##_G1); } \
    if (IN(P##_G2)) { mo_phase_g2(C, ws); SEAM(P##_G2); } \
    if (IN(P##_C)) { mo_phase_c(C, args, ws, layer); if ((layer) != DEPTH - 1) SEAM(P##_C); }
#define HG_PROGRAM \
      \
    if (IN(PH_HG_G1)) { hg_phase_g1(C, ws); SEAM(PH_HG_G1); } \
    if (IN(PH_HG_PREP)) { hg_phase_prep(C, ws); SEAM(PH_HG_PREP); } \
    if (IN(PH_HG_SCAN)) { hg_phase_scan(C, args, ws); SEAM(PH_HG_SCAN); } \
    if (IN(PH_HG_POST)) { hg_phase_post(C, args, ws, 0); SEAM(PH_HG_POST); } \
    if (IN(PH_HG_WO)) { hg_phase_wo(C, ws, 2); SEAM(PH_HG_WO); }
#define PHASE_PROGRAM RW_PROGRAM(PH_RW0, 0, 0) FF_PROGRAM(PH_FF0, 0) HY_PROGRAM MO_PROGRAM(PH_MO1, 1) HG_PROGRAM FF_PROGRAM(PH_FF2, 2) RW_PROGRAM(PH_RW3, 3, 1) MO_PROGRAM(PH_MO3, 3)
#ifndef MK_ONE_LAUNCH
#define MK_ONE_LAUNCH 1
#endif

__global__ void __launch_bounds__(NTHR, 2) mega_fwd(Args args) {
    extern __shared__ __attribute__((aligned(16))) unsigned char lds_raw[];
    Ctx C;
    C.lds = (LAS unsigned char*)lds_raw;
    C.tid = threadIdx.x; C.lane = C.tid & 63; C.wave = __builtin_amdgcn_readfirstlane(C.tid >> 6); C.G = gridDim.x; C.bid = blockIdx.x;
    volatile LAS unsigned* MISC = (volatile LAS unsigned*)(C.lds + LDS_MISC);
    if (C.tid < 64) MISC[C.tid] = 0u;
    __syncthreads();
    unsigned char* ws = args.ws;
    unsigned* ctl = (unsigned*)(ws + WS_CTL);
    XcdBarrier bar; bar.bar = ctl + CW_BAR; bar.x = 0; bar.st = nullptr;
    if (MK_ONE_LAUNCH) bar = xcd_barrier_post(ctl + CW_BAR, MISC + 8);
    const int lo = args.ph_lo, hi = args.ph_hi;
#define IN(k) (lo <= (k) && (k) < hi)
#ifdef PROBE_TS
    unsigned long long* TS = (unsigned long long*)(ws + WS_CTL + 32768);
    if (C.bid == 0 && C.tid == 0) TS[0] = __builtin_amdgcn_s_memrealtime();
#define SEAM(k) do { if (MK_ONE_LAUNCH && IN((k) + 1)) xcd_barrier(bar); else __syncthreads(); if (C.bid == 0 && C.tid == 0) TS[(k) + 1] = __builtin_amdgcn_s_memrealtime(); } while (0)
#else
#define SEAM(k) do { if (MK_ONE_LAUNCH && IN((k) + 1)) xcd_barrier(bar); else __syncthreads(); } while (0)
#endif
    float* RES = (float*)(ws + WS_RES);
    float* MOD = (float*)(ws + WS_MOD);

    if (IN(PH_INIT)) { ph_adaln(C, args.in[I_C], args.in[I_CCTX], args.in[I_ADAW], args.in[I_ADAB], MOD); rw_cvt(C, args, ws, 0); hg_phase_init(C, args, ws); SEAM(PH_INIT); }

    PHASE_PROGRAM

#ifdef PROBE_RWDIAG
    if (IN(PH_FINAL)) { xcd_barrier(bar); const unsigned* r = (const unsigned*)(ws + WS_CTL) + 8200;
        float code = 0.f, best = -1.f; for (int q = 0; q < 7; ++q) { const float lg = fminf(9.f, fmaxf(0.f, log10f(__builtin_bit_cast(float, r[q]) + 1e-30f))); if (lg > best) { best = lg; code = 10.f * (q + 1) + lg; } }
        for (size_t i = (size_t)C.bid * NTHR + C.tid; i < (size_t)NLAT * D; i += (size_t)C.G * NTHR) args.out[i] = (i == 0) ? code : 0.f; }
#endif
#ifdef PROBE_DIFF
    if (C.bid == 0) { __syncthreads(); if (C.tid == 0) { const unsigned* r = (const unsigned*)(ws + WS_CTL) + 8192; const float md = __builtin_bit_cast(float, r[0]), ma = __builtin_bit_cast(float, r[1]);
        asm volatile("s_waitcnt vmcnt(0)" ::: "memory"); args.out[0] = 1.0f + 1000.0f * md / fmaxf(ma, 1e-30f); } }
#endif
#ifdef PROBE_TS
    if (C.bid == 0) { __syncthreads(); if (C.tid == 0) {
#ifdef HY_STAMP
        const unsigned long long d1 = TS[100 + HY_K1], d2 = TS[100 + HY_K2];
#else
        const unsigned long long d1 = TS[PROBE_B1] - TS[PROBE_A1], d2 = TS[PROBE_B2] - TS[PROBE_A2];
#endif
        asm volatile("s_waitcnt vmcnt(0)" ::: "memory");
        args.out[0] = (float)d2 * 1e-4f;
        const unsigned long long t0 = __builtin_amdgcn_s_memrealtime(); while (__builtin_amdgcn_s_memrealtime() - t0 < 4ull * d1) __builtin_amdgcn_s_sleep(8);
    } }
#endif
#undef IN
#undef SEAM
}

extern "C" void kernel_launch(void* const* d_in, const int* in_sizes, int n_in, void* d_out, int out_size, void* d_ws, size_t ws_size, hipStream_t stream) {
    static int grid = 0;
    if (grid == 0) {
        if (n_in != N_IN || out_size != NLAT * D || ws_size < WS_END) { fprintf(stderr, "kernel_launch: unexpected shapes (n_in %d out %d ws %zu need %zu)\n", n_in, out_size, ws_size, (size_t)WS_END); grid = -1; return; }
        int dev = 0, cus = 0, per_cu = 0;
        if (hipGetDevice(&dev) != hipSuccess || hipDeviceGetAttribute(&cus, hipDeviceAttributeMultiprocessorCount, dev) != hipSuccess) { grid = -1; return; }
        if (hipFuncSetAttribute((const void*)mega_fwd, hipFuncAttributeMaxDynamicSharedMemorySize, LDS_BYTES) != hipSuccess) { fprintf(stderr, "kernel_launch: hipFuncSetAttribute failed\n"); grid = -1; return; }
        if (hipOccupancyMaxActiveBlocksPerMultiprocessor(&per_cu, (const void*)mega_fwd, NTHR, LDS_BYTES) != hipSuccess || per_cu < 1) { fprintf(stderr, "kernel_launch: occupancy query says %d\n", per_cu); }
        (void)hipGetLastError();
        grid = cus;
    }
    if (grid < 0) return;
    (void)hipMemsetAsync((char*)d_ws + WS_CTL, 0, CTL_BYTES + ZREG_BYTES, stream);
    Args a{};
    for (int i = 0; i < N_IN; ++i) a.in[i] = (const float*)d_in[i];
    a.out = (float*)d_out; a.ws = (unsigned char*)d_ws;
#if MK_ONE_LAUNCH
    a.ph_lo = 0; a.ph_hi = N_PHASES;
    hipLaunchKernelGGL(mega_fwd, dim3(grid), dim3(NTHR), LDS_BYTES, stream, a);
#else
    for (int p = 0; p < N_PHASES; ++p) { a.ph_lo = p; a.ph_hi = p + 1; hipLaunchKernelGGL(mega_fwd, dim3(grid), dim3(NTHR), LDS_BYTES, stream, a); }
#endif
}
```
